# Optimizing an MI355X kernel written in HIP

```python
import jax
import jax.numpy as jnp
from jax import lax

D_MODEL = 2048
BATCH = 2
SEQ = 4096
DEPTH = 1
DEC_BATCH = 128
DEC_SEQ = 1
PAST_LEN = 2048
PAGE_SIZE = 128

N_HEADS_NSA = 16
HD_NSA = 64
D_NSA = N_HEADS_NSA * HD_NSA
KV_HEADS = 4
GQA = N_HEADS_NSA // KV_HEADS
D_KV = KV_HEADS * HD_NSA
ROPE_DIM = HD_NSA // 4
ROPE_THETA = 500000.0
CMP_BLOCK = 32
CMP_STRIDE = 16
CMP_HIDDEN = 128
SEL_BLOCK = 64
SEL_TOPN = 16
N_LOCAL_FORCED = 2
WINDOW = 512
Q_BLOCK = 128
N_HEADS_RWKV = 16
HS = 64
D_RWKV = N_HEADS_RWKV * HS
LORA_W = 64
LORA_A = 64
LORA_G = 160
D_FF = 5632
RMS_EPS = 1e-6
GN_EPS = 64e-5
NEG = -1e30
FORCE_BONUS = 1e4
NSA_COLS = D_NSA + 6 * D_KV + 3 * N_HEADS_NSA
RWKV_COLS = 3 * D_RWKV + LORA_W + LORA_A + LORA_G
IN_COLS = NSA_COLS + RWKV_COLS
NSA_SPLITS = (D_NSA, D_NSA + D_KV, D_NSA + 2 * D_KV, D_NSA + 3 * D_KV, D_NSA + 4 * D_KV, D_NSA + 5 * D_KV, D_NSA + 6 * D_KV)
RWKV_SPLITS = (D_RWKV, 2 * D_RWKV, 3 * D_RWKV, 3 * D_RWKV + LORA_W, 3 * D_RWKV + LORA_W + LORA_A)

kernel_name = 'hybrid_nsa_rwkv7_macaron_step'


def rms_norm(x, g):
    xf = x.astype(jnp.float32)
    y = xf * lax.rsqrt(jnp.mean(xf * xf, axis=-1, keepdims=True) + RMS_EPS)
    return (y * g.astype(jnp.float32)).astype(x.dtype)


def ffn_half(x, g_pre, w_gu, w_dn, g_post):
    gate, up = jnp.split(rms_norm(x, g_pre) @ w_gu, 2, axis=-1)
    return x + 0.5 * rms_norm((jax.nn.silu(gate) * up) @ w_dn, g_post)


def rope_partial(x, pos):
    half = ROPE_DIM // 2
    inv = ROPE_THETA ** (-jnp.arange(half, dtype=jnp.float32) / half)
    ang = pos.astype(jnp.float32)[:, None] * inv[None, :]
    cos, sin = jnp.cos(ang)[:, None, :], jnp.sin(ang)[:, None, :]
    x1 = x[..., :half].astype(jnp.float32)
    x2 = x[..., half:ROPE_DIM].astype(jnp.float32)
    rot = jnp.concatenate([x1 * cos - x2 * sin, x2 * cos + x1 * sin], axis=-1).astype(x.dtype)
    return jnp.concatenate([rot, x[..., ROPE_DIM:]], axis=-1)


def masked_softmax(s, mask):
    p = jax.nn.softmax(jnp.where(mask, s.astype(jnp.float32), NEG), axis=-1)
    return p * mask


def compress(x, pe, w1, w2):
    b, t = x.shape[:2]
    r = CMP_BLOCK // CMP_STRIDE
    nc = (t - CMP_BLOCK) // CMP_STRIDE + 1
    nseg = nc + r - 1
    seg = x[:, :nseg * CMP_STRIDE].reshape(b, nseg, CMP_STRIDE, KV_HEADS, HD_NSA)
    w1s = w1.reshape(r, CMP_STRIDE, HD_NSA, CMP_HIDDEN)
    pre = jnp.einsum('ld,ldh->h', pe, w1)
    for m in range(r):
        pre = pre + jnp.einsum('bnskd,sdh->bnkh', seg[:, m:m + nc], w1s[m])
    return jnp.einsum('bnkh,hd->bnkd', jax.nn.silu(pre), w2)


def cmp_to_sel(nc, ns):
    i = jnp.arange(nc)[:, None] * CMP_STRIDE
    j = jnp.arange(ns)[None, :] * SEL_BLOCK
    ov = jnp.minimum(i + CMP_BLOCK, j + SEL_BLOCK) - jnp.maximum(i, j)
    return (jnp.maximum(ov, 0) // CMP_STRIDE).astype(jnp.float32)


def nsa_attend(q_raw, q_rot, gates, q_pos, k_cmp, v_cmp, k_sel_blk, v_sel_blk, k_win, v_win, win_pos):
    b, nq = q_raw.shape[:2]
    scale = HD_NSA ** -0.5
    qr = q_raw.reshape(b, nq, KV_HEADS, GQA, HD_NSA)
    qs = q_rot.reshape(b, nq, KV_HEADS, GQA, HD_NSA)
    nc = k_cmp.shape[1]
    cmp_end = jnp.arange(nc) * CMP_STRIDE + CMP_BLOCK - 1
    m_cmp = (cmp_end[None, :] <= q_pos[:, None])[None, :, None, None, :]
    p_cmp = masked_softmax(jnp.einsum('bqkgd,bnkd->bqkgn', qr, k_cmp) * scale, m_cmp)
    o_cmp = jnp.einsum('bqkgn,bnkd->bqkgd', p_cmp.astype(v_cmp.dtype), v_cmp)
    ns = k_sel_blk.shape[1]
    imp = jnp.einsum('bqkn,nj->bqkj', p_cmp.sum(axis=3), cmp_to_sel(nc, ns))
    jb = jnp.arange(ns)[None, :]
    cur = (q_pos // SEL_BLOCK)[:, None]
    valid = jb <= cur
    forced = (jb == 0) | ((cur - jb >= 0) & (cur - jb < N_LOCAL_FORCED))
    score = jnp.where(valid[None, :, None, :], imp + jnp.where(forced, FORCE_BONUS, 0.0)[None, :, None, :], NEG)
    n_top = min(SEL_TOPN, ns)
    top_val, top_idx = lax.top_k(score, n_top)
    top_ok = top_val > NEG / 2
    bi = jnp.arange(b)[:, None, None, None]
    hi = jnp.arange(KV_HEADS)[None, None, :, None]
    k_g = k_sel_blk.transpose(0, 3, 1, 2, 4)[bi, hi, top_idx]
    v_g = v_sel_blk.transpose(0, 3, 1, 2, 4)[bi, hi, top_idx]
    tok_pos = top_idx[..., None] * SEL_BLOCK + jnp.arange(SEL_BLOCK)
    m_sel = (top_ok[..., None] & (tok_pos <= q_pos[None, :, None, None, None]))
    m_sel = m_sel.reshape(b, nq, KV_HEADS, 1, n_top * SEL_BLOCK)
    s_sel = jnp.einsum('bqkgd,bqknld->bqkgnl', qs, k_g) * scale
    p_sel = masked_softmax(s_sel.reshape(b, nq, KV_HEADS, GQA, n_top * SEL_BLOCK), m_sel)
    p_sel = p_sel.reshape(b, nq, KV_HEADS, GQA, n_top, SEL_BLOCK).astype(v_g.dtype)
    o_sel = jnp.einsum('bqkgnl,bqknld->bqkgd', p_sel, v_g)
    dlt = q_pos[:, None] - win_pos[None, :]
    m_win = ((dlt >= 0) & (dlt <= WINDOW) & (win_pos[None, :] >= 0))[None, :, None, None, :]
    p_win = masked_softmax(jnp.einsum('bqkgd,bwkd->bqkgw', qs, k_win) * scale, m_win)
    o_win = jnp.einsum('bqkgw,bwkd->bqkgd', p_win.astype(v_win.dtype), v_win)
    g = gates.reshape(b, nq, KV_HEADS, GQA, 3)
    o = g[..., 0:1] * o_cmp + g[..., 1:2] * o_sel + g[..., 2:3] * o_win
    return o.reshape(b, nq, D_NSA)


def nsa_project(cols, pos):
    b, t = cols.shape[:2]
    q, kc, vc, ks, vs, kw, vw, gl = jnp.split(cols, NSA_SPLITS, axis=-1)
    q = q.reshape(b, t, N_HEADS_NSA, HD_NSA)
    kvh = lambda a: a.reshape(b, t, KV_HEADS, HD_NSA)
    gates = jax.nn.sigmoid(gl).reshape(b, t, N_HEADS_NSA, 3)
    return (q, rope_partial(q, pos), gates, kvh(kc), kvh(vc), rope_partial(kvh(ks), pos), kvh(vs),
            rope_partial(kvh(kw), pos), kvh(vw))


def nsa_prompt(cols, wb, pe_k, w1_k, w2_k, pe_v, w1_v, w2_v):
    b, t = cols.shape[:2]
    q, q_rot, gates, kc, vc, ks, vs, kw, vw = nsa_project(cols, jnp.arange(t))
    k_cmp = compress(kc, pe_k, w1_k, w2_k)
    v_cmp = compress(vc, pe_v, w1_v, w2_v)
    ns = t // SEL_BLOCK
    k_sel = ks.reshape(b, ns, SEL_BLOCK, KV_HEADS, HD_NSA)
    v_sel = vs.reshape(b, ns, SEL_BLOCK, KV_HEADS, HD_NSA)
    pad = ((0, 0), (WINDOW, 0), (0, 0), (0, 0))
    kw_pad, vw_pad = jnp.pad(kw, pad), jnp.pad(vw, pad)

    def q_block(i):
        s0 = i * Q_BLOCK
        take = lambda a, n: lax.dynamic_slice_in_dim(a, s0, n, axis=1)
        return nsa_attend(take(q, Q_BLOCK), take(q_rot, Q_BLOCK), take(gates, Q_BLOCK), s0 + jnp.arange(Q_BLOCK),
                          k_cmp, v_cmp, k_sel, v_sel, take(kw_pad, WINDOW + Q_BLOCK), take(vw_pad, WINDOW + Q_BLOCK),
                          s0 - WINDOW + jnp.arange(WINDOW + Q_BLOCK))

    o = lax.map(q_block, jnp.arange(t // Q_BLOCK))
    o = jnp.moveaxis(o, 0, 1).reshape(b, t, D_NSA)
    kv_rows = jnp.stack([kc, vc, ks, vs], axis=2)
    win = jnp.pad(jnp.stack([kw, vw], axis=2), ((0, 0), (wb, 0), (0, 0), (0, 0), (0, 0)))[:, -wb:]
    return o, kv_rows, win


def nsa_sample(cols, cache, page_table, win_state, pe_k, w1_k, w2_k, pe_v, w1_v, w2_v):
    b, sn = cols.shape[:2]
    past_len = page_table.shape[1] * cache.shape[1]
    pos = past_len + jnp.arange(sn)
    q, q_rot, gates, kc, vc, ks, vs, kw, vw = nsa_project(cols, pos)

    def full(c, new):
        past = cache[page_table, :, c].reshape(b, past_len, KV_HEADS, HD_NSA)
        return jnp.concatenate([past, new.astype(past.dtype)], axis=1)

    t = past_len + sn
    k_cmp = compress(full(0, kc), pe_k, w1_k, w2_k)
    v_cmp = compress(full(1, vc), pe_v, w1_v, w2_v)
    t_pad = -(-t // SEL_BLOCK) * SEL_BLOCK
    blocks = lambda a: jnp.pad(a, ((0, 0), (0, t_pad - t), (0, 0), (0, 0))).reshape(
        b, t_pad // SEL_BLOCK, SEL_BLOCK, KV_HEADS, HD_NSA)
    k_sel = blocks(full(2, ks))
    v_sel = blocks(full(3, vs))
    wb = win_state.shape[1]
    win_all = jnp.concatenate([win_state, jnp.stack([kw, vw], axis=2).astype(win_state.dtype)], axis=1)
    win_pos = past_len - wb + jnp.arange(wb + sn)
    o = nsa_attend(q, q_rot, gates, pos, k_cmp, v_cmp, k_sel, v_sel, win_all[:, :, 0], win_all[:, :, 1], win_pos)
    return o, jnp.stack([kc, vc, ks, vs], axis=2), win_all[:, -wb:]


def rwkv_mix(cols, shift_prev, wkv_prev, mu, w0, w2, a0, a2, g2, k_k, k_a, r_k, gn_w, gn_b):
    f32 = jnp.float32
    b, t = cols.shape[:2]
    prev = jnp.concatenate([shift_prev.astype(cols.dtype), cols[:, :-1]], axis=1)
    xs = cols + (prev - cols) * mu
    r, k, v, wd, ad, gd = jnp.split(xs, RWKV_SPLITS, axis=-1)
    w_log = -jax.nn.softplus(-(w0 + jnp.tanh(wd) @ w2).astype(f32)) - 0.5
    decay = jnp.exp(-jnp.exp(w_log))
    a = jax.nn.sigmoid((a0 + ad @ a2).astype(f32))
    g = jax.nn.sigmoid(gd) @ g2
    heads = lambda z: z.astype(f32).reshape(b, t, N_HEADS_RWKV, HS)
    kk = heads(k * k_k)
    kk = kk / jnp.maximum(jnp.sqrt(jnp.sum(kk * kk, axis=-1, keepdims=True)), 1e-12)
    k_mod = k.astype(f32) * (1.0 + (a - 1.0) * k_a)
    rh, kh, vh, ah, dh = heads(r), heads(k_mod), heads(v), heads(a), heads(decay)

    def step(state, inp):
        r_t, d_t, k_t, v_t, kk_t, a_t = inp
        sa = jnp.einsum('bhij,bhj->bhi', state, -kk_t)
        state = (state * d_t[:, :, None, :] + sa[..., None] * (kk_t * a_t)[:, :, None, :]
                 + v_t[..., None] * k_t[:, :, None, :])
        return state, jnp.einsum('bhij,bhj->bhi', state, r_t)

    seq_major = lambda z: jnp.swapaxes(z, 0, 1)
    wkv, y = lax.scan(step, wkv_prev.astype(f32), tuple(seq_major(z) for z in (rh, dh, kh, vh, kk, ah)))
    y = seq_major(y)
    mean = jnp.mean(y, axis=-1, keepdims=True)
    var = jnp.mean(jnp.square(y - mean), axis=-1, keepdims=True)
    y = ((y - mean) * lax.rsqrt(var + GN_EPS)).reshape(b, t, D_RWKV) * gn_w + gn_b
    bonus = (jnp.sum(rh * kh * r_k, axis=-1, keepdims=True) * vh).reshape(b, t, D_RWKV)
    return ((y + bonus) * g).astype(cols.dtype), wkv, cols[:, -1:]


def mix_sublayer(h, attn_fn, shift0, wkv0, g_pre, w_in, rw_w, w_out, g_post):
    p = rms_norm(h, g_pre) @ w_in
    o_attn, kv_rows, win = attn_fn(p[..., :NSA_COLS])
    o_rwkv, wkv, shift = rwkv_mix(p[..., NSA_COLS:], shift0, wkv0, *rw_w)
    mixed = jnp.concatenate([o_attn.astype(h.dtype), o_rwkv], axis=-1) @ w_out
    return h + rms_norm(mixed, g_post), kv_rows, win, wkv, shift


def setup_inputs(seed: int = 0) -> dict:
    key = jax.random.key(seed)
    keys = iter(jax.random.split(key, 64))
    nrm = lambda shape, scale: jax.random.normal(next(keys), shape, jnp.float32) * scale
    uni = lambda shape, lo, hi: jax.random.uniform(next(keys), shape, jnp.float32, lo, hi)
    gain = lambda: 1.0 + nrm((DEPTH, D_MODEL), 0.05)
    n_pages = PAST_LEN // PAGE_SIZE
    n_phys = (5 * DEC_BATCH * n_pages + 3) // 4
    wb = min(WINDOW, PAST_LEN)
    page_table = jax.random.permutation(next(keys), n_phys)[:DEC_BATCH * n_pages].reshape(
        DEC_BATCH, n_pages).astype(jnp.int32)
    return {
        'x_prompt': nrm((BATCH, SEQ, D_MODEL), 1.0),
        'x_sample': nrm((DEC_BATCH, DEC_SEQ, D_MODEL), 1.0),
        'cache_nsa': nrm((DEPTH, n_phys, PAGE_SIZE, 4, KV_HEADS, HD_NSA), 1.0),
        'page_table': page_table,
        'state_win': nrm((DEPTH, DEC_BATCH, wb, 2, KV_HEADS, HD_NSA), 1.0),
        'state_wkv': nrm((DEPTH, DEC_BATCH, N_HEADS_RWKV, HS, HS), 0.5),
        'state_shift': nrm((DEPTH, DEC_BATCH, 1, RWKV_COLS), 1.0),
        'norm_f1_pre': gain(),
        'norm_f1_post': gain(),
        'ffn1_gu': nrm((DEPTH, D_MODEL, 2 * D_FF), D_MODEL ** -0.5),
        'ffn1_dn': nrm((DEPTH, D_FF, D_MODEL), D_FF ** -0.5),
        'norm_mix_pre': gain(),
        'w_in': nrm((DEPTH, D_MODEL, IN_COLS), D_MODEL ** -0.5),
        'cmp_pe_k': nrm((DEPTH, CMP_BLOCK, HD_NSA), 0.1),
        'cmp_w1_k': nrm((DEPTH, CMP_BLOCK, HD_NSA, CMP_HIDDEN), (CMP_BLOCK * HD_NSA) ** -0.5),
        'cmp_w2_k': nrm((DEPTH, CMP_HIDDEN, HD_NSA), CMP_HIDDEN ** -0.5),
        'cmp_pe_v': nrm((DEPTH, CMP_BLOCK, HD_NSA), 0.1),
        'cmp_w1_v': nrm((DEPTH, CMP_BLOCK, HD_NSA, CMP_HIDDEN), (CMP_BLOCK * HD_NSA) ** -0.5),
        'cmp_w2_v': nrm((DEPTH, CMP_HIDDEN, HD_NSA), CMP_HIDDEN ** -0.5),
        'rw_mu': uni((DEPTH, RWKV_COLS), 0.0, 1.0),
        'rw_w0': uni((DEPTH, D_RWKV), -5.0, 1.0),
        'rw_w2': nrm((DEPTH, LORA_W, D_RWKV), 0.5 * LORA_W ** -0.5),
        'rw_a0': nrm((DEPTH, D_RWKV), 0.5),
        'rw_a2': nrm((DEPTH, LORA_A, D_RWKV), 0.5 * LORA_A ** -0.5),
        'rw_g2': nrm((DEPTH, LORA_G, D_RWKV), LORA_G ** -0.5),
        'rw_kk': 0.85 + nrm((DEPTH, D_RWKV), 0.05),
        'rw_ka': 1.0 + nrm((DEPTH, D_RWKV), 0.05),
        'rw_rk': nrm((DEPTH, N_HEADS_RWKV, HS), 0.1),
        'rw_gn_w': 1.0 + nrm((DEPTH, D_RWKV), 0.05),
        'rw_gn_b': nrm((DEPTH, D_RWKV), 0.02),
        'w_out': nrm((DEPTH, D_NSA + D_RWKV, D_MODEL), (D_NSA + D_RWKV) ** -0.5),
        'norm_mix_post': gain(),
        'norm_f2_pre': gain(),
        'ffn2_gu': nrm((DEPTH, D_MODEL, 2 * D_FF), D_MODEL ** -0.5),
        'ffn2_dn': nrm((DEPTH, D_FF, D_MODEL), D_FF ** -0.5),
        'norm_f2_post': gain(),
    }


def reference(x_prompt, x_sample, cache_nsa, page_table, state_win, state_wkv, state_shift,
              norm_f1_pre, norm_f1_post, ffn1_gu, ffn1_dn, norm_mix_pre, w_in,
              cmp_pe_k, cmp_w1_k, cmp_w2_k, cmp_pe_v, cmp_w1_v, cmp_w2_v,
              rw_mu, rw_w0, rw_w2, rw_a0, rw_a2, rw_g2, rw_kk, rw_ka, rw_rk, rw_gn_w, rw_gn_b,
              w_out, norm_mix_post, norm_f2_pre, ffn2_gu, ffn2_dn, norm_f2_post):
    bp = x_prompt.shape[0]
    wb = state_win.shape[2]
    yp, ys = x_prompt, x_sample
    kvp, kvs, winp, wins, wkvp, wkvs, shp, shs = [], [], [], [], [], [], [], []
    for l in range(DEPTH):
        cmp_w = (cmp_pe_k[l], cmp_w1_k[l], cmp_w2_k[l], cmp_pe_v[l], cmp_w1_v[l], cmp_w2_v[l])
        rw_w = (rw_mu[l], rw_w0[l], rw_w2[l], rw_a0[l], rw_a2[l], rw_g2[l], rw_kk[l], rw_ka[l], rw_rk[l],
                rw_gn_w[l], rw_gn_b[l])
        hp = ffn_half(yp, norm_f1_pre[l], ffn1_gu[l], ffn1_dn[l], norm_f1_post[l])
        hp, kv_p, win_p, wkv_p, sh_p = mix_sublayer(
            hp, lambda c: nsa_prompt(c, wb, *cmp_w),
            jnp.zeros((bp, 1, RWKV_COLS), hp.dtype), jnp.zeros((bp, N_HEADS_RWKV, HS, HS), jnp.float32),
            norm_mix_pre[l], w_in[l], rw_w, w_out[l], norm_mix_post[l])
        yp = ffn_half(hp, norm_f2_pre[l], ffn2_gu[l], ffn2_dn[l], norm_f2_post[l])
        hs = ffn_half(ys, norm_f1_pre[l], ffn1_gu[l], ffn1_dn[l], norm_f1_post[l])
        hs, kv_s, win_s, wkv_s, sh_s = mix_sublayer(
            hs, lambda c: nsa_sample(c, cache_nsa[l], page_table, state_win[l], *cmp_w),
            state_shift[l], state_wkv[l],
            norm_mix_pre[l], w_in[l], rw_w, w_out[l], norm_mix_post[l])
        ys = ffn_half(hs, norm_f2_pre[l], ffn2_gu[l], ffn2_dn[l], norm_f2_post[l])
        kvp.append(kv_p); kvs.append(kv_s); winp.append(win_p); wins.append(win_s)
        wkvp.append(wkv_p); wkvs.append(wkv_s); shp.append(sh_p); shs.append(sh_s)
    return (yp, ys, jnp.stack(kvp), jnp.stack(kvs), jnp.stack(winp), jnp.stack(wins),
            jnp.stack(wkvp), jnp.stack(wkvs), jnp.stack(shp), jnp.stack(shs))
```

```cpp
#include <hip/hip_runtime.h>
#include <cstdio>
#include <cstdint>

#ifndef MK_N_LAUNCHES
#define MK_N_LAUNCHES 1
#endif

constexpr int DM = 2048, SEQ = 4096, NPR = 8192, NSM = 128, NR = NPR + NSM  , MP = 8448  ;
constexpr int DFF = 5632, NGU = 2 * DFF, NIN = 5968, NINP = 6144, NSAC = 2608, RWC = 3360;
constexpr int PAST = 2048, NPAGES = 16, PAGE = 128;
constexpr int NCP = 255  , NCS = 127  ;
constexpr float RMS_EPS = 1e-6f, GN_EPS = 64e-5f, NEGV = -1e30f;

constexpr size_t O_Y = 0, O_KV = 17039360, O_WINP = 25559040, O_WINS = 26083328, O_WKVP = 59637760, O_WKVS = 59768832, O_SHP = 68157440, O_SHS = 68164160, O_END = 68594240;

constexpr size_t al256(size_t x) { return (x + 255) & ~(size_t)255; }
constexpr size_t WS_CTL = 0, CTL_BYTES = 65536;
constexpr size_t WS_WGU1 = al256(WS_CTL + CTL_BYTES);
constexpr size_t WS_WDN1 = al256(WS_WGU1 + (size_t)NGU * DM * 2);
constexpr size_t WS_WIN  = al256(WS_WDN1 + (size_t)DM * DFF * 2);
constexpr size_t WS_WOUT = al256(WS_WIN + (size_t)NINP * DM * 2);
constexpr size_t WS_WGU2 = al256(WS_WOUT + (size_t)DM * DM * 2);
constexpr size_t WS_WDN2 = al256(WS_WGU2 + (size_t)NGU * DM * 2);
constexpr size_t WS_A1   = al256(WS_WDN2 + (size_t)DM * DFF * 2);
constexpr size_t WS_A2   = al256(WS_A1 + (size_t)MP * DM * 2);
constexpr size_t WS_A3   = al256(WS_A2 + (size_t)MP * DM * 2);
constexpr size_t WS_AMIX = al256(WS_A3 + (size_t)MP * DM * 2);
constexpr size_t WS_ACT  = al256(WS_AMIX + (size_t)MP * DM * 2);
constexpr size_t WS_O    = al256(WS_ACT + (size_t)MP * DFF * 2);
constexpr size_t WS_H1   = al256(WS_O + (size_t)MP * DM * 4);
constexpr size_t WS_H2   = al256(WS_H1 + (size_t)NR * DM * 4);
constexpr size_t WS_COLS = al256(WS_H2 + (size_t)NR * DM * 4);
constexpr size_t WS_QRAW = al256(WS_COLS + (size_t)MP * NINP * 4);
constexpr size_t WS_QROT = al256(WS_QRAW + (size_t)NR * 1024 * 4);
constexpr size_t WS_KW   = al256(WS_QROT + (size_t)NR * 1024 * 4);
constexpr size_t WS_GATE = al256(WS_KW + (size_t)NR * 512 * 4);
constexpr size_t WS_RW   = al256(WS_GATE + (size_t)NR * 48 * 4);
constexpr size_t WS_V    = al256(WS_RW + (size_t)NR * 5 * 1024 * 4);
constexpr size_t WS_G    = al256(WS_V + (size_t)NR * 1024 * 4);
constexpr size_t WS_Y    = al256(WS_G + (size_t)NR * 1024 * 4);
constexpr size_t WS_BON  = al256(WS_Y + (size_t)NR * 1024 * 4);
constexpr size_t WS_KCP  = al256(WS_BON + (size_t)NR * 16 * 4);
constexpr size_t WS_VCP  = al256(WS_KCP + (size_t)2 * 256 * 256 * 4);
constexpr size_t WS_KCS  = al256(WS_VCP + (size_t)2 * 256 * 256 * 4);
constexpr size_t WS_VCS  = al256(WS_KCS + (size_t)128 * 128 * 256 * 4);
constexpr size_t WS_ROPE = al256(WS_VCS + (size_t)128 * 128 * 256 * 4);
constexpr size_t WS_END  = al256(WS_ROPE + (size_t)4096 * 16 * 4);

constexpr int CW_BAR = 0;
constexpr int CW_QATT = 4096;
constexpr int CW_QMISC = 4160;

constexpr int NTHREADS = 512, NWAVES = 8;
constexpr int LDS_BYTES = 147456;
constexpr int LDS_MISC = 131072;

typedef unsigned short bf16_t;
__device__ __forceinline__ bf16_t f2bf(float f) { unsigned u = __float_as_uint(f); u += 0x7FFFu + ((u >> 16) & 1u); return (bf16_t)(u >> 16); }
__device__ __forceinline__ unsigned pack2bf(float lo, float hi) { return (unsigned)f2bf(lo) | ((unsigned)f2bf(hi) << 16); }

struct Params {
    const float* in[36];
    float* out;
    unsigned char* ws;
    int ph_lo, ph_hi, pad0, pad1;
};

#define XB_TMO      128
#define XB_XCNT(j)  (256  + 64 * (j))
#define XB_XSUB(j)  (1280 + 64 * (j))
#define XB_XGEN(j)  (2304 + 64 * (j))
#define XB_TOP      3328
#define XB_TOPGEN   3392
#define XCD_BAR_WORDS 3456
#define XB_SPIN_CAP (1u << 18)
#define LAS __attribute__((address_space(3)))

__device__ __forceinline__ unsigned xb_ld(unsigned* p)              { return __hip_atomic_load(p, __ATOMIC_RELAXED, __HIP_MEMORY_SCOPE_AGENT); }
__device__ __forceinline__ unsigned xb_add(unsigned* p, unsigned v) { return __hip_atomic_fetch_add(p, v, __ATOMIC_RELAXED, __HIP_MEMORY_SCOPE_AGENT); }
__device__ __forceinline__ unsigned xb_xcc_id() { return (unsigned)__builtin_amdgcn_s_getreg((3 << 11) | 20) & 0xFu; }
#define XB_SPIN(cond, bar) do { unsigned _sp = 0; while (cond) { __builtin_amdgcn_s_sleep(1); \
    if ((++_sp & 255u) == 0u) { if (xb_ld(&(bar)[XB_TMO])) break; if (_sp > XB_SPIN_CAP) { atomicAdd(&(bar)[XB_TMO], 1u); break; } } } } while (0)

struct XcdBarrier {
    unsigned* bar; unsigned x;
    volatile LAS unsigned* st;
};

__device__ __forceinline__ XcdBarrier xcd_barrier_post(unsigned* bar, volatile LAS unsigned* st) {
    XcdBarrier b; b.bar = bar; b.x = xb_xcc_id(); b.st = st;
    if (threadIdx.x == 0) (void)xb_add(&bar[XB_XCNT(b.x)], 1u);
    return b;
}
__device__ __forceinline__ void xcd_barrier_complete(unsigned* bar, unsigned x, unsigned& nloc, unsigned& nx) {
    const unsigned G = gridDim.x * gridDim.y * gridDim.z;
    unsigned sum, cnt, mine, sp = 0u;
    for (;;) {
        sum = 0u; cnt = 0u; mine = 0u;
#pragma unroll
        for (unsigned j = 0; j < 16; ++j) { const unsigned c = xb_ld(&bar[XB_XCNT(j)]); sum += c; cnt += (c > 0u) ? 1u : 0u; mine = (j == x) ? c : mine; }
        if (sum == G) break;
        __builtin_amdgcn_s_sleep(1);
        if ((++sp & 255u) == 0u) { if (xb_ld(&bar[XB_TMO])) break; if (sp > XB_SPIN_CAP) { atomicAdd(&bar[XB_TMO], 1u); break; } }
    }
    nloc = mine > 0u ? mine : 1u; nx = cnt > 0u ? cnt : 1u;
}

__device__ __forceinline__ void xcd_barrier(const XcdBarrier& b) {
    asm volatile("s_waitcnt vmcnt(0)" ::: "memory");
    __syncthreads();
    if (threadIdx.x == 0) {
        unsigned* bar = b.bar;
        __builtin_amdgcn_s_waitcnt(0);
        unsigned nloc = b.st[0], nx = b.st[1];
        if (nloc == 0u) { xcd_barrier_complete(bar, b.x, nloc, nx); b.st[0] = nloc; b.st[1] = nx; }
        const unsigned old = xb_add(&bar[XB_XSUB(b.x)], 1u);
        const unsigned gen = old / nloc;
        if (old + 1u == (gen + 1u) * nloc) {
            __builtin_amdgcn_fence(__ATOMIC_RELEASE, "agent");
            asm volatile("s_waitcnt vmcnt(0)" ::: "memory");
            const unsigned og = xb_add(&bar[XB_TOP], 1u);
            const unsigned tg = og / nx;
            if (og + 1u == (tg + 1u) * nx) xb_add(&bar[XB_TOPGEN], 1u);
            else XB_SPIN(xb_ld(&bar[XB_TOPGEN]) == tg, bar);
            __builtin_amdgcn_fence(__ATOMIC_ACQUIRE, "agent");
            xb_add(&bar[XB_XGEN(b.x)], 1u);
            asm volatile("s_waitcnt vmcnt(0)" ::: "memory");
        } else {
            XB_SPIN(xb_ld(&bar[XB_XGEN(b.x)]) == gen, bar);
            __builtin_amdgcn_fence(__ATOMIC_ACQUIRE, "agent");
            asm volatile("s_waitcnt vmcnt(0)" ::: "memory");
        }
    }
    __syncthreads();
}
namespace pg8 {
#define PG8_LAS __attribute__((address_space(3)))
typedef unsigned short bf16_t;
typedef short bf16x8 __attribute__((ext_vector_type(8)));
typedef float f32x4 __attribute__((ext_vector_type(4)));
typedef unsigned u32x4 __attribute__((ext_vector_type(4)));
constexpr int BM = 256, BK = 64, HALF = 128, HTB = HALF * BK * 2  , STAGE_BYTES = 8 * HTB, NXCD = 8, WGM = 8;

__host__ __device__ __forceinline__ int lds_byte(int r, int c) { const int st = (r >> 4) * 2 + (c >> 5), rr = r & 15, cc = c & 31, ob = rr * 64 + cc * 2; return st * 1024 + (ob ^ (((ob >> 9) & 1) << 5)); }
__host__ __device__ __forceinline__ void stage_rc(int b, int& R, int& C) { const int st = b / 1024, sb = b % 1024, swz = sb ^ (((sb >> 9) & 1) << 5); R = (st >> 1) * 16 + swz / 64; C = (st & 1) * 32 + (swz % 64) / 2; }
__host__ __device__ __forceinline__ int perm32(int rho) { const int n = rho >> 4, i = rho & 15; return 8 * (i >> 2) + 4 * n + (i & 3); }

struct Unit { int pm, pn; };
struct Gemm { const bf16_t* A; const bf16_t* Bt; int M, N, K; };

struct StaticOrder {
    int nM, nN, nwg, G, c;
    __host__ __device__ void init(int M, int N, int G_, int c_) { nM = M / BM; nN = N / BM; nwg = nM * nN; G = G_; c = c_; }
    __host__ __device__ bool next(int i, Unit& u) const {
        const long L = (long)i * G + c; if (L >= nwg) return false;
        int wgid = (int)L; { const int q = nwg / NXCD, r = nwg % NXCD, xcd = wgid % NXCD, off = wgid / NXCD; wgid = (xcd < r ? xcd * (q + 1) : r * (q + 1) + (xcd - r) * q) + off; }
        const int nig = WGM * nN, gid = wgid / nig, fm = gid * WGM, gsz = (nM - fm) < WGM ? (nM - fm) : WGM;
        u.pm = fm + ((wgid % nig) % gsz); u.pn = (wgid % nig) / gsz; return true;
    }
    __device__ __forceinline__ void a_ready(const Unit&) const {}
    __device__ __forceinline__ void done(const Unit&) const {}
};
__device__ __forceinline__ unsigned cvt_pk_bf16(float lo, float hi) { unsigned r; asm volatile("v_cvt_pk_bf16_f32 %0, %1, %2" : "=v"(r) : "v"(lo), "v"(hi)); return r; }
typedef float f32x2 __attribute__((ext_vector_type(2)));
__device__ __forceinline__ f32x2 gelu_pk(f32x2 v) {
    const f32x2 av = __builtin_elementwise_abs(v), d = av * 0.2316418882f + 1.0f;
    f32x2 t; t.x = __builtin_amdgcn_rcpf(d.x); t.y = __builtin_amdgcn_rcpf(d.y);
    f32x2 q = t * 0.5307027145f + (-0.7265760135f); q = q * t + 0.7107068705f; q = q * t + (-0.142248368f); q = q * t + 0.127414796f; q = q * t;
    const f32x2 s = (v * v) * (-0.72134752044f);
    f32x2 e; e.x = __builtin_amdgcn_exp2f(s.x); e.y = __builtin_amdgcn_exp2f(s.y);
    const f32x2 m = v * (q * e), r = v - m;
    f32x2 o; o.x = v.x < 0.f ? m.x : r.x; o.y = v.y < 0.f ? m.y : r.y; return o;
}

struct EpiF32 {
    static constexpr bool PERM = false, AFTER_DRAIN = false;
    float* C; int ldc; const float* bias;
    __device__ __forceinline__ void operator()(const f32x4 (&acc)[2][2][4][2], const Unit& u, int wr, int wc, int fr, int fq) const {
        const int row0 = u.pm * BM + wr * 64 + fr, col0 = u.pn * BM + wc * 32 + 4 * fq;
        f32x4 bv[2][2];
#pragma unroll
        for (int bj = 0; bj < 2; ++bj)
#pragma unroll
            for (int n = 0; n < 2; ++n) bv[bj][n] = bias ? *(const f32x4*)(bias + col0 + bj * HALF + n * 16) : (f32x4){0.f, 0.f, 0.f, 0.f};
#pragma unroll
        for (int ai = 0; ai < 2; ++ai)
#pragma unroll
            for (int m = 0; m < 4; ++m) { float* rowp = C + (size_t)(row0 + ai * HALF + m * 16) * ldc + col0;
#pragma unroll
                for (int bj = 0; bj < 2; ++bj)
#pragma unroll
                    for (int n = 0; n < 2; ++n) *(f32x4*)(rowp + bj * HALF + n * 16) = acc[ai][bj][m][n] + bv[bj][n]; }
    }
};
template <class Epi, class Sched, bool STAMP = false>
__device__ __forceinline__ void gemm_phase(PG8_LAS unsigned char* lds, const Gemm g, const Sched& S, const Epi& E, unsigned long long* stamps) {
    const int tid = threadIdx.x, wid = __builtin_amdgcn_readfirstlane(tid >> 6), lane = tid & 63, wr = wid >> 2, wc = wid & 3, fr = lane & 15, fq = lane >> 4;
    const int K = g.K, nt = K / BK;
    int ts_lo = 0, ts_hi = 0, nts = 0; const unsigned long long rt_entry = STAMP ? (unsigned long long)wall_clock64() : 0ull;
#define PG8_STAMP() do { if (STAMP && wid == 0 && nts < 64) { const unsigned long long _c = (unsigned long long)clock64(); \
        ts_lo = (lane == nts) ? (int)(unsigned)_c : ts_lo; ts_hi = (lane == nts) ? (int)(unsigned)(_c >> 32) : ts_hi; ++nts; } } while (0)
    PG8_STAMP();
    unsigned voffA[2], voffB[2];
#pragma unroll
    for (int i = 0; i < 2; ++i) { int R, C; stage_rc(tid * 16 + i * 8192, R, C); const int Rb = Epi::PERM ? ((R & ~31) + perm32(R & 31)) : R;
        voffA[i] = (unsigned)(R * K + C) * 2u; voffB[i] = (unsigned)(Rb * K + C) * 2u; }
    const size_t kstep = (size_t)(BK * 2);
    const size_t hstep = (size_t)HALF * K * 2;
    const size_t tstep = 2 * hstep;
    const unsigned ldsw = (unsigned)wid * 1024u;
    const int aoff = lds_byte(wr * 64 + fr, fq * 8), boff = lds_byte(wc * 32 + fr, fq * 8);
#define PG8_SA(b, h) (((b) * 2 + (h)) * HTB)
#define PG8_SB(b, h) ((4 + (b) * 2 + (h)) * HTB)
#define PG8_STAGE(bufoff, gbase, voff) do { _Pragma("unroll") for (int _i = 0; _i < 2; ++_i) \
        __builtin_amdgcn_global_load_lds((const unsigned*)((const char*)(gbase) + (voff)[_i]), (PG8_LAS unsigned*)(lds + (bufoff) + ldsw + _i * 8192), 16, 0, 0); } while (0)
#define PG8_LDA(dst, b, h) do { _Pragma("unroll") for (int m = 0; m < 4; ++m) _Pragma("unroll") for (int k = 0; k < 2; ++k) dst[m][k] = *(const PG8_LAS bf16x8*)(lds + PG8_SA(b, h) + aoff + m * 2048 + k * 1024); } while (0)
#define PG8_LDB(dst, b, h) do { _Pragma("unroll") for (int n = 0; n < 2; ++n) _Pragma("unroll") for (int k = 0; k < 2; ++k) dst[n][k] = *(const PG8_LAS bf16x8*)(lds + PG8_SB(b, h) + boff + n * 2048 + k * 1024); } while (0)
#define PG8_MMA(ai, bj, At, Bt) do { __builtin_amdgcn_s_setprio(1); _Pragma("unroll") for (int m = 0; m < 4; ++m) _Pragma("unroll") for (int n = 0; n < 2; ++n) _Pragma("unroll") for (int k = 0; k < 2; ++k) \
        acc[ai][bj][m][n] = __builtin_amdgcn_mfma_f32_16x16x32_bf16(Bt[n][k], At[m][k], acc[ai][bj][m][n], 0, 0, 0); __builtin_amdgcn_s_setprio(0); } while (0)
#define PG8_WAIT_V(n) asm volatile("s_waitcnt vmcnt(" #n ")" ::: "memory")
#define PG8_WAIT_L(n) asm volatile("s_waitcnt lgkmcnt(" #n ")" ::: "memory")
#define PG8_BAR __builtin_amdgcn_s_barrier()
#define PG8_SCHED __builtin_amdgcn_sched_barrier(0)
    Unit cur, nxt; int ui = 0;
    if (!S.next(0, cur)) return;
    f32x4 acc[2][2][4][2];
#pragma unroll
    for (int a = 0; a < 2; ++a)
#pragma unroll
        for (int b = 0; b < 2; ++b)
#pragma unroll
            for (int m = 0; m < 4; ++m)
#pragma unroll
                for (int n = 0; n < 2; ++n) acc[a][b][m][n] = (f32x4){0.f, 0.f, 0.f, 0.f};
    bf16x8 At[4][2], B0[2][2], B1[2][2];
    const char* cA = (const char*)g.A + (size_t)cur.pm * tstep; const char* cB = (const char*)g.Bt + (size_t)cur.pn * tstep;
    S.a_ready(cur);
    PG8_STAGE(PG8_SB(0, 0), cB, voffB); PG8_STAGE(PG8_SA(0, 0), cA, voffA); PG8_STAGE(PG8_SB(0, 1), cB + hstep, voffB); PG8_STAGE(PG8_SA(0, 1), cA + hstep, voffA);
    if (wr == 1) PG8_BAR;
    PG8_WAIT_V(4); PG8_BAR;
    PG8_STAGE(PG8_SB(1, 0), cB + kstep, voffB); PG8_STAGE(PG8_SA(1, 0), cA + kstep, voffA); PG8_STAGE(PG8_SB(1, 1), cB + hstep + kstep, voffB);
    PG8_WAIT_V(6); PG8_BAR;
    PG8_STAMP();
    for (;;) {
        const bool has_next = S.next(ui + 1, nxt);
        const char* nA = has_next ? (const char*)g.A + (size_t)nxt.pm * tstep : cA; const char* nB = has_next ? (const char*)g.Bt + (size_t)nxt.pn * tstep : cB;
        for (int t = 0; t < nt; t += 2) {
            const bool last = (t == nt - 2);
            const char* a1 = cA + (size_t)(t + 1) * kstep;
            const char* a2 = last ? nA : cA + (size_t)(t + 2) * kstep; const char* b2 = last ? nB : cB + (size_t)(t + 2) * kstep;
            const char* a3 = a2 + kstep; const char* b3 = b2 + kstep;
            if (last && has_next) S.a_ready(nxt);
            PG8_LDB(B0, 0, 0); PG8_SCHED; PG8_LDA(At, 0, 0); PG8_STAGE(PG8_SA(1, 1), a1 + hstep, voffA);
            PG8_WAIT_L(8); PG8_BAR; PG8_WAIT_L(0); PG8_MMA(0, 0, At, B0); PG8_BAR; PG8_SCHED;
            PG8_LDB(B1, 0, 1); PG8_STAGE(PG8_SB(0, 0), b2, voffB);
            PG8_BAR; PG8_WAIT_L(0); PG8_MMA(0, 1, At, B1); PG8_BAR;
            PG8_LDA(At, 0, 1); PG8_STAGE(PG8_SA(0, 0), a2, voffA);
            PG8_BAR; PG8_WAIT_L(0); PG8_MMA(1, 0, At, B0); PG8_BAR; PG8_SCHED;
            PG8_STAGE(PG8_SB(0, 1), b2 + hstep, voffB);
            PG8_WAIT_V(6); PG8_BAR; PG8_MMA(1, 1, At, B1); PG8_BAR;
            PG8_LDB(B0, 1, 0); PG8_SCHED; PG8_LDA(At, 1, 0); PG8_STAGE(PG8_SA(0, 1), a2 + hstep, voffA);
            PG8_WAIT_L(8); PG8_BAR; PG8_WAIT_L(0); PG8_MMA(0, 0, At, B0); PG8_BAR; PG8_SCHED;
            PG8_LDB(B1, 1, 1); PG8_STAGE(PG8_SB(1, 0), b3, voffB);
            PG8_BAR; PG8_WAIT_L(0); PG8_MMA(0, 1, At, B1); PG8_BAR;
            PG8_LDA(At, 1, 1); PG8_STAGE(PG8_SA(1, 0), a3, voffA);
            PG8_BAR; PG8_WAIT_L(0); PG8_MMA(1, 0, At, B0); PG8_BAR; PG8_SCHED;
            PG8_STAGE(PG8_SB(1, 1), b3 + hstep, voffB);
            PG8_WAIT_V(6); PG8_BAR; PG8_MMA(1, 1, At, B1); PG8_BAR;
        }
        PG8_STAMP();
        if constexpr (!Epi::AFTER_DRAIN) { E(acc, cur, wr, wc, fr, fq); S.done(cur); }
        PG8_STAMP();
        if (!has_next) break;
#pragma unroll
        for (int a = 0; a < 2; ++a)
#pragma unroll
            for (int b = 0; b < 2; ++b)
#pragma unroll
                for (int m = 0; m < 4; ++m)
#pragma unroll
                    for (int n = 0; n < 2; ++n) acc[a][b][m][n] = (f32x4){0.f, 0.f, 0.f, 0.f};
        cur = nxt; cA = nA; cB = nB; ++ui;
    }
    PG8_WAIT_V(0);
    if (wr == 0) PG8_BAR;
    PG8_BAR;
    if constexpr (Epi::AFTER_DRAIN) { E.fused(acc, cur, wr, wc, fr, fq, lds, wid, lane); S.done(cur); }
    PG8_STAMP();
    if (STAMP && wid == 0) { stamps[lane] = lane < nts ? (((unsigned long long)(unsigned)ts_hi << 32) | (unsigned)ts_lo) : 0ull;
        if (lane == 62) stamps[62] = rt_entry; if (lane == 63) stamps[63] = (unsigned long long)wall_clock64(); }
#undef PG8_STAMP
#undef PG8_SA
#undef PG8_SB
#undef PG8_STAGE
#undef PG8_LDA
#undef PG8_LDB
#undef PG8_MMA
#undef PG8_WAIT_V
#undef PG8_WAIT_L
#undef PG8_BAR
#undef PG8_SCHED
}

struct EpiSwiGLU {
    static constexpr bool PERM = true, AFTER_DRAIN = false;
    bf16_t* O; int ldc;
    __device__ __forceinline__ void operator()(const f32x4 (&acc)[2][2][4][2], const Unit& u, int wr, int wc, int fr, int fq) const {
        const int row0 = u.pm * BM + wr * 64 + fr, col0 = u.pn * HALF + wc * 32 + 8 * fq;
#pragma unroll
        for (int ai = 0; ai < 2; ++ai)
#pragma unroll
            for (int m = 0; m < 4; ++m) {
                bf16_t* rowp = O + (size_t)(row0 + ai * HALF + m * 16) * ldc + col0;
                float r[8];
#pragma unroll
                for (int n = 0; n < 2; ++n)
#pragma unroll
                    for (int j = 0; j < 4; ++j) { const float g = acc[ai][0][m][n][j], up = acc[ai][1][m][n][j];
                        r[n * 4 + j] = g * __builtin_amdgcn_rcpf(1.0f + __expf(-g)) * up; }
                u32x4 w; w.x = cvt_pk_bf16(r[0], r[1]); w.y = cvt_pk_bf16(r[2], r[3]); w.z = cvt_pk_bf16(r[4], r[5]); w.w = cvt_pk_bf16(r[6], r[7]);
                *(u32x4*)rowp = w;
            }
    }
};
}

#define WAVE_SYNC() asm volatile("s_waitcnt lgkmcnt(0)" ::: "memory")
__device__ __forceinline__ float wave_sum(float v) {
#pragma unroll
    for (int o = 32; o >= 1; o >>= 1) v += __shfl_xor(v, o);
    return v;
}
__device__ __forceinline__ float wave_max(float v) {
#pragma unroll
    for (int o = 32; o >= 1; o >>= 1) v = fmaxf(v, __shfl_xor(v, o));
    return v;
}
__device__ __forceinline__ float red16(float v) {
#pragma unroll
    for (int o = 8; o >= 1; o >>= 1) v += __shfl_xor(v, o);
    return v;
}
__device__ __forceinline__ float dot4(const float4& a, const float4& b) { return a.x * b.x + a.y * b.y + a.z * b.z + a.w * b.w; }
__device__ __forceinline__ float sigmoidf_(float x) { return 1.0f / (1.0f + __expf(-x)); }
__device__ __forceinline__ float siluf_(float x) { return x / (1.0f + __expf(-x)); }

__constant__ double ROPE_INV[8] = {1.0, 0.19392274474868576, 0.03760603093086393, 0.007292664737217109, 0.001414213562373095, 0.0002742481756762073, 5.318295896944988e-05, 1.031338537721246e-05};

struct Ctx {
    const Params* p;
    unsigned char* ws;
    float* out;
    unsigned char* lds;
    int tid, lane, wave, bid, G;
};
#define WSP(T, off) ((T*)(c.ws + (off)))

__device__ __forceinline__ void transpose_tile(const Ctx& c, const float* src, int ldsrc, int c0, int nvalid, int k0, bf16_t* dst, int K, int n0) {
    float* T = (float*)c.lds;
    const int tid = c.tid;
    { const int k = tid >> 3, c8 = (tid & 7) * 8;
      const float* s = src + (size_t)(k0 + k) * ldsrc + c0 + c8;
#pragma unroll
      for (int j = 0; j < 8; ++j) T[k * 65 + c8 + j] = (c8 + j < nvalid) ? s[j] : 0.0f; }
    __syncthreads();
    { const int kg = tid & 7, n = tid >> 3;
      unsigned w[4];
#pragma unroll
      for (int j = 0; j < 4; ++j) w[j] = pack2bf(T[(kg * 8 + 2 * j) * 65 + n], T[(kg * 8 + 2 * j + 1) * 65 + n]);
      *(uint4*)(dst + (size_t)(n0 + n) * K + k0 + kg * 8) = make_uint4(w[0], w[1], w[2], w[3]); }
    __syncthreads();
}

__device__ __forceinline__ void row_norm_bf16(const float* x, const float* g, bf16_t* a, int lane) {
    float4 v[8]; float ss = 0.f;
#pragma unroll
    for (int i = 0; i < 8; ++i) { v[i] = *(const float4*)(x + (i * 64 + lane) * 4); ss += dot4(v[i], v[i]); }
    ss = wave_sum(ss);
    const float s = rsqrtf(ss * (1.0f / DM) + RMS_EPS);
#pragma unroll
    for (int i = 0; i < 8; ++i) { const float4 gg = *(const float4*)(g + (i * 64 + lane) * 4);
        *(uint2*)(a + (i * 64 + lane) * 4) = make_uint2(pack2bf(v[i].x * s * gg.x, v[i].y * s * gg.y), pack2bf(v[i].z * s * gg.z, v[i].w * s * gg.w)); }
}

__device__ __forceinline__ const float* x_row(const Ctx& c, int row) { return row < NPR ? c.p->in[0] + (size_t)row * DM : c.p->in[1] + (size_t)(row - NPR) * DM; }

__device__ __forceinline__ void p0_prologue(const Ctx& c) {
#pragma unroll 1
    for (int w = 0; w < 2; ++w) {
        const float* src = c.p->in[w == 0 ? 9 : 33]; bf16_t* dst = (bf16_t*)(c.ws + (w == 0 ? WS_WGU1 : WS_WGU2));
        const int nkt = DM / 64, nnt = NGU / 64;
#pragma unroll 1
        for (int t = c.bid; t < nkt * nnt; t += c.G) { const int kt = t % nkt, nt = t / nkt; const int rr = nt * 64;
            const int c0 = ((rr % 256) / 128) * DFF + 128 * (rr / 256) + (rr % 128);
            transpose_tile(c, src, NGU, c0, 64, kt * 64, dst, DM, rr); }
    }
#pragma unroll 1
    for (int w = 0; w < 2; ++w) {
        const float* src = c.p->in[w == 0 ? 10 : 34]; bf16_t* dst = (bf16_t*)(c.ws + (w == 0 ? WS_WDN1 : WS_WDN2));
        const int nkt = DFF / 64, nnt = DM / 64;
#pragma unroll 1
        for (int t = c.bid; t < nkt * nnt; t += c.G) { const int kt = t % nkt, nt = t / nkt;
            transpose_tile(c, src, DM, nt * 64, 64, kt * 64, dst, DFF, nt * 64); }
    }
    {
        const float* src = c.p->in[12]; bf16_t* dst = (bf16_t*)(c.ws + WS_WIN);
        const int nkt = DM / 64, nnt = NINP / 64;
#pragma unroll 1
        for (int t = c.bid; t < nkt * nnt; t += c.G) { const int kt = t % nkt, nt = t / nkt; int nv = NIN - nt * 64; nv = nv < 0 ? 0 : (nv > 64 ? 64 : nv);
            transpose_tile(c, src, NIN, nt * 64, nv, kt * 64, dst, DM, nt * 64); }
    }
    {
        const float* src = c.p->in[30]; bf16_t* dst = (bf16_t*)(c.ws + WS_WOUT);
        const int nkt = DM / 64, nnt = DM / 64;
#pragma unroll 1
        for (int t = c.bid; t < nkt * nnt; t += c.G) { const int kt = t % nkt, nt = t / nkt;
            transpose_tile(c, src, DM, nt * 64, 64, kt * 64, dst, DM, nt * 64); }
    }
#pragma unroll 1
    for (int r = c.bid * NWAVES + c.wave; r < NR; r += c.G * NWAVES)
        row_norm_bf16(x_row(c, r), c.p->in[7], WSP(bf16_t, WS_A1) + (size_t)r * DM, c.lane);
#pragma unroll 1
    for (int e = c.bid * NTHREADS + c.tid; e < 4096 * 8; e += c.G * NTHREADS) {
        const int pos = e >> 3, i = e & 7;
        const double inv = ROPE_INV[i];
        double rev = (double)pos * inv * 0.15915494309189535;
        rev -= floor(rev);
        const float a = (float)(rev * 6.283185307179586);
        float* rt = WSP(float, WS_ROPE) + pos * 16;
        rt[i] = cosf(a); rt[8 + i] = sinf(a);
    }
    {
        const float* sw = c.p->in[4]; float* wo = c.out + O_WINS;
        const size_t per_b = (size_t)511 * 512 / 4;
#pragma unroll 1
        for (size_t e = (size_t)c.bid * NTHREADS + c.tid; e < per_b * NSM; e += (size_t)c.G * NTHREADS) {
            const size_t b = e / per_b, o = e % per_b;
            *(float4*)(wo + b * 512 * 512 + o * 4) = *(const float4*)(sw + b * 512 * 512 + 512 + o * 4);
        }
    }
}

__device__ __forceinline__ void thin_norm(const Ctx& c, const float* O, int base_kind  , const float* gpost, float scale, float* hout, const float* gpre, bf16_t* aout) {
#pragma unroll 1
    for (int r = c.bid * NWAVES + c.wave; r < NR; r += c.G * NWAVES) {
        const float* o = O + (size_t)r * DM;
        const float* bs = base_kind == 0 ? x_row(c, r) : (base_kind == 1 ? WSP(const float, WS_H1) : WSP(const float, WS_H2)) + (size_t)r * DM;
        float4 v[8]; float ss = 0.f;
#pragma unroll
        for (int i = 0; i < 8; ++i) { v[i] = *(const float4*)(o + (i * 64 + c.lane) * 4); ss += dot4(v[i], v[i]); }
        ss = wave_sum(ss);
        const float s = rsqrtf(ss * (1.0f / DM) + RMS_EPS) * scale;
        float s2 = 0.f;
#pragma unroll
        for (int i = 0; i < 8; ++i) { const float4 gg = *(const float4*)(gpost + (i * 64 + c.lane) * 4); const float4 b = *(const float4*)(bs + (i * 64 + c.lane) * 4);
            v[i].x = b.x + v[i].x * s * gg.x; v[i].y = b.y + v[i].y * s * gg.y; v[i].z = b.z + v[i].z * s * gg.z; v[i].w = b.w + v[i].w * s * gg.w;
            *(float4*)(hout + (size_t)r * DM + (i * 64 + c.lane) * 4) = v[i]; s2 += dot4(v[i], v[i]); }
        if (aout) {
            s2 = wave_sum(s2);
            const float q = rsqrtf(s2 * (1.0f / DM) + RMS_EPS);
#pragma unroll
            for (int i = 0; i < 8; ++i) { const float4 gg = *(const float4*)(gpre + (i * 64 + c.lane) * 4);
                *(uint2*)(aout + (size_t)r * DM + (i * 64 + c.lane) * 4) = make_uint2(pack2bf(v[i].x * q * gg.x, v[i].y * q * gg.y), pack2bf(v[i].z * q * gg.z, v[i].w * q * gg.w)); }
        }
    }
}

__device__ __forceinline__ int row_pos(int row) { return row < NPR ? (row & (SEQ - 1)) : PAST; }

__device__ __forceinline__ float rope_elem(const float* h16, const float* cs, int d) {
    return d < 8 ? h16[d] * cs[d] - h16[d + 8] * cs[8 + d] : h16[d] * cs[d - 8] + h16[d - 8] * cs[d];
}

__device__ __forceinline__ void p5a_nsa_prep(const Ctx& c) {
    const float* COLS = WSP(const float, WS_COLS);
    float* QRAW = WSP(float, WS_QRAW); float* QROT = WSP(float, WS_QROT); float* KW = WSP(float, WS_KW); float* GATE = WSP(float, WS_GATE);
    const float* ROPE = WSP(const float, WS_ROPE);
#pragma unroll 1
    for (int row = c.bid; row < NR; row += c.G) {
        const float* cr = COLS + (size_t)row * NINP;
        const int pos = row_pos(row);
        const float* cs = ROPE + pos * 16;
        float* kvo = c.out + O_KV + (size_t)row * 1024;
        for (int e = c.tid; e < 1024; e += NTHREADS) { const int d = e & 63; const float v = cr[e];
            QRAW[(size_t)row * 1024 + e] = v;
            QROT[(size_t)row * 1024 + e] = d < 16 ? rope_elem(cr + (e - d), cs, d) : v; }
        for (int e = c.tid; e < 1024; e += NTHREADS) { const int part = e >> 8, d = e & 63; const float v = cr[1024 + e];
            kvo[e] = (part == 2 && d < 16) ? rope_elem(cr + 1024 + (e - d), cs, d) : v; }
        { const int e = c.tid; const int part = e >> 8, d = e & 63; const float v = cr[2048 + e];
            const float o = (part == 0 && d < 16) ? rope_elem(cr + 2048 + (e - d), cs, d) : v;
            KW[(size_t)row * 512 + e] = o;
            if (row < NPR) { const int t = row & (SEQ - 1), b = row >> 12; if (t >= SEQ - 512) c.out[O_WINP + ((size_t)b * 512 + (t - (SEQ - 512))) * 512 + e] = o; }
            else c.out[O_WINS + ((size_t)(row - NPR) * 512 + 511) * 512 + e] = o; }
        if (c.tid < 48) GATE[(size_t)row * 48 + c.tid] = sigmoidf_(cr[2560 + c.tid]);
        if (row >= NPR) { float* so = c.out + O_SHS + (size_t)(row - NPR) * RWC; for (int e = c.tid; e < RWC; e += NTHREADS) so[e] = cr[NSAC + e]; }
        else if ((row & (SEQ - 1)) == SEQ - 1) { float* so = c.out + O_SHP + (size_t)(row >> 12) * RWC; for (int e = c.tid; e < RWC; e += NTHREADS) so[e] = cr[NSAC + e]; }
    }
}

__device__ __forceinline__ void p5b_rwkv_prep(const Ctx& c) {
    const float* COLS = WSP(const float, WS_COLS);
    float* RW = WSP(float, WS_RW); float* V = WSP(float, WS_V); float* Gt = WSP(float, WS_G); float* BON = WSP(float, WS_BON);
    const float* mu = c.p->in[19]; const float* w0 = c.p->in[20]; const float* w2 = c.p->in[21]; const float* a0 = c.p->in[22]; const float* a2 = c.p->in[23];
    const float* g2 = c.p->in[24]; const float* kkw = c.p->in[25]; const float* kaw = c.p->in[26]; const float* rk = c.p->in[27];
    float* L = (float*)c.lds;
    constexpr int RG = 8;
#pragma unroll 1
    for (int it = c.bid; it < NR / RG; it += c.G) {
        const int row0 = it * RG;
        __syncthreads();
        for (int e = c.tid; e < RG * 288; e += NTHREADS) {
            const int r = e / 288, k = e % 288, row = row0 + r, col = 3072 + k;
            const float cur = COLS[(size_t)row * NINP + NSAC + col];
            float prev;
            if (row >= NPR) prev = c.p->in[6][(size_t)(row - NPR) * RWC + col];
            else prev = (row & (SEQ - 1)) == 0 ? 0.f : COLS[(size_t)(row - 1) * NINP + NSAC + col];
            const float xs = cur + (prev - cur) * mu[col];
            L[e] = k < 64 ? tanhf(xs) : (k < 128 ? xs : sigmoidf_(xs));
        }
        __syncthreads();
        float aw[RG][2], aa[RG][2], ag[RG][2];
#pragma unroll
        for (int r = 0; r < RG; ++r) { aw[r][0] = aw[r][1] = aa[r][0] = aa[r][1] = ag[r][0] = ag[r][1] = 0.f; }
        const int n0 = c.tid, n1 = c.tid + 512;
#pragma unroll 4
        for (int k = 0; k < 64; ++k) { const float x0 = w2[k * 1024 + n0], x1 = w2[k * 1024 + n1];
#pragma unroll
            for (int r = 0; r < RG; ++r) { const float l = L[r * 288 + k]; aw[r][0] += l * x0; aw[r][1] += l * x1; } }
#pragma unroll 4
        for (int k = 0; k < 64; ++k) { const float x0 = a2[k * 1024 + n0], x1 = a2[k * 1024 + n1];
#pragma unroll
            for (int r = 0; r < RG; ++r) { const float l = L[r * 288 + 64 + k]; aa[r][0] += l * x0; aa[r][1] += l * x1; } }
#pragma unroll 4
        for (int k = 0; k < 160; ++k) { const float x0 = g2[k * 1024 + n0], x1 = g2[k * 1024 + n1];
#pragma unroll
            for (int r = 0; r < RG; ++r) { const float l = L[r * 288 + 128 + k]; ag[r][0] += l * x0; ag[r][1] += l * x1; } }
#pragma unroll
        for (int r = 0; r < RG; ++r) {
            const int row = row0 + r;
            const float* cr = COLS + (size_t)row * NINP + NSAC;
            const bool first = row < NPR && (row & (SEQ - 1)) == 0;
            const float* pr = row >= NPR ? c.p->in[6] + (size_t)(row - NPR) * RWC : (cr - NINP);
#pragma unroll
            for (int j = 0; j < 2; ++j) {
                const int n = j == 0 ? n0 : n1;
                float xr, xk, xv;
                { const float cu = cr[n], p = first ? 0.f : pr[n]; xr = cu + (p - cu) * mu[n]; }
                { const float cu = cr[1024 + n], p = first ? 0.f : pr[1024 + n]; xk = cu + (p - cu) * mu[1024 + n]; }
                { const float cu = cr[2048 + n], p = first ? 0.f : pr[2048 + n]; xv = cu + (p - cu) * mu[2048 + n]; }
                const float wl = w0[n] + aw[r][j];
                const float nx = -wl; const float sp = fmaxf(nx, 0.f) + log1pf(__expf(-fabsf(nx)));
                const float wlog = -sp - 0.5f;
                const float decay = __expf(-__expf(wlog));
                const float a = sigmoidf_(a0[n] + aa[r][j]);
                const float g = ag[r][j];
                const float kkr = xk * kkw[n];
                const float ssq = wave_sum(kkr * kkr);
                const float kkn = kkr / fmaxf(sqrtf(ssq), 1e-12f);
                const float km = xk * (1.0f + (a - 1.0f) * kaw[n]);
                const float bs = wave_sum(xr * km * rk[n]);
                float* rw = RW + (size_t)row * 5 * 1024;
                rw[n] = xr; rw[1024 + n] = decay; rw[2048 + n] = km; rw[3072 + n] = kkn; rw[4096 + n] = kkn * a;
                V[(size_t)row * 1024 + n] = xv; Gt[(size_t)row * 1024 + n] = g;
                if (c.lane == 0) BON[(size_t)row * 16 + (n >> 6)] = bs;
            }
        }
    }
}

__device__ __forceinline__ void p5c_compress(const Ctx& c) {
    float* X = (float*)c.lds;
    float* HID = X + 80 * 256;
    const int tid = c.tid;
    const int n_items_p = 2 * 64, n_items_s = NSM * 32;
#pragma unroll 1
    for (int it = c.bid; it < n_items_p + n_items_s; it += c.G) {
        const bool smp = it >= n_items_p;
        const int b = smp ? (it - n_items_p) >> 5 : it >> 6;
        const int n0 = smp ? ((it - n_items_p) & 31) * 4 : (it & 63) * 4;
        const int nc = smp ? NCS : NCP;
        const int nb = (nc - n0) < 4 ? (nc - n0) : 4;
        const int nrows = 16 * (nb - 1) + 32;
#pragma unroll 1
        for (int kv = 0; kv < 2; ++kv) {
            const float* pe = c.p->in[kv == 0 ? 13 : 16]; const float* w1 = c.p->in[kv == 0 ? 14 : 17]; const float* w2 = c.p->in[kv == 0 ? 15 : 18];
            __syncthreads();
            for (int e = tid; e < nrows * 64; e += NTHREADS) {
                const int r = e >> 6, q4 = (e & 63) * 4; const int tok = 16 * n0 + r;
                const float* src;
                if (smp) { const int page = ((const int*)c.p->in[3])[b * NPAGES + (tok >> 7)]; src = c.p->in[2] + ((size_t)page * PAGE + (tok & 127)) * 1024 + kv * 256 + q4; }
                else src = WSP(const float, WS_COLS) + (size_t)(b * SEQ + tok) * NINP + 1024 + kv * 256 + q4;
                *(float4*)(X + r * 256 + q4) = *(const float4*)src;
            }
            __syncthreads();
            {
                const int kvh = tid >> 7, h = tid & 127;
                float acc[4] = {0.f, 0.f, 0.f, 0.f};
#pragma unroll 1
                for (int l = 0; l < 32; ++l) {
#pragma unroll 8
                    for (int d = 0; d < 64; ++d) {
                        const float w = w1[(l * 64 + d) * 128 + h], pv = pe[l * 64 + d];
#pragma unroll
                        for (int q = 0; q < 4; ++q) acc[q] += (X[(16 * q + l) * 256 + kvh * 64 + d] + pv) * w;
                    }
                }
#pragma unroll
                for (int q = 0; q < 4; ++q) HID[(q * 4 + kvh) * 128 + h] = siluf_(acc[q]);
            }
            __syncthreads();
            {
#pragma unroll
                for (int j = 0; j < 2; ++j) {
                    const int o = tid + j * 512; const int q = o >> 8, kvh = (o >> 6) & 3, dd = o & 63;
                    float s = 0.f;
#pragma unroll 8
                    for (int h = 0; h < 128; ++h) s += HID[(q * 4 + kvh) * 128 + h] * w2[h * 64 + dd];
                    if (q < nb) {
                        float* dst = smp ? WSP(float, kv == 0 ? WS_KCS : WS_VCS) + ((size_t)b * 128 + n0 + q) * 256 : WSP(float, kv == 0 ? WS_KCP : WS_VCP) + ((size_t)b * 256 + n0 + q) * 256;
                        dst[kvh * 64 + dd] = s;
                    }
                }
            }
        }
    }
}

__device__ __forceinline__ void scan_prompt(const Ctx& c, int chain, int qd) {
    constexpr int CH = 32, BUF_F = CH * 320 + CH * 16;
    float* sm = (float*)c.lds;
    const float* RW = WSP(const float, WS_RW); const float* V = WSP(const float, WS_V); float* Y = WSP(float, WS_Y);
    const int b = chain >> 4, h = chain & 15;
    const int tid = c.tid, wave = c.wave, lane = c.lane, lq = lane >> 4, c4 = lane & 15;
    const int nch = SEQ / CH;
    float4 S = make_float4(0.f, 0.f, 0.f, 0.f);
    const size_t rowbase = (size_t)b * SEQ;
#define SCAN_LOAD(cc, bufp) do { const int lt = tid - 256; \
        for (int i = lt; i < CH * 80; i += 256) { const int st = i / 80, r = i % 80, vec = r >> 4, q = r & 15; \
            *(float4*)((bufp) + (st * 5 + vec) * 64 + q * 4) = *(const float4*)(RW + ((rowbase + (size_t)(cc) * CH + st) * 5 + vec) * 1024 + h * 64 + q * 4); } \
        for (int i = lt; i < CH * 4; i += 256) { const int st = i >> 2, q = i & 3; \
            *(float4*)((bufp) + CH * 320 + st * 16 + q * 4) = *(const float4*)(V + (rowbase + (size_t)(cc) * CH + st) * 1024 + h * 64 + qd * 16 + q * 4); } } while (0)
    __syncthreads();
    if (wave >= 4) SCAN_LOAD(0, sm);
    __syncthreads();
#pragma unroll 1
    for (int cc = 0; cc < nch; ++cc) {
        float* buf = sm + (cc & 1) * BUF_F;
        if (wave < 4) {
            const float* vb = buf + c4 * 4;
            const float* vv = buf + CH * 320 + wave * 4 + lq;
            float4 r4 = *(const float4*)(vb), d4 = *(const float4*)(vb + 64), km4 = *(const float4*)(vb + 128), kk4 = *(const float4*)(vb + 192), ka4 = *(const float4*)(vb + 256);
            float v = vv[0];
#pragma unroll 4
            for (int st = 0; st < CH; ++st) {
                const int sn = st + 1 < CH ? st + 1 : st;
                const float4 r4n = *(const float4*)(vb + sn * 320), d4n = *(const float4*)(vb + sn * 320 + 64), km4n = *(const float4*)(vb + sn * 320 + 128),
                             kk4n = *(const float4*)(vb + sn * 320 + 192), ka4n = *(const float4*)(vb + sn * 320 + 256);
                const float vn = vv[sn * 16];
                const float sa = -red16(dot4(S, kk4));
                S.x = S.x * d4.x + sa * ka4.x + v * km4.x; S.y = S.y * d4.y + sa * ka4.y + v * km4.y;
                S.z = S.z * d4.z + sa * ka4.z + v * km4.z; S.w = S.w * d4.w + sa * ka4.w + v * km4.w;
                const float y = red16(dot4(S, r4));
                if (c4 == 0) Y[(rowbase + (size_t)cc * CH + st) * 1024 + h * 64 + qd * 16 + wave * 4 + lq] = y;
                r4 = r4n; d4 = d4n; km4 = km4n; kk4 = kk4n; ka4 = ka4n; v = vn;
            }
        } else if (cc + 1 < nch) {
            float* nb = sm + ((cc + 1) & 1) * BUF_F;
            SCAN_LOAD(cc + 1, nb);
        }
        __syncthreads();
    }
#undef SCAN_LOAD
    if (wave < 4) *(float4*)(c.out + O_WKVP + ((size_t)chain * 64 + qd * 16 + wave * 4 + lq) * 64 + c4 * 4) = S;
}

__device__ __forceinline__ void scan_sample_item(const Ctx& c, int item) {
    const int b = item >> 4, h = item & 15, lane = c.lane, lq = lane >> 4, c4 = lane & 15;
    const float* RW = WSP(const float, WS_RW) + (size_t)(NPR + b) * 5 * 1024 + h * 64 + c4 * 4;
    const float4 r4 = *(const float4*)(RW), d4 = *(const float4*)(RW + 1024), km4 = *(const float4*)(RW + 2048), kk4 = *(const float4*)(RW + 3072), ka4 = *(const float4*)(RW + 4096);
    const float* V = WSP(const float, WS_V) + (size_t)(NPR + b) * 1024 + h * 64;
    float* Y = WSP(float, WS_Y) + (size_t)(NPR + b) * 1024 + h * 64;
    const float* S0 = c.p->in[5] + (size_t)item * 4096; float* S1 = c.out + O_WKVS + (size_t)item * 4096;
#pragma unroll 4
    for (int itr = 0; itr < 16; ++itr) {
        const int i = itr * 4 + lq;
        float4 S = *(const float4*)(S0 + i * 64 + c4 * 4);
        const float v = V[i];
        const float sa = -red16(dot4(S, kk4));
        S.x = S.x * d4.x + sa * ka4.x + v * km4.x; S.y = S.y * d4.y + sa * ka4.y + v * km4.y;
        S.z = S.z * d4.z + sa * ka4.z + v * km4.z; S.w = S.w * d4.w + sa * ka4.w + v * km4.w;
        *(float4*)(S1 + i * 64 + c4 * 4) = S;
        const float y = red16(dot4(S, r4));
        if (c4 == 0) Y[i] = y;
    }
}

__device__ __forceinline__ void seg_scores(const float4 (&q)[4], const float* kb, int stride, int count, float* sc, int off, int lane) {
    const int l15 = lane & 15, lq = lane >> 4;
#pragma unroll 1
    for (int k0 = 0; k0 < count; k0 += 4) {
        const int key = k0 + lq;
        float4 kv = make_float4(0.f, 0.f, 0.f, 0.f);
        if (key < count) kv = *(const float4*)(kb + (size_t)key * stride + 4 * l15);
        float s0 = red16(dot4(q[0], kv)), s1 = red16(dot4(q[1], kv)), s2 = red16(dot4(q[2], kv)), s3 = red16(dot4(q[3], kv));
        if (l15 == 0 && key < count) { sc[off + key] = s0 * 0.125f; sc[1024 + off + key] = s1 * 0.125f; sc[2048 + off + key] = s2 * 0.125f; sc[3072 + off + key] = s3 * 0.125f; }
    }
}
__device__ __forceinline__ void seg_pv(float4 (&acc)[4], const float* vb, int stride, int count, const float* sc, int off, int lane) {
    const int l15 = lane & 15, lq = lane >> 4;
#pragma unroll 1
    for (int k0 = 0; k0 < count; k0 += 4) {
        const int key = k0 + lq;
        if (key < count) {
            const float4 vv = *(const float4*)(vb + (size_t)key * stride + 4 * l15);
#pragma unroll
            for (int g = 0; g < 4; ++g) { const float pp = sc[g * 1024 + off + key]; acc[g].x += pp * vv.x; acc[g].y += pp * vv.y; acc[g].z += pp * vv.z; acc[g].w += pp * vv.w; }
        }
    }
}
__device__ __forceinline__ void softmax_rows(float* sc, int total, int lane) {
#pragma unroll 1
    for (int g = 0; g < 4; ++g) {
        float* r = sc + g * 1024;
        float m = -3.0e38f;
        for (int i = lane; i < total; i += 64) m = fmaxf(m, r[i]);
        m = wave_max(m);
        float s = 0.f;
        for (int i = lane; i < total; i += 64) { const float e = __expf(r[i] - m); r[i] = e; s += e; }
        s = wave_sum(s);
        const float inv = 1.0f / s;
        for (int i = lane; i < total; i += 64) r[i] *= inv;
    }
}
__device__ __forceinline__ void acc_finish(float4 (&o)[4], float4 (&acc)[4], const float* gate, int gi) {
#pragma unroll
    for (int g = 0; g < 4; ++g) {
        float4 a = acc[g];
        a.x += __shfl_xor(a.x, 16); a.y += __shfl_xor(a.y, 16); a.z += __shfl_xor(a.z, 16); a.w += __shfl_xor(a.w, 16);
        a.x += __shfl_xor(a.x, 32); a.y += __shfl_xor(a.y, 32); a.z += __shfl_xor(a.z, 32); a.w += __shfl_xor(a.w, 32);
        const float gt = gate[g * 3 + gi];
        o[g].x += gt * a.x; o[g].y += gt * a.y; o[g].z += gt * a.z; o[g].w += gt * a.w;
        acc[g] = make_float4(0.f, 0.f, 0.f, 0.f);
    }
}

__device__ __forceinline__ void nsa_item_naive(const Ctx& c, int row, int kvh, float* sc) {
    const int lane = c.lane, l15 = lane & 15;
    const bool smp = row >= NPR;
    const int b = smp ? row - NPR : row >> 12;
    const int t = smp ? PAST : (row & (SEQ - 1));
    const float* KVO = c.out + O_KV;
    const float* KWp = WSP(const float, WS_KW);
    float4 qr[4], qs[4];
#pragma unroll
    for (int g = 0; g < 4; ++g) { qr[g] = *(const float4*)(WSP(const float, WS_QRAW) + (size_t)row * 1024 + (kvh * 4 + g) * 64 + 4 * l15);
                                  qs[g] = *(const float4*)(WSP(const float, WS_QROT) + (size_t)row * 1024 + (kvh * 4 + g) * 64 + 4 * l15); }
    const float* gate = WSP(const float, WS_GATE) + (size_t)row * 48 + kvh * 12;
    float4 o[4], acc[4];
#pragma unroll
    for (int g = 0; g < 4; ++g) { o[g] = make_float4(0.f, 0.f, 0.f, 0.f); acc[g] = make_float4(0.f, 0.f, 0.f, 0.f); }
    WAVE_SYNC();
    int ncmp = smp ? NCS : (t >= 31 ? (t - 31) / 16 + 1 : 0); if (ncmp > NCP) ncmp = NCP;
    const float* kc = (smp ? WSP(const float, WS_KCS) + (size_t)b * 128 * 256 : WSP(const float, WS_KCP) + (size_t)b * 256 * 256) + kvh * 64;
    const float* vc = (smp ? WSP(const float, WS_VCS) + (size_t)b * 128 * 256 : WSP(const float, WS_VCP) + (size_t)b * 256 * 256) + kvh * 64;
    if (ncmp > 0) {
        seg_scores(qr, kc, 256, ncmp, sc, 0, lane); WAVE_SYNC();
        softmax_rows(sc, ncmp, lane); WAVE_SYNC();
        seg_pv(acc, vc, 256, ncmp, sc, 0, lane);
        acc_finish(o, acc, gate, 0);
    }
    unsigned long long mask;
    {
        const int j = lane;
        float imp = 0.f;
#pragma unroll
        for (int r = -1; r <= 3; ++r) { const int n = 4 * j + r; if (n >= 0 && n < ncmp) { const float P = sc[n] + sc[1024 + n] + sc[2048 + n] + sc[3072 + n]; imp += (r == -1 || r == 3) ? P : 2.0f * P; } }
        const int cur = t >> 6;
        const bool valid = j <= cur;
        const bool forced = (j == 0) || (cur - j >= 0 && cur - j < 2);
        const float score = valid ? imp + (forced ? 1.0e4f : 0.0f) : NEGV;
        int rank = 0;
#pragma unroll 1
        for (int jp = 0; jp < 64; ++jp) { const float o2 = __shfl(score, jp); rank += (o2 > score || (o2 == score && jp < j)) ? 1 : 0; }
        mask = __ballot(valid && rank < 16);
    }
    WAVE_SYNC();
    {
        int off = 0;
        unsigned long long m = mask;
#pragma unroll 1
        while (m) { const int j = __ffsll((long long)m) - 1; m &= m - 1;
            const float* kp; int cnt;
            if (!smp) { kp = KVO + ((size_t)(b * SEQ + 64 * j)) * 1024 + 512 + kvh * 64; cnt = t - 64 * j + 1; cnt = cnt > 64 ? 64 : cnt; }
            else if (j < 32) { const int page = ((const int*)c.p->in[3])[b * NPAGES + (j >> 1)]; kp = c.p->in[2] + ((size_t)page * PAGE + (j & 1) * 64) * 1024 + 512 + kvh * 64; cnt = 64; }
            else { kp = KVO + (size_t)row * 1024 + 512 + kvh * 64; cnt = 1; }
            seg_scores(qs, kp, 1024, cnt, sc, off, lane); off += cnt; }
        WAVE_SYNC();
        softmax_rows(sc, off, lane); WAVE_SYNC();
        off = 0; m = mask;
#pragma unroll 1
        while (m) { const int j = __ffsll((long long)m) - 1; m &= m - 1;
            const float* kp; int cnt;
            if (!smp) { kp = KVO + ((size_t)(b * SEQ + 64 * j)) * 1024 + 512 + kvh * 64; cnt = t - 64 * j + 1; cnt = cnt > 64 ? 64 : cnt; }
            else if (j < 32) { const int page = ((const int*)c.p->in[3])[b * NPAGES + (j >> 1)]; kp = c.p->in[2] + ((size_t)page * PAGE + (j & 1) * 64) * 1024 + 512 + kvh * 64; cnt = 64; }
            else { kp = KVO + (size_t)row * 1024 + 512 + kvh * 64; cnt = 1; }
            seg_pv(acc, kp + 256, 1024, cnt, sc, off, lane); off += cnt; }
        acc_finish(o, acc, gate, 1);
    }
    WAVE_SYNC();
    {
        int total;
        if (!smp) { const int start = t > 512 ? t - 512 : 0; const float* kp = KWp + ((size_t)(b * SEQ + start)) * 512 + kvh * 64; total = t - start + 1;
            seg_scores(qs, kp, 512, total, sc, 0, lane); WAVE_SYNC(); softmax_rows(sc, total, lane); WAVE_SYNC(); seg_pv(acc, kp + 256, 512, total, sc, 0, lane); }
        else { const float* k1 = c.p->in[4] + (size_t)b * 512 * 512 + kvh * 64; const float* k2 = KWp + (size_t)row * 512 + kvh * 64; total = 513;
            seg_scores(qs, k1, 512, 512, sc, 0, lane); seg_scores(qs, k2, 512, 1, sc, 512, lane); WAVE_SYNC(); softmax_rows(sc, total, lane); WAVE_SYNC();
            seg_pv(acc, k1 + 256, 512, 512, sc, 0, lane); seg_pv(acc, k2 + 256, 512, 1, sc, 512, lane); }
        acc_finish(o, acc, gate, 2);
    }
    WAVE_SYNC();
    if (lane < 16) {
        bf16_t* dst = WSP(bf16_t, WS_AMIX) + (size_t)row * DM + kvh * 256 + 4 * l15;
#pragma unroll
        for (int g = 0; g < 4; ++g) *(uint2*)(dst + g * 64) = make_uint2(pack2bf(o[g].x, o[g].y), pack2bf(o[g].z, o[g].w));
    }
}

__device__ __forceinline__ void p6_mixers(const Ctx& c) {
    if (c.bid < 128) scan_prompt(c, c.bid >> 2, c.bid & 3);
    else {
        const int nw = (c.G - 128) * NWAVES;
        if (nw > 0) for (int it = (c.bid - 128) * NWAVES + c.wave; it < NSM * 16; it += nw) scan_sample_item(c, it);
    }
    if (c.G <= 128) { for (int it = c.bid * NWAVES + c.wave; it < NSM * 16; it += c.G * NWAVES) scan_sample_item(c, it); }
    __syncthreads();
    unsigned* q = (unsigned*)(c.ws + WS_CTL) + CW_QATT;
    volatile unsigned* sh = (volatile unsigned*)(c.lds + LDS_MISC + 64);
    float* sc = (float*)c.lds + c.wave * 4096;
    const int n_pulls = NR * 4 / NWAVES;
#pragma unroll 1
    for (;;) {
        __syncthreads();
        if (c.tid == 0) sh[0] = atomicAdd(q, 1u);
        __syncthreads();
        const unsigned pull = sh[0];
        if (pull >= (unsigned)n_pulls) break;
        const int item = (int)pull * NWAVES + c.wave;
        nsa_item_naive(c, item >> 2, item & 3, sc);
    }
}

__device__ __forceinline__ void p6b_gn(const Ctx& c) {
    const float* Y = WSP(const float, WS_Y); const float* RW = WSP(const float, WS_RW); const float* V = WSP(const float, WS_V); const float* Gt = WSP(const float, WS_G); const float* BON = WSP(const float, WS_BON);
    const float* gnw = c.p->in[28]; const float* gnb = c.p->in[29];
    bf16_t* AM = WSP(bf16_t, WS_AMIX);
#pragma unroll 1
    for (int row = c.bid; row < NR; row += c.G) {
#pragma unroll
        for (int j = 0; j < 2; ++j) {
            const int n = c.tid + j * 512;
            const float y = Y[(size_t)row * 1024 + n];
            const float mean = wave_sum(y) * (1.0f / 64.0f);
            const float d = y - mean;
            const float var = wave_sum(d * d) * (1.0f / 64.0f);
            const float yn = d * rsqrtf(var + GN_EPS) * gnw[n] + gnb[n];
            const float bonus = BON[(size_t)row * 16 + (n >> 6)] * V[(size_t)row * 1024 + n];
            const float o = (yn + bonus) * Gt[(size_t)row * 1024 + n];
            AM[(size_t)row * DM + 1024 + n] = f2bf(o);
        }
    }
}

constexpr int N_PHASES = 13;

template <class Epi>
__device__ __forceinline__ void run_gemm(const Ctx& c, const bf16_t* A, const bf16_t* Bt, int N, int K, const Epi& E) {
    pg8::Gemm g{A, Bt, MP, N, K};
    pg8::StaticOrder S; S.init(MP, N, c.G, c.bid);
    pg8::gemm_phase<Epi, pg8::StaticOrder, false>((PG8_LAS unsigned char*)c.lds, g, S, E, nullptr);
}

__global__ void __launch_bounds__(NTHREADS, 2) hybrid_fwd(Params prm) {
    extern __shared__ __attribute__((aligned(16))) unsigned char shm[];
    Ctx c; c.p = &prm; c.ws = prm.ws; c.out = prm.out; c.lds = shm;
    c.tid = threadIdx.x; c.lane = c.tid & 63; c.wave = __builtin_amdgcn_readfirstlane(c.tid >> 6); c.bid = blockIdx.x; c.G = gridDim.x;
    const int lo = prm.ph_lo, hi = prm.ph_hi;
    if (c.tid < 4) ((volatile unsigned*)(shm + LDS_MISC))[c.tid] = 0u;
    __syncthreads();
    XcdBarrier bar; bar.bar = (unsigned*)(c.ws + WS_CTL) + CW_BAR; bar.x = 0; bar.st = nullptr;
    const bool multi = (hi - lo) > 1;
    if (multi) bar = xcd_barrier_post((unsigned*)(c.ws + WS_CTL) + CW_BAR, (volatile LAS unsigned*)(shm + LDS_MISC));
#define IN(k) (lo <= (k) && (k) < hi)
#define SEAM(k) do { if (IN(k) && IN((k) + 1)) xcd_barrier(bar); } while (0)

    if (IN(0)) { p0_prologue(c); } SEAM(0);
    if (IN(1)) { pg8::EpiSwiGLU E{WSP(bf16_t, WS_ACT), DFF}; run_gemm(c, WSP(const bf16_t, WS_A1), WSP(const bf16_t, WS_WGU1), NGU, DM, E); } SEAM(1);
    if (IN(2)) { pg8::EpiF32 E{WSP(float, WS_O), DM, nullptr}; run_gemm(c, WSP(const bf16_t, WS_ACT), WSP(const bf16_t, WS_WDN1), DM, DFF, E); } SEAM(2);
    if (IN(3)) { thin_norm(c, WSP(const float, WS_O), 0, prm.in[8], 0.5f, WSP(float, WS_H1), prm.in[11], WSP(bf16_t, WS_A2)); } SEAM(3);
    if (IN(4)) { pg8::EpiF32 E{WSP(float, WS_COLS), NINP, nullptr}; run_gemm(c, WSP(const bf16_t, WS_A2), WSP(const bf16_t, WS_WIN), NINP, DM, E); } SEAM(4);
    if (IN(5)) { p5a_nsa_prep(c); p5b_rwkv_prep(c); p5c_compress(c); } SEAM(5);
    if (IN(6)) { p6_mixers(c); } SEAM(6);
    if (IN(7)) { p6b_gn(c); } SEAM(7);
    if (IN(8)) { pg8::EpiF32 E{WSP(float, WS_O), DM, nullptr}; run_gemm(c, WSP(const bf16_t, WS_AMIX), WSP(const bf16_t, WS_WOUT), DM, DM, E); } SEAM(8);
    if (IN(9)) { thin_norm(c, WSP(const float, WS_O), 1, prm.in[31], 1.0f, WSP(float, WS_H2), prm.in[32], WSP(bf16_t, WS_A3)); } SEAM(9);
    if (IN(10)) { pg8::EpiSwiGLU E{WSP(bf16_t, WS_ACT), DFF}; run_gemm(c, WSP(const bf16_t, WS_A3), WSP(const bf16_t, WS_WGU2), NGU, DM, E); } SEAM(10);
    if (IN(11)) { pg8::EpiF32 E{WSP(float, WS_O), DM, nullptr}; run_gemm(c, WSP(const bf16_t, WS_ACT), WSP(const bf16_t, WS_WDN2), DM, DFF, E); } SEAM(11);
    if (IN(12)) { thin_norm(c, WSP(const float, WS_O), 2, prm.in[35], 0.5f, c.out + O_Y, nullptr, nullptr); }
#undef IN
#undef SEAM
}

extern "C" void kernel_launch(void* const* d_in, const int* in_sizes, int n_in, void* d_out, int out_size, void* d_ws, size_t ws_size, hipStream_t stream) {
    static int grid = 0;
    if (grid == 0) {
        if (n_in != 36 || (size_t)out_size != O_END || ws_size < WS_END) { fprintf(stderr, "kernel_launch: unexpected problem shape (n_in %d, out %d, ws %zu; need 36, %zu, >= %zu)\n", n_in, out_size, ws_size, (size_t)O_END, (size_t)WS_END); grid = -1; return; }
        int dev = 0, cus = 0, per_cu = 0;
        if (hipGetDevice(&dev) != hipSuccess || hipDeviceGetAttribute(&cus, hipDeviceAttributeMultiprocessorCount, dev) != hipSuccess) { grid = -1; return; }
        if (hipFuncSetAttribute((const void*)hybrid_fwd, hipFuncAttributeMaxDynamicSharedMemorySize, LDS_BYTES) != hipSuccess) { fprintf(stderr, "kernel_launch: hipFuncSetAttribute failed\n"); grid = -1; return; }
        if (hipOccupancyMaxActiveBlocksPerMultiprocessor(&per_cu, (const void*)hybrid_fwd, NTHREADS, LDS_BYTES) != hipSuccess || per_cu < 1) { fprintf(stderr, "kernel_launch: occupancy query says %d\n", per_cu); }
        (void)hipGetLastError();
        grid = cus;
        if (grid != 256) fprintf(stderr, "kernel_launch: %d CUs (expected 256)\n", grid);
    }
    if (grid < 0) return;
    if (hipMemsetAsync((char*)d_ws + WS_CTL, 0, CTL_BYTES, stream) != hipSuccess) return;
    Params p{};
    for (int i = 0; i < 36; ++i) p.in[i] = (const float*)d_in[i];
    p.out = (float*)d_out; p.ws = (unsigned char*)d_ws; p.pad0 = 0; p.pad1 = 0;
#if MK_N_LAUNCHES == 1
    p.ph_lo = 0; p.ph_hi = N_PHASES;
    hipLaunchKernelGGL(hybrid_fwd, dim3(grid), dim3(NTHREADS), LDS_BYTES, stream, p);
#else
    for (int ph = 0; ph < N_PHASES; ++ph) { p.ph_lo = ph; p.ph_hi = ph + 1; hipLaunchKernelGGL(hybrid_fwd, dim3(grid), dim3(NTHREADS), LDS_BYTES, stream, p); }
#endif
}
```

```cpp
#include <hip/hip_runtime.h>
#include <cstdio>
#include <cstdint>

#ifndef MK_N_LAUNCHES
#define MK_N_LAUNCHES 1
#endif

constexpr int DM = 2048, SEQ = 4096, NPR = 8192, NSM = 128, NR = NPR + NSM  , MP = 8448  ;
constexpr int DFF = 5632, NGU = 2 * DFF, NIN = 5968, NINP = 6144, NSAC = 2608, RWC = 3360;
constexpr int PAST = 2048, NPAGES = 16, PAGE = 128;
constexpr int NCP = 255  , NCS = 127  ;
constexpr float RMS_EPS = 1e-6f, GN_EPS = 64e-5f, NEGV = -1e30f;

constexpr size_t O_Y = 0, O_KV = 17039360, O_WINP = 25559040, O_WINS = 26083328, O_WKVP = 59637760, O_WKVS = 59768832, O_SHP = 68157440, O_SHS = 68164160, O_END = 68594240;

constexpr size_t al256(size_t x) { return (x + 255) & ~(size_t)255; }
constexpr size_t WS_CTL = 0, CTL_BYTES = 65536;
constexpr size_t WS_WGU1 = al256(WS_CTL + CTL_BYTES);
constexpr size_t WS_WDN1 = al256(WS_WGU1 + (size_t)NGU * DM * 2);
constexpr size_t WS_WIN  = al256(WS_WDN1 + (size_t)DM * DFF * 2);
constexpr size_t WS_WOUT = al256(WS_WIN + (size_t)NINP * DM * 2);
constexpr size_t WS_WGU2 = al256(WS_WOUT + (size_t)DM * DM * 2);
constexpr size_t WS_WDN2 = al256(WS_WGU2 + (size_t)NGU * DM * 2);
constexpr size_t WS_A1   = al256(WS_WDN2 + (size_t)DM * DFF * 2);
constexpr size_t WS_A2   = al256(WS_A1 + (size_t)MP * DM * 2);
constexpr size_t WS_A3   = al256(WS_A2 + (size_t)MP * DM * 2);
constexpr size_t WS_AMIX = al256(WS_A3 + (size_t)MP * DM * 2);
constexpr size_t WS_ACT  = al256(WS_AMIX + (size_t)MP * DM * 2);
constexpr size_t WS_O    = al256(WS_ACT + (size_t)MP * DFF * 2);
constexpr size_t WS_H1   = al256(WS_O + (size_t)MP * DM * 4);
constexpr size_t WS_H2   = al256(WS_H1 + (size_t)NR * DM * 4);
constexpr size_t WS_COLS = al256(WS_H2 + (size_t)NR * DM * 4);
constexpr size_t WS_QRAW = al256(WS_COLS + (size_t)MP * NINP * 4);
constexpr size_t WS_QROT = al256(WS_QRAW + (size_t)NR * 1024 * 4);
constexpr size_t WS_KW   = al256(WS_QROT + (size_t)NR * 1024 * 4);
constexpr size_t WS_GATE = al256(WS_KW + (size_t)NR * 512 * 4);
constexpr size_t WS_RW   = al256(WS_GATE + (size_t)NR * 48 * 4);
constexpr size_t WS_V    = al256(WS_RW + (size_t)NR * 5 * 1024 * 4);
constexpr size_t WS_G    = al256(WS_V + (size_t)NR * 1024 * 4);
constexpr size_t WS_Y    = al256(WS_G + (size_t)NR * 1024 * 4);
constexpr size_t WS_BON  = al256(WS_Y + (size_t)NR * 1024 * 4);
constexpr size_t WS_KCP  = al256(WS_BON + (size_t)NR * 16 * 4);
constexpr size_t WS_VCP  = al256(WS_KCP + (size_t)2 * 256 * 256 * 4);
constexpr size_t WS_KCS  = al256(WS_VCP + (size_t)2 * 256 * 256 * 4);
constexpr size_t WS_VCS  = al256(WS_KCS + (size_t)128 * 128 * 256 * 4);
constexpr size_t WS_ROPE = al256(WS_VCS + (size_t)128 * 128 * 256 * 4);
constexpr size_t WS_QRB  = al256(WS_ROPE + (size_t)4096 * 16 * 4);
constexpr size_t WS_QSB  = al256(WS_QRB + (size_t)NPR * 1024 * 2);
constexpr size_t WS_KSB  = al256(WS_QSB + (size_t)NPR * 1024 * 2);
constexpr size_t WS_VSB  = al256(WS_KSB + (size_t)NPR * 256 * 2);
constexpr size_t WS_KWB  = al256(WS_VSB + (size_t)NPR * 256 * 2);
constexpr size_t WS_VWB  = al256(WS_KWB + (size_t)NPR * 256 * 2);
constexpr size_t WS_KCB  = al256(WS_VWB + (size_t)NPR * 256 * 2);
constexpr size_t WS_VCB  = al256(WS_KCB + (size_t)2 * 256 * 256 * 2);
constexpr size_t WS_W1T  = al256(WS_VCB + (size_t)2 * 256 * 256 * 2);
constexpr size_t WS_W2T  = al256(WS_W1T + (size_t)2 * 16 * 256 * 64 * 2);
constexpr size_t WS_PET  = al256(WS_W2T + (size_t)2 * 64 * 128 * 2);
constexpr size_t WS_DEC  = al256(WS_PET + (size_t)2 * 128 * 4);
constexpr size_t WS_AA   = al256(WS_DEC + (size_t)NR * 1024 * 4);
constexpr size_t WS_LW2T = al256(WS_AA + (size_t)NR * 1024 * 4);
constexpr size_t WS_LA2T = al256(WS_LW2T + (size_t)1024 * 64 * 2);
constexpr size_t WS_LG2T = al256(WS_LA2T + (size_t)1024 * 64 * 2);
constexpr size_t CK_REC = 11520;
constexpr size_t WS_CK   = al256(WS_LG2T + (size_t)1024 * 160 * 2);
constexpr size_t WS_OS   = al256(WS_CK + (size_t)8192 * CK_REC + 4096);
constexpr size_t WS_END  = al256(WS_OS + (size_t)8 * 256 * NINP * 4);

constexpr int CW_BAR = 0;
constexpr int CW_QATT = 4096;
constexpr int CW_QMISC = 4160;

constexpr int NTHREADS = 512, NWAVES = 8;
constexpr int LDS_BYTES = 147456;
constexpr int LDS_MISC = 146432;

typedef unsigned short bf16_t;
typedef float p1_f2 __attribute__((ext_vector_type(2)));
typedef __bf16 p1_b2 __attribute__((ext_vector_type(2)));
__device__ __forceinline__ unsigned pack2bf(float lo, float hi) { const p1_f2 v = {lo, hi}; return __builtin_bit_cast(unsigned, __builtin_convertvector(v, p1_b2)); }
__device__ __forceinline__ bf16_t f2bf(float f) { return (bf16_t)(pack2bf(f, 0.f) & 0xffffu); }

struct Params {
    const float* in[36];
    float* out;
    unsigned char* ws;
    int ph_lo, ph_hi, pad0, pad1;
};

#define XB_TMO      128
#define XB_XCNT(j)  (256  + 64 * (j))
#define XB_XSUB(j)  (1280 + 64 * (j))
#define XB_XGEN(j)  (2304 + 64 * (j))
#define XB_TOP      3328
#define XB_TOPGEN   3392
#define XCD_BAR_WORDS 3456
#define XB_SPIN_CAP (1u << 18)
#define LAS __attribute__((address_space(3)))

__device__ __forceinline__ unsigned xb_ld(unsigned* p)              { return __hip_atomic_load(p, __ATOMIC_RELAXED, __HIP_MEMORY_SCOPE_AGENT); }
__device__ __forceinline__ unsigned xb_add(unsigned* p, unsigned v) { return __hip_atomic_fetch_add(p, v, __ATOMIC_RELAXED, __HIP_MEMORY_SCOPE_AGENT); }
__device__ __forceinline__ unsigned xb_xcc_id() { return (unsigned)__builtin_amdgcn_s_getreg((3 << 11) | 20) & 0xFu; }
#define XB_SPIN(cond, bar) do { unsigned _sp = 0; while (cond) { __builtin_amdgcn_s_sleep(1); \
    if ((++_sp & 255u) == 0u) { if (xb_ld(&(bar)[XB_TMO])) break; if (_sp > XB_SPIN_CAP) { atomicAdd(&(bar)[XB_TMO], 1u); break; } } } } while (0)

struct XcdBarrier {
    unsigned* bar; unsigned x;
    volatile LAS unsigned* st;
};

__device__ __forceinline__ XcdBarrier xcd_barrier_post(unsigned* bar, volatile LAS unsigned* st) {
    XcdBarrier b; b.bar = bar; b.x = xb_xcc_id(); b.st = st;
    if (threadIdx.x == 0) (void)xb_add(&bar[XB_XCNT(b.x)], 1u);
    return b;
}
__device__ __forceinline__ void xcd_barrier_complete(unsigned* bar, unsigned x, unsigned& nloc, unsigned& nx) {
    const unsigned G = gridDim.x * gridDim.y * gridDim.z;
    unsigned sum, cnt, mine, sp = 0u;
    for (;;) {
        sum = 0u; cnt = 0u; mine = 0u;
#pragma unroll
        for (unsigned j = 0; j < 16; ++j) { const unsigned c = xb_ld(&bar[XB_XCNT(j)]); sum += c; cnt += (c > 0u) ? 1u : 0u; mine = (j == x) ? c : mine; }
        if (sum == G) break;
        __builtin_amdgcn_s_sleep(1);
        if ((++sp & 255u) == 0u) { if (xb_ld(&bar[XB_TMO])) break; if (sp > XB_SPIN_CAP) { atomicAdd(&bar[XB_TMO], 1u); break; } }
    }
    nloc = mine > 0u ? mine : 1u; nx = cnt > 0u ? cnt : 1u;
}

__device__ __forceinline__ void xcd_barrier(const XcdBarrier& b) {
    asm volatile("s_waitcnt vmcnt(0)" ::: "memory");
    __syncthreads();
    if (threadIdx.x == 0) {
        unsigned* bar = b.bar;
        __builtin_amdgcn_s_waitcnt(0);
        unsigned nloc = b.st[0], nx = b.st[1];
        if (nloc == 0u) { xcd_barrier_complete(bar, b.x, nloc, nx); b.st[0] = nloc; b.st[1] = nx; }
        const unsigned old = xb_add(&bar[XB_XSUB(b.x)], 1u);
        const unsigned gen = old / nloc;
        if (old + 1u == (gen + 1u) * nloc) {
            __builtin_amdgcn_fence(__ATOMIC_RELEASE, "agent");
            asm volatile("s_waitcnt vmcnt(0)" ::: "memory");
            const unsigned og = xb_add(&bar[XB_TOP], 1u);
            const unsigned tg = og / nx;
            if (og + 1u == (tg + 1u) * nx) xb_add(&bar[XB_TOPGEN], 1u);
            else XB_SPIN(xb_ld(&bar[XB_TOPGEN]) == tg, bar);
            __builtin_amdgcn_fence(__ATOMIC_ACQUIRE, "agent");
            xb_add(&bar[XB_XGEN(b.x)], 1u);
            asm volatile("s_waitcnt vmcnt(0)" ::: "memory");
        } else {
            XB_SPIN(xb_ld(&bar[XB_XGEN(b.x)]) == gen, bar);
            __builtin_amdgcn_fence(__ATOMIC_ACQUIRE, "agent");
            asm volatile("s_waitcnt vmcnt(0)" ::: "memory");
        }
    }
    __syncthreads();
}
namespace pg8 {
#define PG8_LAS __attribute__((address_space(3)))
typedef unsigned short bf16_t;
typedef short bf16x8 __attribute__((ext_vector_type(8)));
typedef float f32x4 __attribute__((ext_vector_type(4)));
typedef unsigned u32x4 __attribute__((ext_vector_type(4)));
constexpr int BM = 256, BK = 64, HALF = 128, HTB = HALF * BK * 2  , STAGE_BYTES = 8 * HTB, NXCD = 8, WGM = 8;

__host__ __device__ __forceinline__ int lds_byte(int r, int c) { const int st = (r >> 4) * 2 + (c >> 5), rr = r & 15, cc = c & 31, ob = rr * 64 + cc * 2; return st * 1024 + (ob ^ (((ob >> 9) & 1) << 5)); }
__host__ __device__ __forceinline__ void stage_rc(int b, int& R, int& C) { const int st = b / 1024, sb = b % 1024, swz = sb ^ (((sb >> 9) & 1) << 5); R = (st >> 1) * 16 + swz / 64; C = (st & 1) * 32 + (swz % 64) / 2; }
__host__ __device__ __forceinline__ int perm32(int rho) { const int n = rho >> 4, i = rho & 15; return 8 * (i >> 2) + 4 * n + (i & 3); }

struct Unit { int pm, pn, ko, ks; };
struct Gemm { const bf16_t* A; const bf16_t* Bt; int M, N, K, ld; };

struct StaticOrder {
    int nM, nN, nwg, G, c;
    __host__ __device__ void init(int M, int N, int G_, int c_) { nM = M / BM; nN = N / BM; nwg = nM * nN; G = G_; c = c_; }
    __host__ __device__ bool next(int i, Unit& u) const {
        const long L = (long)i * G + c; if (L >= nwg) return false;
        int wgid = (int)L; { const int q = nwg / NXCD, r = nwg % NXCD, xcd = wgid % NXCD, off = wgid / NXCD; wgid = (xcd < r ? xcd * (q + 1) : r * (q + 1) + (xcd - r) * q) + off; }
        const int nig = WGM * nN, gid = wgid / nig, fm = gid * WGM, gsz = (nM - fm) < WGM ? (nM - fm) : WGM;
        u.pm = fm + ((wgid % nig) % gsz); u.pn = (wgid % nig) / gsz; u.ko = 0; u.ks = 0; return true;
    }
    __device__ __forceinline__ void a_ready(const Unit&) const {}
    __device__ __forceinline__ void done(const Unit&) const {}
};
struct SplitOrder {
    int nN, nsplit, ksub, G, c;
    __host__ __device__ bool next(int i, Unit& u) const { const long L = (long)i * G + c; if (L >= (long)nN * nsplit) return false; u.pm = 0; u.pn = (int)(L % nN); u.ks = (int)(L / nN); u.ko = u.ks * ksub; return true; }
    __device__ __forceinline__ void a_ready(const Unit&) const {}
    __device__ __forceinline__ void done(const Unit&) const {}
};
typedef float cvt_f2 __attribute__((ext_vector_type(2)));
typedef __bf16 cvt_b2 __attribute__((ext_vector_type(2)));
__device__ __forceinline__ unsigned cvt_pk_bf16(float lo, float hi) { const cvt_f2 v = {lo, hi}; return __builtin_bit_cast(unsigned, __builtin_convertvector(v, cvt_b2)); }
typedef float f32x2 __attribute__((ext_vector_type(2)));
__device__ __forceinline__ f32x2 gelu_pk(f32x2 v) {
    const f32x2 av = __builtin_elementwise_abs(v), d = av * 0.2316418882f + 1.0f;
    f32x2 t; t.x = __builtin_amdgcn_rcpf(d.x); t.y = __builtin_amdgcn_rcpf(d.y);
    f32x2 q = t * 0.5307027145f + (-0.7265760135f); q = q * t + 0.7107068705f; q = q * t + (-0.142248368f); q = q * t + 0.127414796f; q = q * t;
    const f32x2 s = (v * v) * (-0.72134752044f);
    f32x2 e; e.x = __builtin_amdgcn_exp2f(s.x); e.y = __builtin_amdgcn_exp2f(s.y);
    const f32x2 m = v * (q * e), r = v - m;
    f32x2 o; o.x = v.x < 0.f ? m.x : r.x; o.y = v.y < 0.f ? m.y : r.y; return o;
}

struct EpiF32 {
    static constexpr bool PERM = false, AFTER_DRAIN = false;
    float* C0; int ldc; const float* bias; size_t slab;
    __device__ __forceinline__ void operator()(const f32x4 (&acc)[2][2][4][2], const Unit& u, int wr, int wc, int fr, int fq) const {
        float* C = C0 + (size_t)u.ks * slab;
        const int row0 = u.pm * BM + wr * 64 + fr, col0 = u.pn * BM + wc * 32 + 4 * fq;
        f32x4 bv[2][2];
#pragma unroll
        for (int bj = 0; bj < 2; ++bj)
#pragma unroll
            for (int n = 0; n < 2; ++n) bv[bj][n] = bias ? *(const f32x4*)(bias + col0 + bj * HALF + n * 16) : (f32x4){0.f, 0.f, 0.f, 0.f};
#pragma unroll
        for (int ai = 0; ai < 2; ++ai)
#pragma unroll
            for (int m = 0; m < 4; ++m) { float* rowp = C + (size_t)(row0 + ai * HALF + m * 16) * ldc + col0;
#pragma unroll
                for (int bj = 0; bj < 2; ++bj)
#pragma unroll
                    for (int n = 0; n < 2; ++n) *(f32x4*)(rowp + bj * HALF + n * 16) = acc[ai][bj][m][n] + bv[bj][n]; }
    }
};
struct EpiB16 {
    static constexpr bool PERM = true, AFTER_DRAIN = false;
    bf16_t* O; int ldc;
    __device__ __forceinline__ void operator()(const f32x4 (&acc)[2][2][4][2], const Unit& u, int wr, int wc, int fr, int fq) const {
        const int row0 = u.pm * BM + wr * 64 + fr, col0 = u.pn * BM + wc * 32 + 8 * fq;
#pragma unroll
        for (int ai = 0; ai < 2; ++ai)
#pragma unroll
            for (int m = 0; m < 4; ++m) { bf16_t* rowp = O + (size_t)(row0 + ai * HALF + m * 16) * ldc + col0;
#pragma unroll
                for (int bj = 0; bj < 2; ++bj) { const f32x4 v0 = acc[ai][bj][m][0], v1 = acc[ai][bj][m][1];
                    u32x4 w; w.x = cvt_pk_bf16(v0[0], v0[1]); w.y = cvt_pk_bf16(v0[2], v0[3]); w.z = cvt_pk_bf16(v1[0], v1[1]); w.w = cvt_pk_bf16(v1[2], v1[3]);
                    *(u32x4*)(rowp + bj * HALF) = w; } }
    }
};
template <class Epi, class Sched, bool STAMP = false>
__device__ __forceinline__ void gemm_phase(PG8_LAS unsigned char* lds, const Gemm g, const Sched& S, const Epi& E, unsigned long long* stamps) {
    int tid_ = threadIdx.x; asm volatile("" : "+v"(tid_));
    const int tid = tid_, wid = __builtin_amdgcn_readfirstlane(tid >> 6), lane = tid & 63, wr = wid >> 2, wc = wid & 3, fr = lane & 15, fq = lane >> 4;
    const int K = g.K, nt = K / BK;
    int ts_lo = 0, ts_hi = 0, nts = 0; const unsigned long long rt_entry = STAMP ? (unsigned long long)wall_clock64() : 0ull;
#define PG8_STAMP() do { if (STAMP && wid == 0 && nts < 64) { const unsigned long long _c = (unsigned long long)clock64(); \
        ts_lo = (lane == nts) ? (int)(unsigned)_c : ts_lo; ts_hi = (lane == nts) ? (int)(unsigned)(_c >> 32) : ts_hi; ++nts; } } while (0)
    PG8_STAMP();
    unsigned voffA[2], voffB[2];
#pragma unroll
    for (int i = 0; i < 2; ++i) { int R, C; stage_rc(tid * 16 + i * 8192, R, C); const int Rb = Epi::PERM ? ((R & ~31) + perm32(R & 31)) : R;
        voffA[i] = (unsigned)(R * g.ld + C) * 2u; voffB[i] = (unsigned)(Rb * g.ld + C) * 2u; }
    const size_t kstep = (size_t)(BK * 2);
    const size_t hstep = (size_t)HALF * g.ld * 2;
    const size_t tstep = 2 * hstep;
    const unsigned ldsw = (unsigned)wid * 1024u;
    const int aoff = lds_byte(wr * 64 + fr, fq * 8), boff = lds_byte(wc * 32 + fr, fq * 8);
#define PG8_SA(b, h) (((b) * 2 + (h)) * HTB)
#define PG8_SB(b, h) ((4 + (b) * 2 + (h)) * HTB)
#define PG8_STAGE(bufoff, gbase, voff) do { _Pragma("unroll") for (int _i = 0; _i < 2; ++_i) \
        __builtin_amdgcn_global_load_lds((const unsigned*)((const char*)(gbase) + (voff)[_i]), (PG8_LAS unsigned*)(lds + (bufoff) + ldsw + _i * 8192), 16, 0, 0); } while (0)
#define PG8_LDA(dst, b, h) do { _Pragma("unroll") for (int m = 0; m < 4; ++m) _Pragma("unroll") for (int k = 0; k < 2; ++k) dst[m][k] = *(const PG8_LAS bf16x8*)(lds + PG8_SA(b, h) + aoff + m * 2048 + k * 1024); } while (0)
#define PG8_LDB(dst, b, h) do { _Pragma("unroll") for (int n = 0; n < 2; ++n) _Pragma("unroll") for (int k = 0; k < 2; ++k) dst[n][k] = *(const PG8_LAS bf16x8*)(lds + PG8_SB(b, h) + boff + n * 2048 + k * 1024); } while (0)
#define PG8_MMA(ai, bj, At, Bt) do { __builtin_amdgcn_s_setprio(1); _Pragma("unroll") for (int m = 0; m < 4; ++m) _Pragma("unroll") for (int n = 0; n < 2; ++n) _Pragma("unroll") for (int k = 0; k < 2; ++k) \
        acc[ai][bj][m][n] = __builtin_amdgcn_mfma_f32_16x16x32_bf16(Bt[n][k], At[m][k], acc[ai][bj][m][n], 0, 0, 0); __builtin_amdgcn_s_setprio(0); } while (0)
#define PG8_WAIT_V(n) asm volatile("s_waitcnt vmcnt(" #n ")" ::: "memory")
#define PG8_WAIT_L(n) asm volatile("s_waitcnt lgkmcnt(" #n ")" ::: "memory")
#define PG8_BAR __builtin_amdgcn_s_barrier()
#define PG8_SCHED __builtin_amdgcn_sched_barrier(0)
    Unit cur, nxt; int ui = 0;
    if (!S.next(0, cur)) return;
    f32x4 acc[2][2][4][2];
#pragma unroll
    for (int a = 0; a < 2; ++a)
#pragma unroll
        for (int b = 0; b < 2; ++b)
#pragma unroll
            for (int m = 0; m < 4; ++m)
#pragma unroll
                for (int n = 0; n < 2; ++n) acc[a][b][m][n] = (f32x4){0.f, 0.f, 0.f, 0.f};
    bf16x8 At[4][2], B0[2][2], B1[2][2];
    const char* cA = (const char*)g.A + (size_t)cur.pm * tstep + (size_t)cur.ko * 2; const char* cB = (const char*)g.Bt + (size_t)cur.pn * tstep + (size_t)cur.ko * 2;
    S.a_ready(cur);
    PG8_STAGE(PG8_SB(0, 0), cB, voffB); PG8_STAGE(PG8_SA(0, 0), cA, voffA); PG8_STAGE(PG8_SB(0, 1), cB + hstep, voffB); PG8_STAGE(PG8_SA(0, 1), cA + hstep, voffA);
    if (wr == 1) PG8_BAR;
    PG8_WAIT_V(4); PG8_BAR;
    PG8_STAGE(PG8_SB(1, 0), cB + kstep, voffB); PG8_STAGE(PG8_SA(1, 0), cA + kstep, voffA); PG8_STAGE(PG8_SB(1, 1), cB + hstep + kstep, voffB);
    PG8_WAIT_V(6); PG8_BAR;
    PG8_STAMP();
    for (;;) {
        const bool has_next = S.next(ui + 1, nxt);
        const char* nA = has_next ? (const char*)g.A + (size_t)nxt.pm * tstep + (size_t)nxt.ko * 2 : cA; const char* nB = has_next ? (const char*)g.Bt + (size_t)nxt.pn * tstep + (size_t)nxt.ko * 2 : cB;
        for (int t = 0; t < nt; t += 2) {
            const bool last = (t == nt - 2);
            const char* a1 = cA + (size_t)(t + 1) * kstep;
            const char* a2 = last ? nA : cA + (size_t)(t + 2) * kstep; const char* b2 = last ? nB : cB + (size_t)(t + 2) * kstep;
            const char* a3 = a2 + kstep; const char* b3 = b2 + kstep;
            if (last && has_next) S.a_ready(nxt);
            PG8_LDB(B0, 0, 0); PG8_SCHED; PG8_LDA(At, 0, 0); PG8_STAGE(PG8_SA(1, 1), a1 + hstep, voffA);
            PG8_WAIT_L(8); PG8_BAR; PG8_WAIT_L(0); PG8_MMA(0, 0, At, B0); PG8_BAR; PG8_SCHED;
            PG8_LDB(B1, 0, 1); PG8_STAGE(PG8_SB(0, 0), b2, voffB);
            PG8_BAR; PG8_WAIT_L(0); PG8_MMA(0, 1, At, B1); PG8_BAR;
            PG8_LDA(At, 0, 1); PG8_STAGE(PG8_SA(0, 0), a2, voffA);
            PG8_BAR; PG8_WAIT_L(0); PG8_MMA(1, 0, At, B0); PG8_BAR; PG8_SCHED;
            PG8_STAGE(PG8_SB(0, 1), b2 + hstep, voffB);
            PG8_WAIT_V(6); PG8_BAR; PG8_MMA(1, 1, At, B1); PG8_BAR;
            PG8_LDB(B0, 1, 0); PG8_SCHED; PG8_LDA(At, 1, 0); PG8_STAGE(PG8_SA(0, 1), a2 + hstep, voffA);
            PG8_WAIT_L(8); PG8_BAR; PG8_WAIT_L(0); PG8_MMA(0, 0, At, B0); PG8_BAR; PG8_SCHED;
            PG8_LDB(B1, 1, 1); PG8_STAGE(PG8_SB(1, 0), b3, voffB);
            PG8_BAR; PG8_WAIT_L(0); PG8_MMA(0, 1, At, B1); PG8_BAR;
            PG8_LDA(At, 1, 1); PG8_STAGE(PG8_SA(1, 0), a3, voffA);
            PG8_BAR; PG8_WAIT_L(0); PG8_MMA(1, 0, At, B0); PG8_BAR; PG8_SCHED;
            PG8_STAGE(PG8_SB(1, 1), b3 + hstep, voffB);
            PG8_WAIT_V(6); PG8_BAR; PG8_MMA(1, 1, At, B1); PG8_BAR;
        }
        PG8_STAMP();
        if constexpr (!Epi::AFTER_DRAIN) { E(acc, cur, wr, wc, fr, fq); S.done(cur); }
        PG8_STAMP();
        if (!has_next) break;
#pragma unroll
        for (int a = 0; a < 2; ++a)
#pragma unroll
            for (int b = 0; b < 2; ++b)
#pragma unroll
                for (int m = 0; m < 4; ++m)
#pragma unroll
                    for (int n = 0; n < 2; ++n) acc[a][b][m][n] = (f32x4){0.f, 0.f, 0.f, 0.f};
        cur = nxt; cA = nA; cB = nB; ++ui;
    }
    PG8_WAIT_V(0);
    if (wr == 0) PG8_BAR;
    PG8_BAR;
    if constexpr (Epi::AFTER_DRAIN) { E.fused(acc, cur, wr, wc, fr, fq, lds, wid, lane); S.done(cur); }
    PG8_STAMP();
    if (STAMP && wid == 0) { stamps[lane] = lane < nts ? (((unsigned long long)(unsigned)ts_hi << 32) | (unsigned)ts_lo) : 0ull;
        if (lane == 62) stamps[62] = rt_entry; if (lane == 63) stamps[63] = (unsigned long long)wall_clock64(); }
#undef PG8_STAMP
#undef PG8_SA
#undef PG8_SB
#undef PG8_STAGE
#undef PG8_LDA
#undef PG8_LDB
#undef PG8_MMA
#undef PG8_WAIT_V
#undef PG8_WAIT_L
#undef PG8_BAR
#undef PG8_SCHED
}

struct EpiSwiGLU {
    static constexpr bool PERM = true, AFTER_DRAIN = false;
    bf16_t* O; int ldc;
    __device__ __forceinline__ void operator()(const f32x4 (&acc)[2][2][4][2], const Unit& u, int wr, int wc, int fr, int fq) const {
        const int row0 = u.pm * BM + wr * 64 + fr, col0 = u.pn * HALF + wc * 32 + 8 * fq;
#pragma unroll
        for (int ai = 0; ai < 2; ++ai)
#pragma unroll
            for (int m = 0; m < 4; ++m) {
                bf16_t* rowp = O + (size_t)(row0 + ai * HALF + m * 16) * ldc + col0;
                float r[8];
#pragma unroll
                for (int n = 0; n < 2; ++n)
#pragma unroll
                    for (int j = 0; j < 4; ++j) { const float g = acc[ai][0][m][n][j], up = acc[ai][1][m][n][j];
                        r[n * 4 + j] = g * __builtin_amdgcn_rcpf(1.0f + __expf(-g)) * up; }
                u32x4 w; w.x = cvt_pk_bf16(r[0], r[1]); w.y = cvt_pk_bf16(r[2], r[3]); w.z = cvt_pk_bf16(r[4], r[5]); w.w = cvt_pk_bf16(r[6], r[7]);
                *(u32x4*)rowp = w;
            }
    }
};
}

#define WAVE_SYNC() asm volatile("s_waitcnt lgkmcnt(0)" ::: "memory")
template <int CTRL> __device__ __forceinline__ float dpp_mov(float v) { return __builtin_bit_cast(float, __builtin_amdgcn_update_dpp(0, __builtin_bit_cast(int, v), CTRL, 0xF, 0xF, true)); }
__device__ __forceinline__ float xor16_get(float v, float& other) {
    const unsigned u = __builtin_bit_cast(unsigned, v);
    auto r = __builtin_amdgcn_permlane16_swap(u, u, false, false);
    other = __builtin_bit_cast(float, (unsigned)r[1]); return __builtin_bit_cast(float, (unsigned)r[0]);
}
__device__ __forceinline__ float xor32_get(float v, float& other) {
    const unsigned u = __builtin_bit_cast(unsigned, v);
    auto r = __builtin_amdgcn_permlane32_swap(u, u, false, false);
    other = __builtin_bit_cast(float, (unsigned)r[1]); return __builtin_bit_cast(float, (unsigned)r[0]);
}
__device__ __forceinline__ float red16(float v) {
    v += dpp_mov<0xB1>(v);
    v += dpp_mov<0x4E>(v);
    v += dpp_mov<0x124>(v);
    v += dpp_mov<0x128>(v);
    return v;
}
__device__ __forceinline__ float max16(float v) {
    v = fmaxf(v, dpp_mov<0xB1>(v)); v = fmaxf(v, dpp_mov<0x4E>(v)); v = fmaxf(v, dpp_mov<0x124>(v)); v = fmaxf(v, dpp_mov<0x128>(v));
    return v;
}
__device__ __forceinline__ float sum_q(float v) {
    float o; float a = xor16_get(v, o); v = a + o; a = xor32_get(v, o); return a + o;
}
__device__ __forceinline__ float max_q(float v) {
    float o; float a = xor16_get(v, o); v = fmaxf(a, o); a = xor32_get(v, o); return fmaxf(a, o);
}
__device__ __forceinline__ float sum_quad(float v) { v += dpp_mov<0xB1>(v); v += dpp_mov<0x4E>(v); return v; }
__device__ __forceinline__ float wave_sum(float v) { return sum_q(red16(v)); }
__device__ __forceinline__ float wave_max(float v) { return max_q(max16(v)); }
__device__ __forceinline__ float4 ldnt4(const float* p) { typedef float f4v __attribute__((ext_vector_type(4))); const f4v v = __builtin_nontemporal_load((const f4v*)p); return make_float4(v[0], v[1], v[2], v[3]); }
__device__ __forceinline__ float dot4(const float4& a, const float4& b) { return a.x * b.x + a.y * b.y + a.z * b.z + a.w * b.w; }
__device__ __forceinline__ float sigmoidf_(float x) { return 1.0f / (1.0f + __expf(-x)); }
__device__ __forceinline__ float siluf_(float x) { return x / (1.0f + __expf(-x)); }

__constant__ double ROPE_INV[8] = {1.0, 0.19392274474868576, 0.03760603093086393, 0.007292664737217109, 0.001414213562373095, 0.0002742481756762073, 5.318295896944988e-05, 1.031338537721246e-05};

struct Ctx {
    const Params* p;
    unsigned char* ws;
    float* out;
    unsigned char* lds;
    int tid, lane, wave, bid, G;
};
#define WSP(T, off) ((T*)(c.ws + (off)))

struct TileD { const float* src; bf16_t* dst; int ldsrc, c0, nvalid, k0, K, n0; };
constexpr int NT_GU = (DM / 64) * (NGU / 64), NT_DN = (DFF / 64) * (DM / 64), NT_IN = (DM / 64) * (NINP / 64), NT_OUT = (DM / 64) * (DM / 64);
constexpr int NT_ALL = 2 * NT_GU + 2 * NT_DN + NT_IN + NT_OUT;
__device__ __forceinline__ TileD tile_desc(const Ctx& c, int t) {
    TileD d;
    d.src = t < NT_GU ? c.p->in[9] : t < 2 * NT_GU ? c.p->in[33] : t < 2 * NT_GU + NT_DN ? c.p->in[10] : t < 2 * NT_GU + 2 * NT_DN ? c.p->in[34] : t < 2 * NT_GU + 2 * NT_DN + NT_IN ? c.p->in[12] : c.p->in[30];
    if (t < 2 * NT_GU) { const int w = t >= NT_GU; t -= w * NT_GU; const int nkt = DM / 64, kt = t % nkt, rr = (t / nkt) * 64;
         d.dst = (bf16_t*)(c.ws + (w ? WS_WGU2 : WS_WGU1)); d.ldsrc = NGU; d.c0 = ((rr % 256) / 128) * DFF + 128 * (rr / 256) + (rr % 128); d.nvalid = 64; d.k0 = kt * 64; d.K = DM; d.n0 = rr; return d; }
    t -= 2 * NT_GU;
    if (t < 2 * NT_DN) { const int w = t >= NT_DN; t -= w * NT_DN; const int nkt = DFF / 64, kt = t % nkt, nt = t / nkt;
         d.dst = (bf16_t*)(c.ws + (w ? WS_WDN2 : WS_WDN1)); d.ldsrc = DM; d.c0 = nt * 64; d.nvalid = 64; d.k0 = kt * 64; d.K = DFF; d.n0 = nt * 64; return d; }
    t -= 2 * NT_DN;
    if (t < NT_IN) { const int nkt = DM / 64, kt = t % nkt, nt = t / nkt; int nv = NIN - nt * 64; nv = nv < 0 ? 0 : (nv > 64 ? 64 : nv);
        d.dst = (bf16_t*)(c.ws + WS_WIN); d.ldsrc = NIN; d.c0 = nt * 64; d.nvalid = nv; d.k0 = kt * 64; d.K = DM; d.n0 = nt * 64; return d; }
    t -= NT_IN;
    { const int nkt = DM / 64, kt = t % nkt, nt = t / nkt;
        d.dst = (bf16_t*)(c.ws + WS_WOUT); d.ldsrc = DM; d.c0 = nt * 64; d.nvalid = 64; d.k0 = kt * 64; d.K = DM; d.n0 = nt * 64; return d; }
}
__device__ __forceinline__ void tile_load(const TileD& d, int tid, float4& a, float4& b) {
    const int k = tid >> 3, c8 = (tid & 7) * 8;
    const float* s0 = d.src + (size_t)d.k0 * d.ldsrc + (d.nvalid > 0 ? d.c0 : 0);
    const float* s = d.src + (size_t)(d.k0 + k) * d.ldsrc + d.c0 + c8;
    const float* sa = c8 < d.nvalid ? s : s0; const float* sb = c8 + 4 < d.nvalid ? s + 4 : s0;
    a = *(const float4*)sa; b = *(const float4*)sb;
}
__device__ __forceinline__ void convert_weights(const Ctx& c) {
    const int tid = c.tid;
    float* T0 = (float*)c.lds;
    float4 a0, b0, a1, b1, a2, b2, a3, b3;
    int par = 0;
#define CW_LOAD(av, bv, dv, tt) { const int tc_ = (tt) < NT_ALL ? (tt) : NT_ALL - 1; dv = tile_desc(c, tc_); tile_load(dv, tid, av, bv); }
#define CW_STEP(av, bv, dv, tt) { const TileD d = dv; float* T = T0 + par * (64 * 65); \
        { const int k = tid >> 3, c8 = (tid & 7) * 8; float* tp = T + k * 65 + c8; const bool va_ = c8 < d.nvalid, vb_ = c8 + 4 < d.nvalid; \
          tp[0] = va_ ? av.x : 0.f; tp[1] = va_ ? av.y : 0.f; tp[2] = va_ ? av.z : 0.f; tp[3] = va_ ? av.w : 0.f; tp[4] = vb_ ? bv.x : 0.f; tp[5] = vb_ ? bv.y : 0.f; tp[6] = vb_ ? bv.z : 0.f; tp[7] = vb_ ? bv.w : 0.f; } \
        CW_LOAD(av, bv, dv, (tt) + 4 * c.G) \
        __syncthreads(); \
        { const int kg = tid & 7, n = tid >> 3; unsigned w[4]; \
          _Pragma("unroll") for (int j = 0; j < 4; ++j) w[j] = pack2bf(T[(kg * 8 + 2 * j) * 65 + n], T[(kg * 8 + 2 * j + 1) * 65 + n]); \
          *(uint4*)(d.dst + (size_t)(d.n0 + n) * d.K + d.k0 + kg * 8) = make_uint4(w[0], w[1], w[2], w[3]); } \
        par ^= 1; }
    TileD d0, d1, d2, d3;
    CW_LOAD(a0, b0, d0, c.bid) CW_LOAD(a1, b1, d1, c.bid + c.G) CW_LOAD(a2, b2, d2, c.bid + 2 * c.G) CW_LOAD(a3, b3, d3, c.bid + 3 * c.G)
#pragma unroll 1
    for (int t = c.bid; t < NT_ALL; t += 4 * c.G) {
        CW_STEP(a0, b0, d0, t)
        CW_STEP(a1, b1, d1, t + c.G)
        CW_STEP(a2, b2, d2, t + 2 * c.G)
        CW_STEP(a3, b3, d3, t + 3 * c.G)
    }
#undef CW_LOAD
#undef CW_STEP
    __syncthreads();
}

__device__ __forceinline__ void row_norm_bf16(const float* x, const float* g, bf16_t* a, int lane) {
    float4 v[8]; float ss = 0.f;
#pragma unroll
    for (int i = 0; i < 8; ++i) { v[i] = *(const float4*)(x + (i * 64 + lane) * 4); ss += dot4(v[i], v[i]); }
    ss = wave_sum(ss);
    const float s = rsqrtf(ss * (1.0f / DM) + RMS_EPS);
#pragma unroll
    for (int i = 0; i < 8; ++i) { const float4 gg = *(const float4*)(g + (i * 64 + lane) * 4);
        *(uint2*)(a + (i * 64 + lane) * 4) = make_uint2(pack2bf(v[i].x * s * gg.x, v[i].y * s * gg.y), pack2bf(v[i].z * s * gg.z, v[i].w * s * gg.w)); }
}

__device__ __forceinline__ const float* x_row(const Ctx& c, int row) { return row < NPR ? c.p->in[0] + (size_t)row * DM : c.p->in[1] + (size_t)(row - NPR) * DM; }

__device__ __forceinline__ void p0_prologue(const Ctx& c) {
    convert_weights(c);
#pragma unroll 1
    for (int r = c.bid * NWAVES + c.wave; r < NR; r += c.G * NWAVES)
        row_norm_bf16(x_row(c, r), c.p->in[7], WSP(bf16_t, WS_A1) + (size_t)r * DM, c.lane);
#pragma unroll 1
    for (int e = c.bid * NTHREADS + c.tid; e < 4096 * 8; e += c.G * NTHREADS) {
        const int pos = e >> 3, i = e & 7;
        const double inv = ROPE_INV[i];
        double rev = (double)pos * inv * 0.15915494309189535;
        rev -= floor(rev);
        const float a = (float)(rev * 6.283185307179586);
        float* rt = WSP(float, WS_ROPE) + pos * 16;
        rt[i] = cosf(a); rt[8 + i] = sinf(a);
    }
#pragma unroll 1
    for (int e = c.bid * NTHREADS + c.tid; e < 2 * 16 * 256 * 64; e += c.G * NTHREADS) {
        const int d = e & 63, n = (e >> 6) & 255, sl = (e >> 14) & 15, kv = e >> 18, hf = n >> 7, h = n & 127;
        WSP(bf16_t, WS_W1T)[e] = f2bf(c.p->in[kv ? 17 : 14][((size_t)(hf * 16 + sl) * 64 + d) * 128 + h]);
    }
#pragma unroll 1
    for (int e = c.bid * NTHREADS + c.tid; e < 2 * 64 * 128; e += c.G * NTHREADS) {
        const int h = e & 127, dd = (e >> 7) & 63, kv = e >> 13;
        WSP(bf16_t, WS_W2T)[e] = f2bf(c.p->in[kv ? 18 : 15][h * 64 + dd]);
    }
#pragma unroll 1
    for (int o = c.bid * NWAVES + c.wave; o < 256; o += c.G * NWAVES) {
        const int kv = o >> 7, h = o & 127; const float* pe = c.p->in[kv ? 16 : 13]; const float* w1 = c.p->in[kv ? 17 : 14];
        float s = 0.f;
#pragma unroll
        for (int i = 0; i < 32; ++i) { const int k = i * 64 + c.lane; s += pe[k] * w1[(size_t)k * 128 + h]; }
        s = wave_sum(s);
        if (c.lane == 0) WSP(float, WS_PET)[o] = s;
    }
#pragma unroll 1
    for (int e = c.bid * NTHREADS + c.tid; e < 1024 * 64; e += c.G * NTHREADS) { const int k = e & 63, n = e >> 6;
        WSP(bf16_t, WS_LW2T)[e] = f2bf(c.p->in[21][k * 1024 + n]); WSP(bf16_t, WS_LA2T)[e] = f2bf(c.p->in[23][k * 1024 + n]); }
#pragma unroll 1
    for (int e = c.bid * NTHREADS + c.tid; e < 1024 * 160; e += c.G * NTHREADS) { const int k = e % 160, n = e / 160;
        WSP(bf16_t, WS_LG2T)[e] = f2bf(c.p->in[24][k * 1024 + n]); }
}

struct ThinRow { float4 v[8]; float ss; };
__device__ __forceinline__ void thin_load(const Ctx& c, ThinRow& t, const float* O, int nsplit, int r) {
    t.ss = 0.f;
#pragma unroll
    for (int i = 0; i < 8; ++i) {
        if (r < NPR) { const uint2 w = *(const uint2*)((const bf16_t*)O + (size_t)r * DM + (i * 64 + c.lane) * 4);
            t.v[i] = make_float4(__uint_as_float(w.x << 16), __uint_as_float(w.x & 0xffff0000u), __uint_as_float(w.y << 16), __uint_as_float(w.y & 0xffff0000u)); }
        else { const float* os = WSP(const float, WS_OS) + (size_t)(r - NPR) * DM + (i * 64 + c.lane) * 4; float4 a = *(const float4*)os;
            for (int sp = 1; sp < nsplit; ++sp) { const float4 x = *(const float4*)(os + (size_t)sp * 256 * DM); a.x += x.x; a.y += x.y; a.z += x.z; a.w += x.w; }
            t.v[i] = a; }
        t.ss += dot4(t.v[i], t.v[i]); }
}
__device__ __forceinline__ void thin_finish(const Ctx& c, ThinRow& t, int r, int base_kind, const float* gpost, float scale, float* hout, const float* gpre, bf16_t* aout) {
    const float* bs = base_kind == 0 ? x_row(c, r) : (base_kind == 1 ? WSP(const float, WS_H1) : WSP(const float, WS_H2)) + (size_t)r * DM;
    float4 b[8];
#pragma unroll
    for (int i = 0; i < 8; ++i) b[i] = *(const float4*)(bs + (i * 64 + c.lane) * 4);
    const float ss = wave_sum(t.ss);
    const float s = rsqrtf(ss * (1.0f / DM) + RMS_EPS) * scale;
    float s2 = 0.f;
#pragma unroll
    for (int i = 0; i < 8; ++i) { const float4 gg = *(const float4*)(gpost + (i * 64 + c.lane) * 4);
        t.v[i].x = b[i].x + t.v[i].x * s * gg.x; t.v[i].y = b[i].y + t.v[i].y * s * gg.y; t.v[i].z = b[i].z + t.v[i].z * s * gg.z; t.v[i].w = b[i].w + t.v[i].w * s * gg.w;
        *(float4*)(hout + (size_t)r * DM + (i * 64 + c.lane) * 4) = t.v[i]; s2 += dot4(t.v[i], t.v[i]); }
    if (aout) {
        s2 = wave_sum(s2);
        const float q = rsqrtf(s2 * (1.0f / DM) + RMS_EPS);
#pragma unroll
        for (int i = 0; i < 8; ++i) { const float4 gg = *(const float4*)(gpre + (i * 64 + c.lane) * 4);
            *(uint2*)(aout + (size_t)r * DM + (i * 64 + c.lane) * 4) = make_uint2(pack2bf(t.v[i].x * q * gg.x, t.v[i].y * q * gg.y), pack2bf(t.v[i].z * q * gg.z, t.v[i].w * q * gg.w)); }
    }
}
__device__ __forceinline__ float block_sum(const Ctx& c, float v, float* red) {
    v = wave_sum(v);
    __syncthreads();
    if (c.lane == 0) red[c.wave] = v;
    __syncthreads();
    return ((red[0] + red[1]) + (red[2] + red[3])) + ((red[4] + red[5]) + (red[6] + red[7]));
}
__device__ __forceinline__ void thin_norm(const Ctx& c, const float* O, int nsplit  , int base_kind  , const float* gpost, float scale, float* hout, const float* gpre, bf16_t* aout) {
    const int stride = c.G * NWAVES;
#pragma unroll 1
    for (int r = c.bid * NWAVES + c.wave; r < NPR; r += 2 * stride) {
        const int r2 = r + stride; const bool two = r2 < NPR;
        ThinRow t0, t1;
        thin_load(c, t0, O, nsplit, r);
        if (two) thin_load(c, t1, O, nsplit, r2);
        thin_finish(c, t0, r, base_kind, gpost, scale, hout, gpre, aout);
        if (two) thin_finish(c, t1, r2, base_kind, gpost, scale, hout, gpre, aout);
    }
    if (c.bid < NSM) {
        const int r = NPR + c.bid, col = c.tid * 4;
        float* red = (float*)c.lds;
        const float* os = WSP(const float, WS_OS) + (size_t)c.bid * DM + col;
        float4 a = *(const float4*)os;
        for (int sp = 1; sp < nsplit; ++sp) { const float4 x = *(const float4*)(os + (size_t)sp * 256 * DM); a.x += x.x; a.y += x.y; a.z += x.z; a.w += x.w; }
        const float* bs = base_kind == 0 ? x_row(c, r) : (base_kind == 1 ? WSP(const float, WS_H1) : WSP(const float, WS_H2)) + (size_t)r * DM;
        const float4 b = *(const float4*)(bs + col), gg = *(const float4*)(gpost + col);
        const float ss = block_sum(c, dot4(a, a), red);
        const float sc = rsqrtf(ss * (1.0f / DM) + RMS_EPS) * scale;
        float4 h; h.x = b.x + a.x * sc * gg.x; h.y = b.y + a.y * sc * gg.y; h.z = b.z + a.z * sc * gg.z; h.w = b.w + a.w * sc * gg.w;
        *(float4*)(hout + (size_t)r * DM + col) = h;
        if (aout) {
            const float s2 = block_sum(c, dot4(h, h), red);
            const float q = rsqrtf(s2 * (1.0f / DM) + RMS_EPS);
            const float4 gp = *(const float4*)(gpre + col);
            *(uint2*)(aout + (size_t)r * DM + col) = make_uint2(pack2bf(h.x * q * gp.x, h.y * q * gp.y), pack2bf(h.z * q * gp.z, h.w * q * gp.w));
        }
    }
}

__device__ __forceinline__ int row_pos(int row) { return row < NPR ? (row & (SEQ - 1)) : PAST; }

__device__ __forceinline__ float rope_elem(const float* h16, const float* cs, int d) {
    return d < 8 ? h16[d] * cs[d] - h16[d + 8] * cs[8 + d] : h16[d] * cs[d - 8] + h16[d - 8] * cs[d];
}

constexpr float QSCALE = 0.18033688011112042f;
__device__ __forceinline__ float4 rope4(float4 x, int c16, float4 cs4, float4 sn4) {
    float4 p; p.x = dpp_mov<0x4E>(x.x); p.y = dpp_mov<0x4E>(x.y); p.z = dpp_mov<0x4E>(x.z); p.w = dpp_mov<0x4E>(x.w);
    const float sg = (c16 & 2) ? 1.0f : -1.0f; const bool rot = c16 < 4;
    float4 o;
    o.x = rot ? x.x * cs4.x + sg * p.x * sn4.x : x.x; o.y = rot ? x.y * cs4.y + sg * p.y * sn4.y : x.y;
    o.z = rot ? x.z * cs4.z + sg * p.z * sn4.z : x.z; o.w = rot ? x.w * cs4.w + sg * p.w * sn4.w : x.w;
    return o;
}
__device__ __forceinline__ uint2 bf4(float4 v, float sc) { return make_uint2(pg8::cvt_pk_bf16(v.x * sc, v.y * sc), pg8::cvt_pk_bf16(v.z * sc, v.w * sc)); }
__device__ __forceinline__ void p5a_nsa_prep(const Ctx& c, int grp) {
    const float* COLS = WSP(const float, WS_COLS);
    const float* ROPE = WSP(const float, WS_ROPE);
    const int lane = c.lane, c16 = lane & 15;
#pragma unroll 1
    for (int row = grp * 32 + c.wave * 4; row < grp * 32 + c.wave * 4 + 4; ++row) {
        const float* cr = COLS + (size_t)row * NINP;
        const int pos = row_pos(row);
        const float4 cs4 = *(const float4*)(ROPE + pos * 16 + 4 * (c16 & 1)), sn4 = *(const float4*)(ROPE + pos * 16 + 8 + 4 * (c16 & 1));
        float* kvo = c.out + O_KV + (size_t)row * 1024;
        const bool pr = row < NPR;
        const float4 q0 = *(const float4*)(cr + lane * 4), q1 = *(const float4*)(cr + (lane + 64) * 4), q2 = *(const float4*)(cr + (lane + 128) * 4), q3 = *(const float4*)(cr + (lane + 192) * 4);
        const float4 kc = *(const float4*)(cr + 1024 + lane * 4), vc = *(const float4*)(cr + 1280 + lane * 4), ksv = *(const float4*)(cr + 1536 + lane * 4),
                     vs = *(const float4*)(cr + 1792 + lane * 4), kwv = *(const float4*)(cr + 2048 + lane * 4), vw = *(const float4*)(cr + 2304 + lane * 4);
        const float4 r0 = rope4(q0, c16, cs4, sn4), r1 = rope4(q1, c16, cs4, sn4), r2 = rope4(q2, c16, cs4, sn4), r3 = rope4(q3, c16, cs4, sn4);
        const float4 ksr = rope4(ksv, c16, cs4, sn4), kwr = rope4(kwv, c16, cs4, sn4);
        *(float4*)(kvo + lane * 4) = kc; *(float4*)(kvo + 256 + lane * 4) = vc; *(float4*)(kvo + 512 + lane * 4) = ksr; *(float4*)(kvo + 768 + lane * 4) = vs;
        if (pr) {
            bf16_t* qrb = WSP(bf16_t, WS_QRB) + (size_t)row * 1024 + lane * 4; bf16_t* qsb = WSP(bf16_t, WS_QSB) + (size_t)row * 1024 + lane * 4;
            *(uint2*)(qrb) = bf4(q0, QSCALE); *(uint2*)(qrb + 256) = bf4(q1, QSCALE); *(uint2*)(qrb + 512) = bf4(q2, QSCALE); *(uint2*)(qrb + 768) = bf4(q3, QSCALE);
            *(uint2*)(qsb) = bf4(r0, QSCALE); *(uint2*)(qsb + 256) = bf4(r1, QSCALE); *(uint2*)(qsb + 512) = bf4(r2, QSCALE); *(uint2*)(qsb + 768) = bf4(r3, QSCALE);
            *(uint2*)(WSP(bf16_t, WS_KSB) + (size_t)row * 256 + lane * 4) = bf4(ksr, 1.0f); *(uint2*)(WSP(bf16_t, WS_VSB) + (size_t)row * 256 + lane * 4) = bf4(vs, 1.0f);
            *(uint2*)(WSP(bf16_t, WS_KWB) + (size_t)row * 256 + lane * 4) = bf4(kwr, 1.0f); *(uint2*)(WSP(bf16_t, WS_VWB) + (size_t)row * 256 + lane * 4) = bf4(vw, 1.0f);
            const int t = row & (SEQ - 1), b = row >> 12;
            if (t >= SEQ - 512) { float* wo = c.out + O_WINP + ((size_t)b * 512 + (t - (SEQ - 512))) * 512; *(float4*)(wo + lane * 4) = kwr; *(float4*)(wo + 256 + lane * 4) = vw; }
        } else {
            float* qra = WSP(float, WS_QRAW) + (size_t)row * 1024 + lane * 4; float* qro = WSP(float, WS_QROT) + (size_t)row * 1024 + lane * 4;
            *(float4*)(qra) = q0; *(float4*)(qra + 256) = q1; *(float4*)(qra + 512) = q2; *(float4*)(qra + 768) = q3;
            *(float4*)(qro) = r0; *(float4*)(qro + 256) = r1; *(float4*)(qro + 512) = r2; *(float4*)(qro + 768) = r3;
            float* kw = WSP(float, WS_KW) + (size_t)row * 512; *(float4*)(kw + lane * 4) = kwr; *(float4*)(kw + 256 + lane * 4) = vw;
            float* wo = c.out + O_WINS + ((size_t)(row - NPR) * 512 + 511) * 512; *(float4*)(wo + lane * 4) = kwr; *(float4*)(wo + 256 + lane * 4) = vw;
        }
        if (lane < 12) { const float4 gl = *(const float4*)(cr + 2560 + lane * 4);
            *(float4*)(WSP(float, WS_GATE) + (size_t)row * 48 + lane * 4) = make_float4(sigmoidf_(gl.x), sigmoidf_(gl.y), sigmoidf_(gl.z), sigmoidf_(gl.w)); }
        float* so = nullptr;
        if (!pr) so = c.out + O_SHS + (size_t)(row - NPR) * RWC; else if ((row & (SEQ - 1)) == SEQ - 1) so = c.out + O_SHP + (size_t)(row >> 12) * RWC;
        if (so) {
            const float* sp = cr + NSAC + lane * 4; float* dp = so + lane * 4;
            float4 t0, t1, t2, t3, t4, t5, t6, t7, t8, t9, t10, t11, t12, t13;
            t0 = *(const float4*)(sp); t1 = *(const float4*)(sp + 256); t2 = *(const float4*)(sp + 512); t3 = *(const float4*)(sp + 768); t4 = *(const float4*)(sp + 1024);
            t5 = *(const float4*)(sp + 1280); t6 = *(const float4*)(sp + 1536); t7 = *(const float4*)(sp + 1792); t8 = *(const float4*)(sp + 2048); t9 = *(const float4*)(sp + 2304);
            t10 = *(const float4*)(sp + 2560); t11 = *(const float4*)(sp + 2816); t12 = *(const float4*)(sp + 3072); t13 = *(const float4*)(sp + (lane < 8 ? 3328 : 3072));
            *(float4*)(dp) = t0; *(float4*)(dp + 256) = t1; *(float4*)(dp + 512) = t2; *(float4*)(dp + 768) = t3; *(float4*)(dp + 1024) = t4; *(float4*)(dp + 1280) = t5; *(float4*)(dp + 1536) = t6;
            *(float4*)(dp + 1792) = t7; *(float4*)(dp + 2048) = t8; *(float4*)(dp + 2304) = t9; *(float4*)(dp + 2560) = t10; *(float4*)(dp + 2816) = t11; *(float4*)(dp + 3072) = t12;
            if (lane < 8) *(float4*)(dp + 3328) = t13;
        }
    }
}

__device__ __forceinline__ void p5b_rwkv_prep(const Ctx& c) {
    const float* COLS = WSP(const float, WS_COLS);
    float* RW = WSP(float, WS_RW); float* V = WSP(float, WS_V); float* Gt = WSP(float, WS_G); float* BON = WSP(float, WS_BON);
    const float* mu = c.p->in[19]; const float* w0 = c.p->in[20]; const float* w2 = c.p->in[21]; const float* a0 = c.p->in[22]; const float* a2 = c.p->in[23];
    const float* g2 = c.p->in[24]; const float* kkw = c.p->in[25]; const float* kaw = c.p->in[26]; const float* rk = c.p->in[27];
    float* L = (float*)c.lds;
    constexpr int RG = 8;
#pragma unroll 1
    for (int it = c.bid; it < NR / RG; it += c.G) {
        const int row0 = it * RG;
        __syncthreads();
        for (int e = c.tid; e < RG * 288; e += NTHREADS) {
            const int r = e / 288, k = e % 288, row = row0 + r, col = 3072 + k;
            const float cur = COLS[(size_t)row * NINP + NSAC + col];
            float prev;
            if (row >= NPR) prev = c.p->in[6][(size_t)(row - NPR) * RWC + col];
            else prev = (row & (SEQ - 1)) == 0 ? 0.f : COLS[(size_t)(row - 1) * NINP + NSAC + col];
            const float xs = cur + (prev - cur) * mu[col];
            L[e] = k < 64 ? tanhf(xs) : (k < 128 ? xs : sigmoidf_(xs));
        }
        __syncthreads();
        float aw[RG][2], aa[RG][2], ag[RG][2];
#pragma unroll
        for (int r = 0; r < RG; ++r) { aw[r][0] = aw[r][1] = aa[r][0] = aa[r][1] = ag[r][0] = ag[r][1] = 0.f; }
        const int n0 = c.tid, n1 = c.tid + 512;
#pragma unroll 4
        for (int k = 0; k < 64; ++k) { const float x0 = w2[k * 1024 + n0], x1 = w2[k * 1024 + n1];
#pragma unroll
            for (int r = 0; r < RG; ++r) { const float l = L[r * 288 + k]; aw[r][0] += l * x0; aw[r][1] += l * x1; } }
#pragma unroll 4
        for (int k = 0; k < 64; ++k) { const float x0 = a2[k * 1024 + n0], x1 = a2[k * 1024 + n1];
#pragma unroll
            for (int r = 0; r < RG; ++r) { const float l = L[r * 288 + 64 + k]; aa[r][0] += l * x0; aa[r][1] += l * x1; } }
#pragma unroll 4
        for (int k = 0; k < 160; ++k) { const float x0 = g2[k * 1024 + n0], x1 = g2[k * 1024 + n1];
#pragma unroll
            for (int r = 0; r < RG; ++r) { const float l = L[r * 288 + 128 + k]; ag[r][0] += l * x0; ag[r][1] += l * x1; } }
#pragma unroll
        for (int r = 0; r < RG; ++r) {
            const int row = row0 + r;
            const float* cr = COLS + (size_t)row * NINP + NSAC;
            const bool first = row < NPR && (row & (SEQ - 1)) == 0;
            const float* pr = row >= NPR ? c.p->in[6] + (size_t)(row - NPR) * RWC : (cr - NINP);
#pragma unroll
            for (int j = 0; j < 2; ++j) {
                const int n = j == 0 ? n0 : n1;
                float xr, xk, xv;
                { const float cu = cr[n], p = first ? 0.f : pr[n]; xr = cu + (p - cu) * mu[n]; }
                { const float cu = cr[1024 + n], p = first ? 0.f : pr[1024 + n]; xk = cu + (p - cu) * mu[1024 + n]; }
                { const float cu = cr[2048 + n], p = first ? 0.f : pr[2048 + n]; xv = cu + (p - cu) * mu[2048 + n]; }
                const float wl = w0[n] + aw[r][j];
                const float nx = -wl; const float sp = fmaxf(nx, 0.f) + log1pf(__expf(-fabsf(nx)));
                const float wlog = -sp - 0.5f;
                const float decay = __expf(-__expf(wlog));
                const float a = sigmoidf_(a0[n] + aa[r][j]);
                const float g = ag[r][j];
                const float kkr = xk * kkw[n];
                const float ssq = wave_sum(kkr * kkr);
                const float kkn = kkr / fmaxf(sqrtf(ssq), 1e-12f);
                const float km = xk * (1.0f + (a - 1.0f) * kaw[n]);
                const float bs = wave_sum(xr * km * rk[n]);
                float* rw = RW + (size_t)row * 5 * 1024;
                rw[n] = xr; rw[1024 + n] = decay; rw[2048 + n] = km; rw[3072 + n] = kkn; rw[4096 + n] = kkn * a;
                V[(size_t)row * 1024 + n] = xv; Gt[(size_t)row * 1024 + n] = g;
                if (c.lane == 0) BON[(size_t)row * 16 + (n >> 6)] = bs;
            }
        }
    }
}

__device__ __forceinline__ void p5c_compress(const Ctx& c) {
    float* X = (float*)c.lds;
    float* HID = X + 80 * 256;
    const int tid = c.tid;
    const int n_items_p = 2 * 64, n_items_s = NSM * 32;
#pragma unroll 1
    for (int it = c.bid; it < n_items_p + n_items_s; it += c.G) {
        const bool smp = it >= n_items_p;
        const int b = smp ? (it - n_items_p) >> 5 : it >> 6;
        const int n0 = smp ? ((it - n_items_p) & 31) * 4 : (it & 63) * 4;
        const int nc = smp ? NCS : NCP;
        const int nb = (nc - n0) < 4 ? (nc - n0) : 4;
        const int nrows = 16 * (nb - 1) + 32;
#pragma unroll 1
        for (int kv = 0; kv < 2; ++kv) {
            const float* pe = c.p->in[kv == 0 ? 13 : 16]; const float* w1 = c.p->in[kv == 0 ? 14 : 17]; const float* w2 = c.p->in[kv == 0 ? 15 : 18];
            __syncthreads();
            for (int e = tid; e < nrows * 64; e += NTHREADS) {
                const int r = e >> 6, q4 = (e & 63) * 4; const int tok = 16 * n0 + r;
                const float* src;
                if (smp) { const int page = ((const int*)c.p->in[3])[b * NPAGES + (tok >> 7)]; src = c.p->in[2] + ((size_t)page * PAGE + (tok & 127)) * 1024 + kv * 256 + q4; }
                else src = WSP(const float, WS_COLS) + (size_t)(b * SEQ + tok) * NINP + 1024 + kv * 256 + q4;
                *(float4*)(X + r * 256 + q4) = *(const float4*)src;
            }
            __syncthreads();
            {
                const int kvh = tid >> 7, h = tid & 127;
                float acc[4] = {0.f, 0.f, 0.f, 0.f};
#pragma unroll 1
                for (int l = 0; l < 32; ++l) {
#pragma unroll 8
                    for (int d = 0; d < 64; ++d) {
                        const float w = w1[(l * 64 + d) * 128 + h], pv = pe[l * 64 + d];
#pragma unroll
                        for (int q = 0; q < 4; ++q) acc[q] += (X[(16 * q + l) * 256 + kvh * 64 + d] + pv) * w;
                    }
                }
#pragma unroll
                for (int q = 0; q < 4; ++q) HID[(q * 4 + kvh) * 128 + h] = siluf_(acc[q]);
            }
            __syncthreads();
            {
#pragma unroll
                for (int j = 0; j < 2; ++j) {
                    const int o = tid + j * 512; const int q = o >> 8, kvh = (o >> 6) & 3, dd = o & 63;
                    float s = 0.f;
#pragma unroll 8
                    for (int h = 0; h < 128; ++h) s += HID[(q * 4 + kvh) * 128 + h] * w2[h * 64 + dd];
                    if (q < nb) {
                        if (smp) WSP(float, kv == 0 ? WS_KCS : WS_VCS)[((size_t)b * 128 + n0 + q) * 256 + kvh * 64 + dd] = s;
                        else WSP(bf16_t, kv == 0 ? WS_KCB : WS_VCB)[((size_t)b * 256 + n0 + q) * 256 + kvh * 64 + dd] = f2bf(s);
                    } else if (!smp && n0 + q == 255) WSP(bf16_t, kv == 0 ? WS_KCB : WS_VCB)[((size_t)b * 256 + 255) * 256 + kvh * 64 + dd] = 0;
                }
            }
        }
    }
}

typedef short bf16x8_t __attribute__((ext_vector_type(8)));
typedef float f32x4_t __attribute__((ext_vector_type(4)));
#define MFMA16(a, b, c) __builtin_amdgcn_mfma_f32_16x16x32_bf16((a), (b), (c), 0, 0, 0)
constexpr int AT_LD = 72;
constexpr int AT_TILE = 64 * AT_LD;
constexpr int AT_OFF_K = 0, AT_OFF_V = 2 * AT_TILE * 2, AT_OFF_MSK = 4 * AT_TILE * 2, AT_OFF_SCO = AT_OFF_MSK + 512;

struct AtStage { uint4 k, v; };
__device__ __forceinline__ void at_load(AtStage& s, const bf16_t* kb, const bf16_t* vb, int row0, int tid) {
    const int key = tid >> 3, dc = tid & 7;
    s.k = *(const uint4*)(kb + (size_t)(row0 + key) * 256 + dc * 8);
    s.v = *(const uint4*)(vb + (size_t)(row0 + key) * 256 + dc * 8);
}
constexpr int AT_VDH = 4096 + 64;
typedef short at_v4i16 __attribute__((ext_vector_type(4)));
__device__ __forceinline__ at_v4i16 at_vtr(const unsigned char* p) { return __builtin_amdgcn_ds_read_tr16_b64_v4i16((__attribute__((address_space(3))) at_v4i16*)p); }
__device__ __forceinline__ void at_store(const AtStage& s, bf16_t* KT, bf16_t* VT, int tid) {
    const int key = tid >> 3, dc = tid & 7;
    *(uint4*)(KT + key * AT_LD + dc * 8) = s.k;
    *(uint4*)((unsigned char*)VT + (dc >> 2) * AT_VDH + key * 64 + (((dc & 3) * 16) ^ (((key >> 3) & 1) * 32))) = make_uint4(s.v.x, s.v.y, s.v.z, s.v.w);
}

__device__ __forceinline__ void at_scores(const bf16_t* KT, const bf16x8_t (&qf)[2], f32x4_t (&S)[2][2], const f32x4_t& nref4, int r, int q) {
    bf16x8_t a[2][2][2];
#pragma unroll
    for (int kg = 0; kg < 2; ++kg)
#pragma unroll
        for (int kt = 0; kt < 2; ++kt) {
            const int krow = 32 * kg + 8 * (r >> 2) + 4 * kt + (r & 3);
            a[kg][kt][0] = *(const bf16x8_t*)(KT + krow * AT_LD + q * 8); a[kg][kt][1] = *(const bf16x8_t*)(KT + krow * AT_LD + 32 + q * 8);
        }
    __builtin_amdgcn_sched_barrier(0);
#pragma unroll
    for (int kg = 0; kg < 2; ++kg)
#pragma unroll
        for (int kt = 0; kt < 2; ++kt) S[kg][kt] = MFMA16(a[kg][kt][1], qf[1], MFMA16(a[kg][kt][0], qf[0], nref4));
}
template <int MODE  >
__device__ __forceinline__ void at_update(const bf16_t* VT, f32x4_t (&S)[2][2], f32x4_t (&O)[4], f32x4_t& L, f32x4_t& nref4, bool& seen, int keybase, int lo, int hi, int r, int q) {
    const int vb0 = (8 * q + (r >> 2)) * 64 + ((8 * (r & 3)) ^ ((q & 1) * 32));
    const unsigned char* vp0 = (const unsigned char*)VT + vb0; const int vsw = (vb0 ^ 32) - vb0;
    bf16x8_t va[4][2];
#pragma unroll
    for (int dt = 0; dt < 4; ++dt)
#pragma unroll
        for (int kg = 0; kg < 2; ++kg) { const unsigned char* ap = vp0 + (dt >> 1) * AT_VDH + (dt & 1) * vsw + 32 * kg * 64;
            const at_v4i16 lo = at_vtr(ap), hi = at_vtr(ap + 4 * 64);
            va[dt][kg] = __builtin_shufflevector(lo, hi, 0, 1, 2, 3, 4, 5, 6, 7); }
    __builtin_amdgcn_sched_barrier(0);
    const int rhi = hi - keybase - 8 * q, rlo = lo - keybase - 8 * q;
    const bool on = hi >= 0;
    float mx = -3.0e38f;
#pragma unroll
    for (int kg = 0; kg < 2; ++kg)
#pragma unroll
        for (int kt = 0; kt < 2; ++kt)
#pragma unroll
            for (int i = 0; i < 4; ++i) {
                const int o = 32 * kg + 4 * kt + i;
                if (MODE == 1) S[kg][kt][i] = on ? S[kg][kt][i] : -3.0e38f;
                if (MODE == 2) S[kg][kt][i] = (o <= rhi) ? S[kg][kt][i] : -3.0e38f;
                if (MODE == 3) S[kg][kt][i] = (o <= rhi && o >= rlo) ? S[kg][kt][i] : -3.0e38f;
                mx = fmaxf(mx, S[kg][kt][i]); }
    mx = max_q(mx);
    const bool valid = mx > -1.0e30f;
    const bool need = valid && (!seen || mx > 24.0f);
    if (__any(need)) {
        const float d = need ? mx : 0.0f, sc = __builtin_amdgcn_exp2f(-d);
#pragma unroll
        for (int kg = 0; kg < 2; ++kg)
#pragma unroll
            for (int kt = 0; kt < 2; ++kt)
#pragma unroll
                for (int i = 0; i < 4; ++i) S[kg][kt][i] -= d;
#pragma unroll
        for (int dt = 0; dt < 4; ++dt) O[dt] *= sc;
        L *= sc;
        nref4 -= d;
    }
    seen = seen || valid;
    bf16x8_t pb[2];
#pragma unroll
    for (int kg = 0; kg < 2; ++kg) {
        float p[8];
#pragma unroll
        for (int kt = 0; kt < 2; ++kt)
#pragma unroll
            for (int i = 0; i < 4; ++i) p[kt * 4 + i] = __builtin_amdgcn_exp2f(S[kg][kt][i]);
        uint4 w; w.x = pg8::cvt_pk_bf16(p[0], p[1]); w.y = pg8::cvt_pk_bf16(p[2], p[3]); w.z = pg8::cvt_pk_bf16(p[4], p[5]); w.w = pg8::cvt_pk_bf16(p[6], p[7]);
        pb[kg] = __builtin_bit_cast(bf16x8_t, w);
    }
    const unsigned ow = (r == 0) ? 0x3F803F80u : 0u;
    const bf16x8_t ones = __builtin_bit_cast(bf16x8_t, make_uint4(ow, ow, ow, ow));
    L = MFMA16(ones, pb[1], MFMA16(ones, pb[0], L));
#pragma unroll
    for (int dt = 0; dt < 4; ++dt) {
        f32x4_t o = O[dt];
#pragma unroll
        for (int kg = 0; kg < 2; ++kg) o = MFMA16(va[dt][kg], pb[kg], o);
        O[dt] = o;
    }
}
__device__ __forceinline__ float at_rowsum(const f32x4_t& L, int q) { return sum_q(q == 0 ? L[0] : 0.0f); }
__device__ __forceinline__ void at_finish(f32x4_t (&OUT)[4], f32x4_t (&O)[4], f32x4_t& L, f32x4_t& nref4, bool& seen, float gate, int q) {
    const float l = at_rowsum(L, q);
    const float f = l > 0.f ? gate / l : 0.f;
#pragma unroll
    for (int dt = 0; dt < 4; ++dt) { OUT[dt] += O[dt] * f; O[dt] = (f32x4_t){0.f, 0.f, 0.f, 0.f}; }
    L = (f32x4_t){0.f, 0.f, 0.f, 0.f}; nref4 = (f32x4_t){0.f, 0.f, 0.f, 0.f}; seen = false;
}

#ifndef PROBE_T
#define PROBE_T -1
#endif
#define PSEC(k, x) do { if (PROBE_T == (k) && pacc) { x; } } while (0)
__device__ __forceinline__ void nsa_tile_mfma(const Ctx& c, int item, unsigned long long* pacc = nullptr) {
    const int tile = 127 - (item >> 3), bk = item & 7, b = bk >> 2, kvh = bk & 3;
    const int s0 = tile * 32;
    int tid = c.tid; asm volatile("" : "+v"(tid));
    const int lane = tid & 63, wave = c.wave, r = lane & 15, q = lane >> 4;
    bf16_t* KT = (bf16_t*)(c.lds + AT_OFF_K); bf16_t* VT = (bf16_t*)(c.lds + AT_OFF_V);
    unsigned long long* MSK = (unsigned long long*)(c.lds + AT_OFF_MSK);
    float* SCO = (float*)(c.lds + AT_OFF_SCO) + wave * 256;
    const int tokl = 4 * wave + (r >> 2), g = r & 3;
    const int t = s0 + tokl;
    const size_t trow = (size_t)b * SEQ + t;
    const size_t rb = (size_t)b * SEQ;
    bf16x8_t qr[2], qs[2];
#pragma unroll
    for (int ks = 0; ks < 2; ++ks) { qr[ks] = *(const bf16x8_t*)(WSP(const bf16_t, WS_QRB) + trow * 1024 + (kvh * 4 + g) * 64 + ks * 32 + q * 8);
                                     qs[ks] = *(const bf16x8_t*)(WSP(const bf16_t, WS_QSB) + trow * 1024 + (kvh * 4 + g) * 64 + ks * 32 + q * 8); }
    const float* gate = WSP(const float, WS_GATE) + trow * 48 + (kvh * 4 + g) * 3;
    const float g0 = gate[0], g1 = gate[1], g2 = gate[2];
    f32x4_t OUT[4], O[4];
#pragma unroll
    for (int dt = 0; dt < 4; ++dt) { OUT[dt] = (f32x4_t){0.f, 0.f, 0.f, 0.f}; O[dt] = (f32x4_t){0.f, 0.f, 0.f, 0.f}; }
    f32x4_t L = {0.f, 0.f, 0.f, 0.f}, nref4 = {0.f, 0.f, 0.f, 0.f}; bool seen = false;
    AtStage st;
    __syncthreads();
    unsigned long long pt_ = 0; PSEC(201, pt_ = wall_clock64());

    const int ntc = (s0 / 16 + 1 + 63) >> 6;
    const int ncr = t >= 31 ? (t - 31) / 16 + 1 : 0;
    f32x4_t SC[4][2][2];
#pragma unroll
    for (int ti = 0; ti < 4; ++ti)
#pragma unroll
        for (int kg = 0; kg < 2; ++kg)
#pragma unroll
            for (int kt = 0; kt < 2; ++kt) SC[ti][kg][kt] = (f32x4_t){0.f, 0.f, 0.f, 0.f};
    {
        const bf16_t* kb = WSP(const bf16_t, WS_KCB) + (size_t)b * 256 * 256 + kvh * 64; const bf16_t* vb = WSP(const bf16_t, WS_VCB) + (size_t)b * 256 * 256 + kvh * 64;
        AtStage c1, c2, c3;
        at_load(st, kb, vb, 0, tid);
        at_load(c1, kb, vb, (1 < ntc ? 1 : ntc - 1) * 64, tid); at_load(c2, kb, vb, (2 < ntc ? 2 : ntc - 1) * 64, tid); at_load(c3, kb, vb, (3 < ntc ? 3 : ntc - 1) * 64, tid);
        at_store(st, KT, VT, tid); __syncthreads();
#define AT_CMP_STEP(ti, nslot) \
            if ((ti) < ntc) { \
                f32x4_t S2[2][2]; \
                at_scores(KT + ((ti) & 1) * AT_TILE, qr, S2, nref4, r, q); \
                _Pragma("unroll") for (int kg = 0; kg < 2; ++kg) _Pragma("unroll") for (int kt = 0; kt < 2; ++kt) SC[ti][kg][kt] = S2[kg][kt] - nref4;          \
                at_update<2>(VT + ((ti) & 1) * AT_TILE, S2, O, L, nref4, seen, (ti) * 64, 0, ncr - 1, r, q); \
                if ((ti) + 1 < ntc) at_store(nslot, KT + (((ti) + 1) & 1) * AT_TILE, VT + (((ti) + 1) & 1) * AT_TILE, tid); \
                __syncthreads(); \
            }
        AT_CMP_STEP(0, c1) AT_CMP_STEP(1, c2) AT_CMP_STEP(2, c3) AT_CMP_STEP(3, c3)
#undef AT_CMP_STEP
    }
    {
        const float ltot = at_rowsum(L, q); const float m = -nref4[0];
        const float inv = ltot > 0.f ? 1.0f / ltot : 0.f;
        float A[8][2], Bv[8];
#pragma unroll
        for (int ti = 0; ti < 4; ++ti)
#pragma unroll
            for (int kg = 0; kg < 2; ++kg) {
                float pa[2][4];
#pragma unroll
                for (int kt = 0; kt < 2; ++kt)
#pragma unroll
                    for (int i = 0; i < 4; ++i) { const int n = ti * 64 + 32 * kg + 8 * q + 4 * kt + i; pa[kt][i] = (ti < ntc && n < ncr) ? __builtin_amdgcn_exp2f(SC[ti][kg][kt][i] - m) * inv : 0.f; }
                A[ti * 2 + kg][0] = 2.0f * (pa[0][0] + pa[0][1] + pa[0][2]) + pa[0][3];
                A[ti * 2 + kg][1] = 2.0f * (pa[1][0] + pa[1][1] + pa[1][2]) + pa[1][3] + pa[0][3];
                Bv[ti * 2 + kg] = pa[1][3];
            }
        float prevB[8];
#pragma unroll
        for (int kgg = 0; kgg < 8; ++kgg) prevB[kgg] = __shfl(Bv[kgg], (lane + 48) & 63);
#pragma unroll
        for (int kgg = 0; kgg < 8; ++kgg) { const float pb = q > 0 ? prevB[kgg] : (kgg > 0 ? prevB[kgg - 1] : 0.f); A[kgg][0] += pb; }
        const int cur = t >> 6;
#pragma unroll
        for (int kgg = 0; kgg < 8; ++kgg)
#pragma unroll
            for (int kt = 0; kt < 2; ++kt) { const float v = sum_quad(A[kgg][kt]);
                const int j = 8 * kgg + 2 * q + kt;
                const bool valid = j <= cur, forced = (j == 0) || (cur - j >= 0 && cur - j < 2);
                if (g == 0) SCO[(r >> 2) * 64 + j] = valid ? v + (forced ? 1.0e4f : 0.0f) : NEGV; }
    }
    at_finish(OUT, O, L, nref4, seen, g0, q);
    WAVE_SYNC();
    {
        const int tk = lane >> 4, jj = lane & 15;
        const float* sc = SCO + tk * 64;
        const float s0v = sc[jj], s1v = sc[jj + 16], s2v = sc[jj + 32], s3v = sc[jj + 48];
        int r0 = 0, r1 = 0, r2 = 0, r3 = 0;
#pragma unroll 8
        for (int jp = 0; jp < 64; ++jp) { const float o = sc[jp];
            r0 += (o > s0v || (o == s0v && jp < jj)) ? 1 : 0; r1 += (o > s1v || (o == s1v && jp < jj + 16)) ? 1 : 0;
            r2 += (o > s2v || (o == s2v && jp < jj + 32)) ? 1 : 0; r3 += (o > s3v || (o == s3v && jp < jj + 48)) ? 1 : 0; }
        const unsigned long long b0 = __ballot(r0 < 16 && s0v > -0.5e30f), b1 = __ballot(r1 < 16 && s1v > -0.5e30f), b2 = __ballot(r2 < 16 && s2v > -0.5e30f), b3 = __ballot(r3 < 16 && s3v > -0.5e30f);
        if (lane < 4) { const int sh = 16 * lane;
            MSK[wave * 4 + lane] = ((b0 >> sh) & 0xffffull) | (((b1 >> sh) & 0xffffull) << 16) | (((b2 >> sh) & 0xffffull) << 32) | (((b3 >> sh) & 0xffffull) << 48); }
    }
    __syncthreads();
    PSEC(201, *pacc += wall_clock64() - pt_); PSEC(202, pt_ = wall_clock64());
    {
        unsigned long long un = 0ull;
#pragma unroll 4
        for (int i = 0; i < 32; ++i) un |= MSK[i];
        const unsigned long long mine = MSK[tokl];
        unsigned long long wany, wall;
        { const unsigned long long m0 = MSK[4 * wave], m1 = MSK[4 * wave + 1], m2 = MSK[4 * wave + 2], m3 = MSK[4 * wave + 3]; const unsigned long long o_ = m0 | m1 | m2 | m3, a_ = m0 & m1 & m2 & m3;
          wany = ((unsigned long long)(unsigned)__builtin_amdgcn_readfirstlane((int)(o_ >> 32)) << 32) | (unsigned)__builtin_amdgcn_readfirstlane((int)o_);
          wall = ((unsigned long long)(unsigned)__builtin_amdgcn_readfirstlane((int)(a_ >> 32)) << 32) | (unsigned)__builtin_amdgcn_readfirstlane((int)a_); }
        const bf16_t* kb = WSP(const bf16_t, WS_KSB) + rb * 256 + kvh * 64; const bf16_t* vb = WSP(const bf16_t, WS_VSB) + rb * 256 + kvh * 64;
        int j = __ffsll((long long)un) - 1; un &= un - 1;
#define AT_NEXT(dst) do { dst = un ? (__ffsll((long long)un) - 1) : -1; un &= un - 1; } while (0)
#define AT_SEL_STEP(slot, jslot) { \
            if (j >= 0 && ((wany >> j) & 1ull)) { f32x4_t S[2][2]; const bool on_ = (mine >> j) & 1ull; \
                if (64 * j + 63 <= s0 + 4 * wave) {         \
                    f32x4_t cin_; cin_[0] = on_ ? nref4[0] : -3.0e38f; cin_[1] = on_ ? nref4[1] : -3.0e38f; cin_[2] = on_ ? nref4[2] : -3.0e38f; cin_[3] = on_ ? nref4[3] : -3.0e38f; \
                    at_scores(KT + buf * AT_TILE, qs, S, cin_, r, q); at_update<0>(VT + buf * AT_TILE, S, O, L, nref4, seen, j * 64, 0, 0, r, q); } \
                else { at_scores(KT + buf * AT_TILE, qs, S, nref4, r, q); at_update<2>(VT + buf * AT_TILE, S, O, L, nref4, seen, j * 64, 0, on_ ? t : -1, r, q); } } \
            at_store(slot, KT + (buf ^ 1) * AT_TILE, VT + (buf ^ 1) * AT_TILE, tid); __syncthreads(); \
            j = jslot; buf ^= 1; AT_NEXT(jslot); at_load(slot, kb, vb, (jslot >= 0 ? jslot : 0) * 64, tid); }
        at_load(st, kb, vb, j * 64, tid);
        int j0_, j1_, j2_, j3_; AT_NEXT(j0_); AT_NEXT(j1_); AT_NEXT(j2_); AT_NEXT(j3_);
        AtStage q0, q1, q2, q3;
        at_load(q0, kb, vb, (j0_ >= 0 ? j0_ : 0) * 64, tid);
        at_load(q1, kb, vb, (j1_ >= 0 ? j1_ : 0) * 64, tid);
        at_load(q2, kb, vb, (j2_ >= 0 ? j2_ : 0) * 64, tid);
        at_load(q3, kb, vb, (j3_ >= 0 ? j3_ : 0) * 64, tid);
        at_store(st, KT, VT, tid); __syncthreads();
        int buf = 0;
#pragma unroll 1
        do {
            AT_SEL_STEP(q0, j0_)
            AT_SEL_STEP(q1, j1_)
            AT_SEL_STEP(q2, j2_)
            AT_SEL_STEP(q3, j3_)
        } while (j >= 0);
#undef AT_SEL_STEP
#undef AT_NEXT
    }
    at_finish(OUT, O, L, nref4, seen, g1, q);
    PSEC(202, *pacc += wall_clock64() - pt_); PSEC(203, pt_ = wall_clock64());
    {
        const bf16_t* kb = WSP(const bf16_t, WS_KWB) + rb * 256 + kvh * 64; const bf16_t* vb = WSP(const bf16_t, WS_VWB) + rb * 256 + kvh * 64;
        const int j0 = (s0 > 512 ? s0 - 512 : 0) >> 6, j1 = (s0 + 31) >> 6;
        unsigned long long un = ((2ull << j1) - 1ull) & ~((1ull << j0) - 1ull);
        int j = j0; un &= un - 1;
#define AT_NEXT(dst) do { dst = un ? (__ffsll((long long)un) - 1) : -1; un &= un - 1; } while (0)
#define AT_WIN_STEP(slot, jslot) { \
            if (j >= 0) { f32x4_t S[2][2]; at_scores(KT + buf * AT_TILE, qs, S, nref4, r, q); \
                if (64 * j >= s0 + 4 * wave + 3 - 512 && 64 * j + 63 <= s0 + 4 * wave) at_update<0>(VT + buf * AT_TILE, S, O, L, nref4, seen, j * 64, 0, 0, r, q);     \
                else at_update<3>(VT + buf * AT_TILE, S, O, L, nref4, seen, j * 64, t - 512, t, r, q); } \
            at_store(slot, KT + (buf ^ 1) * AT_TILE, VT + (buf ^ 1) * AT_TILE, tid); __syncthreads(); \
            j = jslot; buf ^= 1; AT_NEXT(jslot); at_load(slot, kb, vb, (jslot >= 0 ? jslot : 0) * 64, tid); }
        at_load(st, kb, vb, j * 64, tid);
        int j0_, j1_, j2_, j3_; AT_NEXT(j0_); AT_NEXT(j1_); AT_NEXT(j2_); AT_NEXT(j3_);
        AtStage q0, q1, q2, q3;
        at_load(q0, kb, vb, (j0_ >= 0 ? j0_ : 0) * 64, tid);
        at_load(q1, kb, vb, (j1_ >= 0 ? j1_ : 0) * 64, tid);
        at_load(q2, kb, vb, (j2_ >= 0 ? j2_ : 0) * 64, tid);
        at_load(q3, kb, vb, (j3_ >= 0 ? j3_ : 0) * 64, tid);
        at_store(st, KT, VT, tid); __syncthreads();
        int buf = 0;
#pragma unroll 1
        do {
            AT_WIN_STEP(q0, j0_)
            AT_WIN_STEP(q1, j1_)
            AT_WIN_STEP(q2, j2_)
            AT_WIN_STEP(q3, j3_)
        } while (j >= 0);
#undef AT_WIN_STEP
#undef AT_NEXT
    }
    at_finish(OUT, O, L, nref4, seen, g2, q);
    PSEC(203, *pacc += wall_clock64() - pt_);
    {
        bf16_t* dst = WSP(bf16_t, WS_AMIX) + trow * DM + (kvh * 4 + g) * 64 + 4 * q;
#pragma unroll
        for (int dt = 0; dt < 4; ++dt) *(uint2*)(dst + 16 * dt) = make_uint2(pg8::cvt_pk_bf16(OUT[dt][0], OUT[dt][1]), pg8::cvt_pk_bf16(OUT[dt][2], OUT[dt][3]));
    }
}

constexpr int CP_LD = 72, CP_ABUF = 144 * CP_LD;
constexpr int CP_X1_OFF = 0, CP_HID_OFF = 73728, CP_HLD = 136;

__device__ __forceinline__ void cp_cvt_store(bf16_t* A, int u, const float4& x, const float4& y) {
    const int s = u >> 5, kvh = (u & 31) >> 3, d8 = (u & 7) * 8;
    *(uint4*)(A + (s * 4 + kvh) * CP_LD + d8) = make_uint4(pg8::cvt_pk_bf16(x.x, x.y), pg8::cvt_pk_bf16(x.z, x.w), pg8::cvt_pk_bf16(y.x, y.y), pg8::cvt_pk_bf16(y.z, y.w));
}

__device__ __forceinline__ void compress_mfma(const Ctx& c, int it) {
    const int tid = c.tid, lane = c.lane, wave = c.wave, r = lane & 15, q = lane >> 4;
    bf16_t* Abuf = (bf16_t*)c.lds;
    float* X1 = (float*)(c.lds + CP_X1_OFF);
    bf16_t* HID = (bf16_t*)(c.lds + CP_HID_OFF);
    const bf16_t* W1T = WSP(const bf16_t, WS_W1T); const bf16_t* W2T = WSP(const bf16_t, WS_W2T); const float* PET = WSP(const float, WS_PET);
    const int n_items_p = 2 * 8 * 2;
    {
        unsigned long long ps_ = 0; if (PROBE_T >= 331 && PROBE_T <= 333) ps_ = wall_clock64();
        const bool smp = it >= n_items_p;
        const int kv = it & 1;
        const int b = smp ? (it - n_items_p) >> 3 : it >> 4;
        const int g = smp ? ((it - n_items_p) >> 1) & 3 : (it >> 1) & 7;
        const int nseg = smp ? 128 : 256;
        const float* src[3]; const size_t tstride = smp ? 1024 : NINP;
#pragma unroll
        for (int k = 0; k < 3; ++k) {
            int u = k < 2 ? tid + k * 512 : (tid < 32 ? 1024 + tid : tid); if (k == 2) asm volatile("" : "+v"(u));
            int seg = 32 * g + (u >> 5); if (seg > nseg - 1) seg = nseg - 1;
            const int kvh = (u & 31) >> 3, d8 = (u & 7) * 8;
            if (smp) { const int page = ((const int*)c.p->in[3])[b * NPAGES + (seg >> 3)]; src[k] = c.p->in[2] + ((size_t)page * PAGE + ((16 * seg) & 127)) * 1024 + kv * 256 + kvh * 64 + d8; }
            else src[k] = WSP(const float, WS_COLS) + ((size_t)b * SEQ + 16 * seg) * NINP + 1024 + kv * 256 + kvh * 64 + d8;
        }
        const bool has3 = tid < 32;
        const bf16_t* wb = W1T + (size_t)kv * 16 * 256 * 64 + (size_t)(32 * wave + r) * 64 + q * 8;
        f32x4_t acc[9][2];
#pragma unroll
        for (int mt = 0; mt < 9; ++mt) { acc[mt][0] = (f32x4_t){0.f, 0.f, 0.f, 0.f}; acc[mt][1] = (f32x4_t){0.f, 0.f, 0.f, 0.f}; }
        float4 pf[2][3][2];
        bf16x8_t bc[2][2], bn[2][2];
        __syncthreads();
#define CP_LOADA(sl, L) do { _Pragma("unroll") for (int k = 0; k < 3; ++k) { pf[sl][k][0] = *(const float4*)(src[k] + (size_t)(L) * tstride); pf[sl][k][1] = *(const float4*)(src[k] + (size_t)(L) * tstride + 4); } } while (0)
#define CP_STOREA(sl, Ap) do { cp_cvt_store(Ap, tid, pf[sl][0][0], pf[sl][0][1]); cp_cvt_store(Ap, tid + 512, pf[sl][1][0], pf[sl][1][1]); cp_cvt_store(Ap, has3 ? 1024 + tid : 1056 + (tid & 31), pf[sl][2][0], pf[sl][2][1]); } while (0)
#define CP_LOADB(bb, L) do { _Pragma("unroll") for (int nt = 0; nt < 2; ++nt) _Pragma("unroll") for (int ks = 0; ks < 2; ++ks) bb[nt][ks] = *(const bf16x8_t*)(wb + (size_t)(L) * 256 * 64 + nt * 16 * 64 + ks * 32); } while (0)
#define CP_MMA(Ap, bb) do { _Pragma("unroll") for (int mg = 0; mg < 3; ++mg) { _Pragma("unroll") for (int ks = 0; ks < 2; ++ks) _Pragma("unroll") for (int mm = 0; mm < 3; ++mm) { const int mt = mg * 3 + mm; \
            const bf16x8_t a = *(const bf16x8_t*)((Ap) + (16 * mt + r) * CP_LD + ks * 32 + q * 8); acc[mt][0] = MFMA16(a, bb[0][ks], acc[mt][0]); acc[mt][1] = MFMA16(a, bb[1][ks], acc[mt][1]); } \
            } } while (0)
        CP_LOADA(0, 0); CP_LOADA(1, 1); CP_LOADB(bc, 0);
        CP_STOREA(0, Abuf); CP_STOREA(1, Abuf + CP_ABUF);
        __syncthreads();
        if (PROBE_T == 331) { if (c.tid == 0) atomicMax((unsigned*)(c.ws + WS_CTL) + 6000, (unsigned)(wall_clock64() - ps_)); }
        if (PROBE_T == 332) ps_ = wall_clock64();
#pragma unroll 1
        for (int lp = 0; lp < 7; ++lp) {
            const bf16_t* A0 = Abuf + ((lp & 1) * 2) * CP_ABUF;
            CP_LOADA(0, 2 * lp + 2); CP_LOADA(1, 2 * lp + 3);
            CP_LOADB(bn, 2 * lp + 1);
            __builtin_amdgcn_sched_barrier(0);
            CP_MMA(A0, bc);
            CP_LOADB(bc, 2 * lp + 2);
            __builtin_amdgcn_sched_barrier(0);
            CP_MMA(A0 + CP_ABUF, bn);
            { bf16_t* An = Abuf + (((lp + 1) & 1) * 2) * CP_ABUF; CP_STOREA(0, An); CP_STOREA(1, An + CP_ABUF); }
            __syncthreads();
        }
        { const bf16_t* A0 = Abuf + 2 * CP_ABUF;
            CP_LOADB(bn, 15);
            CP_MMA(A0, bc);
            CP_MMA(A0 + CP_ABUF, bn);
            __syncthreads(); }
#undef CP_LOADA
#undef CP_STOREA
#undef CP_LOADB
#undef CP_MMA
        if (PROBE_T == 332) { if (c.tid == 0) atomicMax((unsigned*)(c.ws + WS_CTL) + 6000, (unsigned)(wall_clock64() - ps_)); }
        if (PROBE_T == 333) ps_ = wall_clock64();
        if (wave >= 4) {
            int xw = 4 * q * 128 + 32 * (wave - 4) + r; asm volatile("" : "+v"(xw));
            float* xp = X1 + xw; float* xp8 = xp + 128 * 128;
#pragma unroll
            for (int mt = 0; mt < 9; ++mt)
#pragma unroll
                for (int nt = 0; nt < 2; ++nt)
#pragma unroll
                    for (int i = 0; i < 4; ++i) { if (mt < 8) xp[(16 * mt + i) * 128 + 16 * nt] = acc[mt][nt][i]; else xp8[i * 128 + 16 * nt] = acc[mt][nt][i]; }
        }
        __syncthreads();
        if (wave < 4) {
            int xr = (4 * q + 4) * 128 + 32 * wave + r, hw = 4 * q * CP_HLD + 32 * wave + r; asm volatile("" : "+v"(xr), "+v"(hw));
            const float* xp = X1 + xr; bf16_t* hp = HID + hw;
#pragma unroll
            for (int nt = 0; nt < 2; ++nt) {
                const float pt = PET[kv * 128 + 32 * wave + 16 * nt + r];
#pragma unroll
                for (int mt = 0; mt < 8; ++mt)
#pragma unroll
                    for (int i = 0; i < 4; ++i) { const float v = acc[mt][nt][i] + xp[(16 * mt + i) * 128 + 16 * nt] + pt;
                        hp[(16 * mt + i) * CP_HLD + 16 * nt] = f2bf(v * __builtin_amdgcn_rcpf(1.0f + __expf(-v))); }
            }
        }
        __syncthreads();
        {
            f32x4_t o2[4];
#pragma unroll
            for (int nt = 0; nt < 4; ++nt) o2[nt] = (f32x4_t){0.f, 0.f, 0.f, 0.f};
#pragma unroll
            for (int ks = 0; ks < 4; ++ks) { const bf16x8_t a = *(const bf16x8_t*)(HID + (16 * wave + r) * CP_HLD + ks * 32 + q * 8);
#pragma unroll
                for (int nt = 0; nt < 4; ++nt) { const bf16x8_t bb = *(const bf16x8_t*)(W2T + (size_t)kv * 64 * 128 + (16 * nt + r) * 128 + ks * 32 + q * 8); o2[nt] = MFMA16(a, bb, o2[nt]); } }
#pragma unroll
            for (int i = 0; i < 4; ++i) { const int row = 16 * wave + 4 * q + i, sl = row >> 2, kvh = row & 3, n = 32 * g + sl;
#pragma unroll
                for (int nt = 0; nt < 4; ++nt) { const int dd = 16 * nt + r;
                    if (smp) { if (n <= nseg - 2) WSP(float, kv == 0 ? WS_KCS : WS_VCS)[((size_t)b * 128 + n) * 256 + kvh * 64 + dd] = o2[nt][i]; }
                    else WSP(bf16_t, kv == 0 ? WS_KCB : WS_VCB)[((size_t)b * 256 + n) * 256 + kvh * 64 + dd] = n <= nseg - 2 ? f2bf(o2[nt][i]) : (bf16_t)0; } }
        }
        if (PROBE_T == 333) { __syncthreads(); if (c.tid == 0) atomicMax((unsigned*)(c.ws + WS_CTL) + 6000, (unsigned)(wall_clock64() - ps_)); }
    }
}

constexpr int LR_LD = 296;
__device__ __forceinline__ void p5_lora(const Ctx& c, int it) {
    const float* COLS = WSP(const float, WS_COLS);
    const float* mu = c.p->in[19]; const float* w0 = c.p->in[20]; const float* a0 = c.p->in[22];
    bf16_t* LA = (bf16_t*)c.lds;
    const int tid = c.tid, lane = c.lane, wave = c.wave, r = lane & 15, q = lane >> 4;
    {
        const int row0 = it * 32;
        __syncthreads();
        float4 cu_[5], pv_[5], m4_[5];
#pragma unroll
        for (int k = 0; k < 5; ++k) {
            int u = tid + k * NTHREADS; u = u < 32 * 72 ? u : 32 * 72 - 1;
            const int rr = u / 72, c4 = u - rr * 72, row = row0 + rr, col = 3072 + 4 * c4;
            cu_[k] = *(const float4*)(COLS + (size_t)row * NINP + NSAC + col);
            const float* pp = row >= NPR ? c.p->in[6] + (size_t)(row - NPR) * RWC + col : COLS + (size_t)((row & (SEQ - 1)) == 0 ? row : row - 1) * NINP + NSAC + col;
            pv_[k] = *(const float4*)pp;
            m4_[k] = *(const float4*)(mu + col);
        }
#pragma unroll
        for (int k = 0; k < 5; ++k) {
            const int u0 = tid + k * NTHREADS; const int u = u0 < 32 * 72 ? u0 : 32 * 72 - 1;
            const int rr = u / 72, c4 = u - rr * 72, row = row0 + rr;
            const float4 cu = cu_[k], m4 = m4_[k]; float4 pv = pv_[k];
            if (row < NPR && (row & (SEQ - 1)) == 0) pv = make_float4(0.f, 0.f, 0.f, 0.f);
            float x[4] = {cu.x + (pv.x - cu.x) * m4.x, cu.y + (pv.y - cu.y) * m4.y, cu.z + (pv.z - cu.z) * m4.z, cu.w + (pv.w - cu.w) * m4.w};
            if (c4 < 16) { for (int j = 0; j < 4; ++j) x[j] = tanhf(x[j]); }
            else if (c4 >= 32) { for (int j = 0; j < 4; ++j) x[j] = sigmoidf_(x[j]); }
            if (u0 < 32 * 72) *(uint2*)(LA + rr * LR_LD + 4 * c4) = make_uint2(pack2bf(x[0], x[1]), pack2bf(x[2], x[3]));
        }
        __syncthreads();
        int lao = r * LR_LD + 8 * q; asm volatile("" : "+v"(lao));
#pragma unroll
        for (int lo = 0; lo < 3; ++lo) {
            const int Kl = lo == 2 ? 160 : 64, koff = lo == 0 ? 0 : (lo == 1 ? 64 : 128);
            unsigned loff = (unsigned)((128 * wave + r) * Kl + 8 * q); asm volatile("" : "+v"(loff));
            const bf16_t* Wt = WSP(const bf16_t, lo == 0 ? WS_LW2T : (lo == 1 ? WS_LA2T : WS_LG2T)) + loff;
            f32x4_t acc[8][2];
#pragma unroll
            for (int nt = 0; nt < 8; ++nt) { acc[nt][0] = (f32x4_t){0.f, 0.f, 0.f, 0.f}; acc[nt][1] = (f32x4_t){0.f, 0.f, 0.f, 0.f}; }
#pragma unroll
            for (int ks = 0; ks < (lo == 2 ? 5 : 2); ++ks) {
                const bf16x8_t b0 = *(const bf16x8_t*)(LA + lao + koff + 32 * ks), b1 = *(const bf16x8_t*)(LA + lao + 16 * LR_LD + koff + 32 * ks);
#pragma unroll
                for (int nt = 0; nt < 8; ++nt) { const bf16x8_t a = *(const bf16x8_t*)(Wt + (size_t)(16 * nt) * Kl + 32 * ks);
                    acc[nt][0] = MFMA16(a, b0, acc[nt][0]); acc[nt][1] = MFMA16(a, b1, acc[nt][1]); }
            }
            float* dst = WSP(float, lo == 0 ? WS_DEC : (lo == 1 ? WS_AA : WS_G));
#pragma unroll
            for (int nt = 0; nt < 8; ++nt) {
                const int n4 = 128 * wave + 16 * nt + 4 * q;
                float4 bias = make_float4(0.f, 0.f, 0.f, 0.f);
                if (lo == 0) bias = *(const float4*)(w0 + n4); else if (lo == 1) bias = *(const float4*)(a0 + n4);
#pragma unroll
                for (int ct = 0; ct < 2; ++ct) {
                    float v[4] = {acc[nt][ct][0] + bias.x, acc[nt][ct][1] + bias.y, acc[nt][ct][2] + bias.z, acc[nt][ct][3] + bias.w};
                    if (lo == 0) {
#pragma unroll
                        for (int j = 0; j < 4; ++j) { const float nx = -v[j]; const float sp = fmaxf(nx, 0.f) + log1pf(__expf(-fabsf(nx))); v[j] = __expf(-__expf(-sp - 0.5f)); }
                    } else if (lo == 1) {
#pragma unroll
                        for (int j = 0; j < 4; ++j) v[j] = sigmoidf_(v[j]);
                    }
                    *(float4*)(dst + (size_t)(row0 + 16 * ct + r) * 1024 + n4) = make_float4(v[0], v[1], v[2], v[3]);
                }
            }
        }
    }
}

#define P5_QUEUE(word, n_items, BODY, PK) do { unsigned* q_ = (unsigned*)(c.ws + WS_CTL) + (word); \
    _Pragma("unroll 1") for (;;) { __syncthreads(); if (c.tid == 0) sh[0] = atomicAdd(q_, 1u); __syncthreads(); const int pull = (int)sh[0]; if (pull >= (n_items)) break; \
        unsigned long long ti_ = 0; if (PROBE_T == (PK)) ti_ = wall_clock64(); BODY; if (PROBE_T == (PK)) { __syncthreads(); if (c.tid == 0) atomicMax((unsigned*)(c.ws + WS_CTL) + 6000, (unsigned)(wall_clock64() - ti_)); } } } while (0)
__device__ __forceinline__ void p5_queue(const Ctx& c, unsigned long long* pacc = nullptr) {
    volatile unsigned* sh = (volatile unsigned*)(c.lds + LDS_MISC + 64);
    unsigned long long t0_ = 0;
    if (PROBE_T == 301 && pacc) t0_ = wall_clock64();
    if (PROBE_T == 302 && pacc) t0_ = wall_clock64();
    P5_QUEUE(CW_QMISC + 64, NR / 32, p5_lora(c, pull), 322);
    if (PROBE_T == 302 && pacc) *pacc = wall_clock64() - t0_;
    if (PROBE_T == 312 && c.tid == 0) atomicMax((unsigned*)(c.ws + WS_CTL) + 6000, (unsigned)(wall_clock64() - *pacc));
    P5_QUEUE(CW_QMISC, 2 * 8 * 2 + NSM * 4 * 2, compress_mfma(c, pull), 323);
    if (PROBE_T == 301 && pacc) *pacc = wall_clock64() - t0_;
    if (PROBE_T == 311 && c.tid == 0) atomicMax((unsigned*)(c.ws + WS_CTL) + 6000, (unsigned)(wall_clock64() - *pacc));
    if (PROBE_T == 303 && pacc) t0_ = wall_clock64();
    P5_QUEUE(CW_QMISC + 128, NR / 32, p5a_nsa_prep(c, NR / 32 - 1 - pull), 321);
    if (PROBE_T == 303 && pacc) *pacc = wall_clock64() - t0_;
    if (PROBE_T == 313 && c.tid == 0) atomicMax((unsigned*)(c.ws + WS_CTL) + 6000, (unsigned)(wall_clock64() - *pacc));
}


struct RwConst { float mur, muk, muv, kkw, kaw, rkw; };
__device__ __forceinline__ RwConst rw_const(const Ctx& c, int h, int j) {
    const int n = h * 64 + j; RwConst k;
    k.mur = c.p->in[19][n]; k.muk = c.p->in[19][1024 + n]; k.muv = c.p->in[19][2048 + n]; k.kkw = c.p->in[25][n]; k.kaw = c.p->in[26][n]; k.rkw = c.p->in[27][n];
    return k;
}
struct RwStep { float r, d, km, kk, ka, v, bon; };
__device__ __forceinline__ RwStep rw_prep(const RwConst& k, float cr, float ck, float cv, float pr, float pk, float pv, float dec, float a) {
    RwStep o;
    o.r = cr + (pr - cr) * k.mur; const float xk = ck + (pk - ck) * k.muk; o.v = cv + (pv - cv) * k.muv;
    const float kkr = xk * k.kkw;
    const float ssq = wave_sum(kkr * kkr);
    o.kk = kkr * rsqrtf(fmaxf(ssq, 1e-24f));
    o.km = xk * (1.0f + (a - 1.0f) * k.kaw);
    o.ka = o.kk * a; o.d = dec;
    o.bon = wave_sum(o.r * o.km * k.rkw);
    return o;
}


constexpr int CKN = 32 * 256;
__device__ __forceinline__ void sm_mul(const float (&X)[4], const float (&Y)[4], float (&Z)[4], float* SA, float* SB, int q, int r) {
    WAVE_SYNC();
#pragma unroll
    for (int e = 0; e < 4; ++e) { SA[(4 * q + e) * 16 + r] = X[e]; SB[(4 * q + e) * 16 + r] = Y[e]; }
    WAVE_SYNC();
#pragma unroll
    for (int e = 0; e < 4; ++e) Z[e] = 0.f;
#pragma unroll
    for (int u4 = 0; u4 < 4; ++u4) {
        const float y0 = SB[(4 * u4) * 16 + r], y1 = SB[(4 * u4 + 1) * 16 + r], y2 = SB[(4 * u4 + 2) * 16 + r], y3 = SB[(4 * u4 + 3) * 16 + r];
#pragma unroll
        for (int e = 0; e < 4; ++e) { const float4 x = *(const float4*)(SA + (4 * q + e) * 16 + 4 * u4); Z[e] += x.x * y0 + x.y * y1 + x.z * y2 + x.w * y3; }
    }
}

__device__ __forceinline__ void rwc_prep_item(const Ctx& c, int item, float* wl) {
    const int chain = item >> 8, cc = item & 255, b = chain >> 4, h = chain & 15;
    const int lane = c.lane, q = lane >> 4, r = lane & 15;
    constexpr int XP = 68;
    float* XB = wl; float* XX = wl + 16 * XP; float* XA = wl + 32 * XP; float* XR = wl + 48 * XP;
    const float* COLS = WSP(const float, WS_COLS); const float* DEC = WSP(const float, WS_DEC); const float* AA = WSP(const float, WS_AA);
    const RwConst kc = rw_const(c, h, lane);
    const int hcol = h * 64 + lane;
    const size_t r0 = (size_t)b * SEQ + (size_t)cc * 16;
    float al[16], rh[16], vv[16];
    float gam = 1.0f, pr = 0.f, pk = 0.f, pv = 0.f;
    if (cc != 0) { const float* pp = COLS + (r0 - 1) * NINP + NSAC + hcol; pr = pp[0]; pk = pp[1024]; pv = pp[2048]; }
    WAVE_SYNC();
#pragma unroll
    for (int hf = 0; hf < 2; ++hf) {
        float cr[8], ck[8], cv[8], de[8], aa[8];
#pragma unroll
        for (int s_ = 0; s_ < 8; ++s_) { const size_t row = r0 + hf * 8 + s_; const float* cp = COLS + row * NINP + NSAC + hcol; cr[s_] = cp[0]; ck[s_] = cp[1024]; cv[s_] = cp[2048];
            de[s_] = DEC[row * 1024 + hcol]; aa[s_] = AA[row * 1024 + hcol]; }
#pragma unroll
        for (int s_ = 0; s_ < 8; ++s_) { const int t = hf * 8 + s_;
            const RwStep o = rw_prep(kc, cr[s_], ck[s_], cv[s_], pr, pk, pv, de[s_], aa[s_]); pr = cr[s_]; pk = ck[s_]; pv = cv[s_];
            if (lane == 0) WSP(float, WS_BON)[(r0 + t) * 16 + h] = o.bon;
            const float gp = gam; gam *= o.d; const float ig = __builtin_amdgcn_rcpf(gam);
            al[t] = gp * o.kk; rh[t] = gam * o.r; vv[t] = o.v;
            XB[t * XP + lane] = o.ka * ig; XX[t * XP + lane] = o.km * ig; XA[t * XP + lane] = al[t]; XR[t * XP + lane] = rh[t]; }
    }
    WAVE_SYNC();
    float mb[4], mx[4], nb[4], nx[4];
#pragma unroll
    for (int e = 0; e < 4; ++e) { mb[e] = 0.f; mx[e] = 0.f; nb[e] = 0.f; nx[e] = 0.f; }
#pragma unroll 4
    for (int j4 = 0; j4 < 16; ++j4) {
        const float4 a = *(const float4*)(XA + r * XP + 4 * j4), p = *(const float4*)(XR + r * XP + 4 * j4);
#pragma unroll
        for (int e = 0; e < 4; ++e) { const float4 be = *(const float4*)(XB + (4 * q + e) * XP + 4 * j4), xe = *(const float4*)(XX + (4 * q + e) * XP + 4 * j4);
            mb[e] += dot4(be, a); nb[e] += dot4(be, p); mx[e] += dot4(xe, a); nx[e] += dot4(xe, p); }
    }
#pragma unroll
    for (int e = 0; e < 4; ++e) { const int s = 4 * q + e; if (!(s < r)) { mb[e] = 0.f; mx[e] = 0.f; } if (!(s <= r)) { nb[e] = 0.f; nx[e] = 0.f; } }
    float* SA = XA; float* SB = XA + 256; float* TL = XA + 512; float* NL = XA + 768;
    float id[4], m2[4], m4[4], m8[4], t0[4], t1[4], f1[4], T[4], mh[4], nh[4], tmp[4];
#pragma unroll
    for (int e = 0; e < 4; ++e) id[e] = (4 * q + e == r) ? 1.0f : 0.0f;
    sm_mul(mb, mb, m2, SA, SB, q, r); sm_mul(m2, m2, m4, SA, SB, q, r); sm_mul(m4, m4, m8, SA, SB, q, r);
#pragma unroll
    for (int e = 0; e < 4; ++e) { t0[e] = id[e] - mb[e]; f1[e] = id[e] + m2[e]; }
    sm_mul(t0, f1, t1, SA, SB, q, r);
#pragma unroll
    for (int e = 0; e < 4; ++e) f1[e] = id[e] + m4[e];
    sm_mul(t1, f1, t0, SA, SB, q, r);
#pragma unroll
    for (int e = 0; e < 4; ++e) f1[e] = id[e] + m8[e];
    sm_mul(t0, f1, T, SA, SB, q, r);
    sm_mul(mx, T, mh, SA, SB, q, r);
    sm_mul(mh, nb, tmp, SA, SB, q, r);
#pragma unroll
    for (int e = 0; e < 4; ++e) nh[e] = nx[e] - tmp[e];
    WAVE_SYNC();
#pragma unroll
    for (int e = 0; e < 4; ++e) { TL[(4 * q + e) * 16 + r] = T[e]; NL[(4 * q + e) * 16 + r] = nb[e]; }
    WAVE_SYNC();
    float ah[16], ph[16];
#pragma unroll
    for (int t = 0; t < 16; ++t) { float a = 0.f;
#pragma unroll
        for (int s = 0; s <= t; ++s) a += al[s] * TL[s * 16 + t];
        ah[t] = a; }
#pragma unroll
    for (int t = 0; t < 16; ++t) { float p = rh[t];
#pragma unroll
        for (int s = 0; s <= t; ++s) p -= ah[s] * NL[s * 16 + t];
        ph[t] = p; }
    constexpr int AP = 72;
    bf16_t* ALa = (bf16_t*)XA; bf16_t* ALp = ALa + 16 * AP;
    WAVE_SYNC();
#pragma unroll
    for (int t = 0; t < 16; ++t) { ALa[t * AP + lane] = f2bf(ah[t]); ALp[t * AP + lane] = f2bf(ph[t]); }
    WAVE_SYNC();
    unsigned char* rec = c.ws + WS_CK + (size_t)item * CK_REC;
#pragma unroll
    for (int ks = 0; ks < 2; ++ks) {
        const uint2 alo = *(const uint2*)(ALa + r * AP + 32 * ks + 4 * q), ahi = *(const uint2*)(ALa + r * AP + 32 * ks + 16 + 4 * q);
        const uint2 plo = *(const uint2*)(ALp + r * AP + 32 * ks + 4 * q), phi = *(const uint2*)(ALp + r * AP + 32 * ks + 16 + 4 * q);
        ((uint4*)rec)[ks * 64 + lane] = make_uint4(alo.x, alo.y, ahi.x, ahi.y);
        ((uint4*)(rec + 2048))[ks * 64 + lane] = make_uint4(plo.x, plo.y, phi.x, phi.y);
    }
    ((uint2*)(rec + 4096))[lane] = make_uint2(pack2bf(mh[0], mh[1]), pack2bf(mh[2], mh[3]));
    ((uint2*)(rec + 4608))[lane] = make_uint2(pack2bf(nh[0], nh[1]), pack2bf(nh[2], nh[3]));
#pragma unroll
    for (int mt = 0; mt < 4; ++mt) { const float g16 = __shfl(gam, 16 * mt + r);
        const float b0 = XB[(4 * q) * XP + 16 * mt + r], b1 = XB[(4 * q + 1) * XP + 16 * mt + r], b2 = XB[(4 * q + 2) * XP + 16 * mt + r], b3 = XB[(4 * q + 3) * XP + 16 * mt + r];
        const float x0 = XX[(4 * q) * XP + 16 * mt + r], x1 = XX[(4 * q + 1) * XP + 16 * mt + r], x2 = XX[(4 * q + 2) * XP + 16 * mt + r], x3 = XX[(4 * q + 3) * XP + 16 * mt + r];
        ((uint2*)(rec + 5120))[mt * 64 + lane] = make_uint2(pack2bf(-b0 * g16, -b1 * g16), pack2bf(-b2 * g16, -b3 * g16));
        ((uint2*)(rec + 7168))[mt * 64 + lane] = make_uint2(pack2bf(x0 * g16, x1 * g16), pack2bf(x2 * g16, x3 * g16)); }
    ((float*)(rec + 9216))[lane] = gam;
    { uint4 v0, v1; v0.x = pack2bf(vv[0], vv[1]); v0.y = pack2bf(vv[2], vv[3]); v0.z = pack2bf(vv[4], vv[5]); v0.w = pack2bf(vv[6], vv[7]);
      v1.x = pack2bf(vv[8], vv[9]); v1.y = pack2bf(vv[10], vv[11]); v1.z = pack2bf(vv[12], vv[13]); v1.w = pack2bf(vv[14], vv[15]);
      uint4* vp = (uint4*)(rec + 9472) + lane * 2; vp[0] = v0; vp[1] = v1; }
    WAVE_SYNC();
}

__device__ __forceinline__ bf16x8_t half_frag(const uint2& v) { return __builtin_bit_cast(bf16x8_t, make_uint4(v.x, v.y, 0u, 0u)); }

__device__ __forceinline__ void rwc_fill(const unsigned char* src, unsigned char* dst, int lt) {
    constexpr int NU = 4 * (int)CK_REC / 16;
    const uint4* s4 = (const uint4*)src; uint4* d4 = (uint4*)dst;
    uint4 t0, t1, t2, t3, t4, t5, t6, t7, t8, t9, t10, t11;
    { const int u11 = lt + 2816 < NU ? lt + 2816 : NU - 1;
      t0 = s4[lt]; t1 = s4[lt + 256]; t2 = s4[lt + 512]; t3 = s4[lt + 768]; t4 = s4[lt + 1024]; t5 = s4[lt + 1280]; t6 = s4[lt + 1536]; t7 = s4[lt + 1792];
      t8 = s4[lt + 2048]; t9 = s4[lt + 2304]; t10 = s4[lt + 2560]; t11 = s4[u11]; }
    d4[lt] = t0; d4[lt + 256] = t1; d4[lt + 512] = t2; d4[lt + 768] = t3; d4[lt + 1024] = t4; d4[lt + 1280] = t5; d4[lt + 1536] = t6; d4[lt + 1792] = t7;
    d4[lt + 2048] = t8; d4[lt + 2304] = t9; d4[lt + 2560] = t10; if (lt + 2816 < NU) d4[lt + 2816] = t11;
}

__device__ __forceinline__ void rwc_wincopy(const Ctx& c, int slot, int lt) {
    const size_t per_b = (size_t)511 * 128, total = per_b * NSM; const float* sw = c.p->in[4]; float* wo = c.out + O_WINS;
#pragma unroll
    for (int hb = 0; hb < 2; ++hb) {
        float4 t0, t1, t2, t3, t4, t5, t6, t7;
        const size_t e0 = (size_t)slot * 4096 + lt + 2048 * hb;
#define WC_LD(tk, k) { const size_t e_ = e0 + 256 * (k); const size_t ec = e_ < total ? e_ : total - 1; tk = *(const float4*)(sw + (ec / per_b) * 512 * 512 + 512 + (ec % per_b) * 4); }
#define WC_ST(tk, k) { const size_t e_ = e0 + 256 * (k); if (e_ < total) *(float4*)(wo + (e_ / per_b) * 512 * 512 + (e_ % per_b) * 4) = tk; }
        WC_LD(t0, 0) WC_LD(t1, 1) WC_LD(t2, 2) WC_LD(t3, 3) WC_LD(t4, 4) WC_LD(t5, 5) WC_LD(t6, 6) WC_LD(t7, 7)
        WC_ST(t0, 0) WC_ST(t1, 1) WC_ST(t2, 2) WC_ST(t3, 3) WC_ST(t4, 4) WC_ST(t5, 5) WC_ST(t6, 6) WC_ST(t7, 7)
#undef WC_LD
#undef WC_ST
    }
}
__device__ __forceinline__ void rwc_gn(const Ctx& c, int chain, int g, const float* yb, int lw, int lane) {
    const int b = chain >> 4, h = chain & 15, hcol = h * 64 + lane;
    const float* COLS = WSP(const float, WS_COLS); const float* Gt = WSP(const float, WS_G); const float* BON = WSP(const float, WS_BON);
    const float gw = c.p->in[28][hcol], gb = c.p->in[29][hcol], muv = c.p->in[19][2048 + hcol];
    bf16_t* AM = WSP(bf16_t, WS_AMIX);
#pragma unroll
    for (int hb = 0; hb < 2; ++hb) {
        float cu[9], gg[8], bo[8];
        const size_t r0 = (size_t)b * SEQ + (size_t)g * 64 + lw * 16 + hb * 8;
        cu[0] = ((r0 & (SEQ - 1)) == 0) ? 0.f : COLS[(r0 - 1) * NINP + NSAC + 2048 + hcol];
#pragma unroll
        for (int k = 0; k < 8; ++k) { cu[k + 1] = COLS[(r0 + k) * NINP + NSAC + 2048 + hcol]; gg[k] = Gt[(r0 + k) * 1024 + hcol]; bo[k] = BON[(r0 + k) * 16 + h]; }
#pragma unroll
        for (int k = 0; k < 8; ++k) {
            const float y = yb[(lw * 16 + hb * 8 + k) * 64 + lane];
            const float mean = wave_sum(y) * (1.0f / 64.0f); const float d = y - mean; const float var = wave_sum(d * d) * (1.0f / 64.0f);
            const float yn = d * rsqrtf(var + GN_EPS) * gw + gb;
            const float xv = cu[k + 1] + (cu[k] - cu[k + 1]) * muv;
            AM[(r0 + k) * DM + 1024 + hcol] = f2bf((yn + bo[k] * xv) * gg[k]);
        }
    }
}

__device__ __forceinline__ void rwc_scan_wg(const Ctx& c, int chain) {
    constexpr int NB = 4, BUFB = NB * (int)CK_REC, NU = BUFB / 16;
    const int tid = c.tid, wave = c.wave, lane = c.lane, q = lane >> 4, r = lane & 15;
    unsigned char* buf0 = c.lds;
    const unsigned char* recs = c.ws + WS_CK + (size_t)chain * 256 * CK_REC;
    f32x4_t ST[4];
#pragma unroll
    for (int mt = 0; mt < 4; ++mt) ST[mt] = (f32x4_t){0.f, 0.f, 0.f, 0.f};
    float* YB = (float*)(c.lds + 2 * BUFB);
    const int lt = tid - 256;
    __syncthreads();
    if (wave >= 4) rwc_fill(recs, buf0, lt);
    __syncthreads();
#pragma unroll 1
    for (int g = 0; g < 256 / NB; ++g) {
        if (wave < 4) {
            const unsigned char* bb = buf0 + (g & 1) * BUFB;
            float* yb = YB + (g & 1) * 4096;
#pragma unroll
            for (int u4 = 0; u4 < NB; ++u4) {
                const int cc = g * NB + u4;
                const unsigned char* sl = bb + u4 * CK_REC;
                const uint4 at0 = ((const uint4*)sl)[lane], at1 = ((const uint4*)sl)[64 + lane], pt0 = ((const uint4*)(sl + 2048))[lane], pt1 = ((const uint4*)(sl + 2048))[64 + lane];
                const uint2 mhf = ((const uint2*)(sl + 4096))[lane], nhf = ((const uint2*)(sl + 4608))[lane];
                const uint2 vtf = *(const uint2*)(sl + 9472 + ((16 * wave + r) * 16 + 4 * q) * 2);
                bf16x8_t sb[2];
#pragma unroll
                for (int ks = 0; ks < 2; ++ks) { uint4 u; u.x = pg8::cvt_pk_bf16(ST[2 * ks][0], ST[2 * ks][1]); u.y = pg8::cvt_pk_bf16(ST[2 * ks][2], ST[2 * ks][3]);
                    u.z = pg8::cvt_pk_bf16(ST[2 * ks + 1][0], ST[2 * ks + 1][1]); u.w = pg8::cvt_pk_bf16(ST[2 * ks + 1][2], ST[2 * ks + 1][3]); sb[ks] = __builtin_bit_cast(bf16x8_t, u); }
                const bf16x8_t vb = half_frag(vtf);
                f32x4_t UT = {0.f, 0.f, 0.f, 0.f}, YT = {0.f, 0.f, 0.f, 0.f};
                UT = MFMA16(__builtin_bit_cast(bf16x8_t, at0), sb[0], UT); UT = MFMA16(__builtin_bit_cast(bf16x8_t, at1), sb[1], UT); UT = MFMA16(half_frag(mhf), vb, UT);
                YT = MFMA16(__builtin_bit_cast(bf16x8_t, pt0), sb[0], YT); YT = MFMA16(__builtin_bit_cast(bf16x8_t, pt1), sb[1], YT); YT = MFMA16(half_frag(nhf), vb, YT);
#pragma unroll
                for (int e = 0; e < 4; ++e) yb[(u4 * 16 + 4 * q + e) * 64 + 16 * wave + r] = YT[e];
                const bf16x8_t ub = __builtin_bit_cast(bf16x8_t, make_uint4(pg8::cvt_pk_bf16(UT[0], UT[1]), pg8::cvt_pk_bf16(UT[2], UT[3]), 0u, 0u));
#pragma unroll
                for (int mt = 0; mt < 4; ++mt) { const uint2 bgf = ((const uint2*)(sl + 5120))[mt * 64 + lane], xgf = ((const uint2*)(sl + 7168))[mt * 64 + lane];
                    const float4 gm = *(const float4*)(sl + 9216 + (16 * mt + 4 * q) * 4);
                    f32x4_t s = ST[mt]; s[0] *= gm.x; s[1] *= gm.y; s[2] *= gm.z; s[3] *= gm.w;
                    s = MFMA16(half_frag(bgf), ub, s); s = MFMA16(half_frag(xgf), vb, s); ST[mt] = s; }
            }
        } else {
            if (g + 1 < 256 / NB) rwc_fill(recs + (size_t)(g + 1) * BUFB, buf0 + ((g + 1) & 1) * BUFB, lt);
            if (g > 0) rwc_gn(c, chain, g - 1, YB + ((g - 1) & 1) * 4096, wave - 4, lane);
        }
        __syncthreads();
    }
    if (wave >= 4) rwc_gn(c, chain, 256 / NB - 1, YB + ((256 / NB - 1) & 1) * 4096, wave - 4, lane);
    if (wave < 4) {
        float* so = c.out + O_WKVP + ((size_t)chain * 64 + 16 * wave + r) * 64 + 4 * q;
#pragma unroll
        for (int mt = 0; mt < 4; ++mt) *(float4*)(so + 16 * mt) = make_float4(ST[mt][0], ST[mt][1], ST[mt][2], ST[mt][3]);
    }
}

__device__ __forceinline__ void scan_sample_item(const Ctx& c, int item, float* wl) {
    const int b = item >> 4, h = item & 15, lane = c.lane, lq = lane >> 4, c4 = lane & 15;
    const size_t row = (size_t)NPR + b; const int hcol = h * 64 + lane;
    float bon_s;
    {
        const RwConst kc = rw_const(c, h, lane);
        const float* cp = WSP(const float, WS_COLS) + row * NINP + NSAC + hcol; const float* pp = c.p->in[6] + (size_t)b * RWC + hcol;
        const RwStep o = rw_prep(kc, cp[0], cp[1024], cp[2048], pp[0], pp[1024], pp[2048], WSP(const float, WS_DEC)[row * 1024 + hcol], WSP(const float, WS_AA)[row * 1024 + hcol]);
        WAVE_SYNC();
        wl[lane] = o.r; wl[64 + lane] = o.d; wl[128 + lane] = o.km; wl[192 + lane] = o.kk; wl[256 + lane] = o.ka; wl[320 + lane] = o.v;
        bon_s = o.bon;
        WAVE_SYNC();
    }
    const float4 r4 = *(const float4*)(wl + c4 * 4), d4 = *(const float4*)(wl + 64 + c4 * 4), km4 = *(const float4*)(wl + 128 + c4 * 4), kk4 = *(const float4*)(wl + 192 + c4 * 4), ka4 = *(const float4*)(wl + 256 + c4 * 4);
    const float* S0 = c.p->in[5] + (size_t)item * 4096; float* S1 = c.out + O_WKVS + (size_t)item * 4096;
    float4 Sv[16];
#pragma unroll
    for (int itr = 0; itr < 16; ++itr) Sv[itr] = *(const float4*)(S0 + (itr * 4 + lq) * 64 + c4 * 4);
#pragma unroll
    for (int itr = 0; itr < 16; ++itr) {
        const int i = itr * 4 + lq;
        float4 S = Sv[itr];
        const float v = wl[320 + i];
        const float sa = -red16(dot4(S, kk4));
        S.x = S.x * d4.x + sa * ka4.x + v * km4.x; S.y = S.y * d4.y + sa * ka4.y + v * km4.y;
        S.z = S.z * d4.z + sa * ka4.z + v * km4.z; S.w = S.w * d4.w + sa * ka4.w + v * km4.w;
        *(float4*)(S1 + i * 64 + c4 * 4) = S;
        const float y = red16(dot4(S, r4));
        if (c4 == 0) wl[384 + i] = y;
    }
    WAVE_SYNC();
    {
        const float y = wl[384 + lane];
        const float mean = wave_sum(y) * (1.0f / 64.0f); const float d = y - mean; const float var = wave_sum(d * d) * (1.0f / 64.0f);
        const float yn = d * rsqrtf(var + GN_EPS) * c.p->in[28][hcol] + c.p->in[29][hcol];
        WSP(bf16_t, WS_AMIX)[row * DM + 1024 + hcol] = f2bf((yn + bon_s * wl[320 + lane]) * WSP(const float, WS_G)[row * 1024 + hcol]);
    }
    WAVE_SYNC();
}

__device__ __forceinline__ void seg_scores(const float4 (&q)[4], const float* kb, int stride, int count, float* sc, int off, int lane) {
    const int l15 = lane & 15, lq = lane >> 4;
#pragma unroll 1
    for (int k0 = 0; k0 < count; k0 += 4) {
        const int key = k0 + lq;
        float4 kv = make_float4(0.f, 0.f, 0.f, 0.f);
        if (key < count) kv = *(const float4*)(kb + (size_t)key * stride + 4 * l15);
        float s0 = red16(dot4(q[0], kv)), s1 = red16(dot4(q[1], kv)), s2 = red16(dot4(q[2], kv)), s3 = red16(dot4(q[3], kv));
        if (l15 == 0 && key < count) { sc[off + key] = s0 * 0.125f; sc[1024 + off + key] = s1 * 0.125f; sc[2048 + off + key] = s2 * 0.125f; sc[3072 + off + key] = s3 * 0.125f; }
    }
}
__device__ __forceinline__ void seg_pv(float4 (&acc)[4], const float* vb, int stride, int count, const float* sc, int off, int lane) {
    const int l15 = lane & 15, lq = lane >> 4;
#pragma unroll 1
    for (int k0 = 0; k0 < count; k0 += 4) {
        const int key = k0 + lq;
        if (key < count) {
            const float4 vv = *(const float4*)(vb + (size_t)key * stride + 4 * l15);
#pragma unroll
            for (int g = 0; g < 4; ++g) { const float pp = sc[g * 1024 + off + key]; acc[g].x += pp * vv.x; acc[g].y += pp * vv.y; acc[g].z += pp * vv.z; acc[g].w += pp * vv.w; }
        }
    }
}
__device__ __forceinline__ void softmax_rows(float* sc, int total, int lane) {
#pragma unroll 1
    for (int g = 0; g < 4; ++g) {
        float* r = sc + g * 1024;
        float m = -3.0e38f;
        for (int i = lane; i < total; i += 64) m = fmaxf(m, r[i]);
        m = wave_max(m);
        float s = 0.f;
        for (int i = lane; i < total; i += 64) { const float e = __expf(r[i] - m); r[i] = e; s += e; }
        s = wave_sum(s);
        const float inv = 1.0f / s;
        for (int i = lane; i < total; i += 64) r[i] *= inv;
    }
}
__device__ __forceinline__ void acc_finish(float4 (&o)[4], float4 (&acc)[4], const float* gate, int gi) {
#pragma unroll
    for (int g = 0; g < 4; ++g) {
        float4 a = acc[g];
        a.x = sum_q(a.x); a.y = sum_q(a.y); a.z = sum_q(a.z); a.w = sum_q(a.w);
        const float gt = gate[g * 3 + gi];
        o[g].x += gt * a.x; o[g].y += gt * a.y; o[g].z += gt * a.z; o[g].w += gt * a.w;
        acc[g] = make_float4(0.f, 0.f, 0.f, 0.f);
    }
}

__device__ __forceinline__ void nsa_item_naive(const Ctx& c, int row, int kvh, float* sc) {
    const int lane = c.lane, l15 = lane & 15;
    const bool smp = row >= NPR;
    const int b = smp ? row - NPR : row >> 12;
    const int t = smp ? PAST : (row & (SEQ - 1));
    const float* KVO = c.out + O_KV;
    const float* KWp = WSP(const float, WS_KW);
    float4 qr[4], qs[4];
#pragma unroll
    for (int g = 0; g < 4; ++g) { qr[g] = *(const float4*)(WSP(const float, WS_QRAW) + (size_t)row * 1024 + (kvh * 4 + g) * 64 + 4 * l15);
                                  qs[g] = *(const float4*)(WSP(const float, WS_QROT) + (size_t)row * 1024 + (kvh * 4 + g) * 64 + 4 * l15); }
    const float* gate = WSP(const float, WS_GATE) + (size_t)row * 48 + kvh * 12;
    float4 o[4], acc[4];
#pragma unroll
    for (int g = 0; g < 4; ++g) { o[g] = make_float4(0.f, 0.f, 0.f, 0.f); acc[g] = make_float4(0.f, 0.f, 0.f, 0.f); }
    WAVE_SYNC();
    int ncmp = smp ? NCS : (t >= 31 ? (t - 31) / 16 + 1 : 0); if (ncmp > NCP) ncmp = NCP;
    const float* kc = (smp ? WSP(const float, WS_KCS) + (size_t)b * 128 * 256 : WSP(const float, WS_KCP) + (size_t)b * 256 * 256) + kvh * 64;
    const float* vc = (smp ? WSP(const float, WS_VCS) + (size_t)b * 128 * 256 : WSP(const float, WS_VCP) + (size_t)b * 256 * 256) + kvh * 64;
    if (ncmp > 0) {
        seg_scores(qr, kc, 256, ncmp, sc, 0, lane); WAVE_SYNC();
        softmax_rows(sc, ncmp, lane); WAVE_SYNC();
        seg_pv(acc, vc, 256, ncmp, sc, 0, lane);
        acc_finish(o, acc, gate, 0);
    }
    unsigned long long mask;
    {
        const int j = lane;
        float imp = 0.f;
#pragma unroll
        for (int r = -1; r <= 3; ++r) { const int n = 4 * j + r; if (n >= 0 && n < ncmp) { const float P = sc[n] + sc[1024 + n] + sc[2048 + n] + sc[3072 + n]; imp += (r == -1 || r == 3) ? P : 2.0f * P; } }
        const int cur = t >> 6;
        const bool valid = j <= cur;
        const bool forced = (j == 0) || (cur - j >= 0 && cur - j < 2);
        const float score = valid ? imp + (forced ? 1.0e4f : 0.0f) : NEGV;
        int rank = 0;
#pragma unroll 1
        for (int jp = 0; jp < 64; ++jp) { const float o2 = __shfl(score, jp); rank += (o2 > score || (o2 == score && jp < j)) ? 1 : 0; }
        mask = __ballot(valid && rank < 16);
    }
    WAVE_SYNC();
    {
        int off = 0;
        unsigned long long m = mask;
#pragma unroll 1
        while (m) { const int j = __ffsll((long long)m) - 1; m &= m - 1;
            const float* kp; int cnt;
            if (!smp) { kp = KVO + ((size_t)(b * SEQ + 64 * j)) * 1024 + 512 + kvh * 64; cnt = t - 64 * j + 1; cnt = cnt > 64 ? 64 : cnt; }
            else if (j < 32) { const int page = ((const int*)c.p->in[3])[b * NPAGES + (j >> 1)]; kp = c.p->in[2] + ((size_t)page * PAGE + (j & 1) * 64) * 1024 + 512 + kvh * 64; cnt = 64; }
            else { kp = KVO + (size_t)row * 1024 + 512 + kvh * 64; cnt = 1; }
            seg_scores(qs, kp, 1024, cnt, sc, off, lane); off += cnt; }
        WAVE_SYNC();
        softmax_rows(sc, off, lane); WAVE_SYNC();
        off = 0; m = mask;
#pragma unroll 1
        while (m) { const int j = __ffsll((long long)m) - 1; m &= m - 1;
            const float* kp; int cnt;
            if (!smp) { kp = KVO + ((size_t)(b * SEQ + 64 * j)) * 1024 + 512 + kvh * 64; cnt = t - 64 * j + 1; cnt = cnt > 64 ? 64 : cnt; }
            else if (j < 32) { const int page = ((const int*)c.p->in[3])[b * NPAGES + (j >> 1)]; kp = c.p->in[2] + ((size_t)page * PAGE + (j & 1) * 64) * 1024 + 512 + kvh * 64; cnt = 64; }
            else { kp = KVO + (size_t)row * 1024 + 512 + kvh * 64; cnt = 1; }
            seg_pv(acc, kp + 256, 1024, cnt, sc, off, lane); off += cnt; }
        acc_finish(o, acc, gate, 1);
    }
    WAVE_SYNC();
    {
        int total;
        if (!smp) { const int start = t > 512 ? t - 512 : 0; const float* kp = KWp + ((size_t)(b * SEQ + start)) * 512 + kvh * 64; total = t - start + 1;
            seg_scores(qs, kp, 512, total, sc, 0, lane); WAVE_SYNC(); softmax_rows(sc, total, lane); WAVE_SYNC(); seg_pv(acc, kp + 256, 512, total, sc, 0, lane); }
        else { const float* k1 = c.p->in[4] + (size_t)b * 512 * 512 + kvh * 64; const float* k2 = KWp + (size_t)row * 512 + kvh * 64; total = 513;
            seg_scores(qs, k1, 512, 512, sc, 0, lane); seg_scores(qs, k2, 512, 1, sc, 512, lane); WAVE_SYNC(); softmax_rows(sc, total, lane); WAVE_SYNC();
            seg_pv(acc, k1 + 256, 512, 512, sc, 0, lane); seg_pv(acc, k2 + 256, 512, 1, sc, 512, lane); }
        acc_finish(o, acc, gate, 2);
    }
    WAVE_SYNC();
    if (lane < 16) {
        bf16_t* dst = WSP(bf16_t, WS_AMIX) + (size_t)row * DM + kvh * 256 + 4 * l15;
#pragma unroll
        for (int g = 0; g < 4; ++g) *(uint2*)(dst + g * 64) = make_uint2(pack2bf(o[g].x, o[g].y), pack2bf(o[g].z, o[g].w));
    }
}

#define SW_LOAD(dst, base, kb_) _Pragma("unroll") for (int u = 0; u < 8; ++u) { int key = (kb_) + 4 * u + lq; key = key < k1 ? key : k1 - 1; dst[u] = *(const float4*)((base) + (size_t)key * stride + 4 * l15); }
__device__ __forceinline__ void sw_scores(const float4 (&q)[4], const float* kb, int stride, int k0, int k1, float* sc, int ld, int off, int lane) {
    const int l15 = lane & 15, lq = lane >> 4;
#define SW_SCORE(kv, kb_) _Pragma("unroll") for (int u = 0; u < 8; ++u) { const int key = (kb_) + 4 * u + lq; \
            const float s0 = red16(dot4(q[0], kv[u])), s1 = red16(dot4(q[1], kv[u])), s2 = red16(dot4(q[2], kv[u])), s3 = red16(dot4(q[3], kv[u])); \
            if (l15 == 0 && key < k1) { sc[off + key] = s0 * 0.125f; sc[ld + off + key] = s1 * 0.125f; sc[2 * ld + off + key] = s2 * 0.125f; sc[3 * ld + off + key] = s3 * 0.125f; } }
    float4 ka[8], kc_[8];
    SW_LOAD(ka, kb, k0)
#pragma unroll 1
    for (int kb0 = k0; kb0 < k1; kb0 += 64) {
        SW_LOAD(kc_, kb, kb0 + 32)
        SW_SCORE(ka, kb0)
        SW_LOAD(ka, kb, kb0 + 64)
        if (kb0 + 32 < k1) { SW_SCORE(kc_, kb0 + 32) }
    }
#undef SW_SCORE
}
__device__ __forceinline__ void sw_pv(float4 (&acc)[4], const float* vb, int stride, int k0, int k1, const float* sc, int ld, int off, int lane) {
    const int l15 = lane & 15, lq = lane >> 4;
#define SW_PV(vv, kb_) _Pragma("unroll") for (int u = 0; u < 8; ++u) { const int key = (kb_) + 4 * u + lq; \
            if (key < k1) { \
                _Pragma("unroll") for (int g = 0; g < 4; ++g) { const float pp = sc[g * ld + off + key]; acc[g].x += pp * vv[u].x; acc[g].y += pp * vv[u].y; acc[g].z += pp * vv[u].z; acc[g].w += pp * vv[u].w; } } }
    float4 va[8], vc_[8];
    SW_LOAD(va, vb, k0)
#pragma unroll 1
    for (int kb0 = k0; kb0 < k1; kb0 += 64) {
        SW_LOAD(vc_, vb, kb0 + 32)
        SW_PV(va, kb0)
        SW_LOAD(va, vb, kb0 + 64)
        if (kb0 + 32 < k1) { SW_PV(vc_, kb0 + 32) }
    }
#undef SW_PV
}
#undef SW_LOAD
__device__ __forceinline__ void sw_softmax_row(float* r, int total, int lane) {
    float m = -3.0e38f;
    for (int i = lane; i < total; i += 64) m = fmaxf(m, r[i]);
    m = wave_max(m);
    float s = 0.f;
    for (int i = lane; i < total; i += 64) { const float e = __expf(r[i] - m); r[i] = e; s += e; }
    s = wave_sum(s);
    const float inv = 1.0f / s;
    for (int i = lane; i < total; i += 64) r[i] *= inv;
}
__device__ __forceinline__ void sw_gate_add(float4 (&tot)[4], float4 (&acc)[4], const float* gate, int gi) {
#pragma unroll
    for (int g = 0; g < 4; ++g) { const float gt = gate[g * 3 + gi]; tot[g].x += gt * acc[g].x; tot[g].y += gt * acc[g].y; tot[g].z += gt * acc[g].z; tot[g].w += gt * acc[g].w; acc[g] = make_float4(0.f, 0.f, 0.f, 0.f); }
}

__device__ __forceinline__ void nsa_sample_wg(const Ctx& c, int item) {
    const int b = item >> 2, kvh = item & 3, row = NPR + b;
    int tid = c.tid; asm volatile("" : "+v"(tid));
    const int lane = tid & 63, wave = c.wave, l15 = lane & 15;
    float* L = (float*)c.lds;
    float* SCC = L;
    float* SCS = L + 512;
    float* SCW = L + 512 + 4096;
    float* SCO = SCW + 4 * 576;
    float* PART = SCO + 64;
    unsigned long long* MSKp = (unsigned long long*)(PART + 8 * 256);
    const float* KVO = c.out + O_KV;
    const float* gate = WSP(const float, WS_GATE) + (size_t)row * 48 + kvh * 12;
    float4 qr[4], qs[4];
#pragma unroll
    for (int g = 0; g < 4; ++g) { qr[g] = *(const float4*)(WSP(const float, WS_QRAW) + (size_t)row * 1024 + (kvh * 4 + g) * 64 + 4 * l15);
                                  qs[g] = *(const float4*)(WSP(const float, WS_QROT) + (size_t)row * 1024 + (kvh * 4 + g) * 64 + 4 * l15); }
    float4 tot[4], acc[4];
#pragma unroll
    for (int g = 0; g < 4; ++g) { tot[g] = make_float4(0.f, 0.f, 0.f, 0.f); acc[g] = make_float4(0.f, 0.f, 0.f, 0.f); }
    const float* kc = WSP(const float, WS_KCS) + (size_t)b * 128 * 256 + kvh * 64;
    const float* vc = WSP(const float, WS_VCS) + (size_t)b * 128 * 256 + kvh * 64;
    const float* kw1 = c.p->in[4] + (size_t)b * 512 * 512 + kvh * 64;
    const float* kw2 = WSP(const float, WS_KW) + (size_t)row * 512 + kvh * 64;
    __syncthreads();
    { const int k0 = 16 * wave, k1 = (16 * wave + 16) < NCS ? 16 * wave + 16 : NCS; if (k0 < k1) sw_scores(qr, kc, 256, k0, k1, SCC, 128, 0, lane); }
    sw_scores(qs, kw1, 512, 64 * wave, 64 * wave + 64, SCW, 576, 0, lane);
    if (wave == 7) sw_scores(qs, kw2, 512, 0, 1, SCW, 576, 512, lane);
    __syncthreads();
    if (wave < 4) sw_softmax_row(SCC + wave * 128, NCS, lane); else sw_softmax_row(SCW + (wave - 4) * 576, 513, lane);
    __syncthreads();
    if (wave == 0) {
        const int j = lane;
        float imp = 0.f;
#pragma unroll
        for (int r = -1; r <= 3; ++r) { const int n = 4 * j + r; if (n >= 0 && n < NCS) { const float P = SCC[n] + SCC[128 + n] + SCC[256 + n] + SCC[384 + n]; imp += (r == -1 || r == 3) ? P : 2.0f * P; } }
        const bool valid = j <= 32, forced = (j == 0) || (j == 31) || (j == 32);
        const float score = valid ? imp + (forced ? 1.0e4f : 0.0f) : NEGV;
        SCO[j] = score;
        WAVE_SYNC();
        int rank = 0;
#pragma unroll 8
        for (int jp = 0; jp < 64; ++jp) { const float o2 = SCO[jp]; rank += (o2 > score || (o2 == score && jp < j)) ? 1 : 0; }
        const unsigned long long mk = __ballot(valid && rank < 16);
        if (lane == 0) MSKp[0] = mk;
    }
    { const int k0 = 16 * wave, k1 = (16 * wave + 16) < NCS ? 16 * wave + 16 : NCS; if (k0 < k1) sw_pv(acc, vc, 256, k0, k1, SCC, 128, 0, lane); }
    sw_gate_add(tot, acc, gate, 0);
    sw_pv(acc, kw1 + 256, 512, 64 * wave, 64 * wave + 64, SCW, 576, 0, lane);
    if (wave == 7) sw_pv(acc, kw2 + 256, 512, 0, 1, SCW, 576, 512, lane);
    sw_gate_add(tot, acc, gate, 2);
    __syncthreads();
    const unsigned long long mask = MSKp[0];
    const float* kp[2]; int cnt[2];
    {
        unsigned long long m = mask; int sidx = 0;
        kp[0] = KVO; kp[1] = KVO; cnt[0] = 0; cnt[1] = 0;
#pragma unroll 1
        while (m) { const int j = __ffsll((long long)m) - 1; m &= m - 1;
            if ((sidx >> 1) == wave) {
                const float* p; int n;
                if (j < 32) { const int page = ((const int*)c.p->in[3])[b * NPAGES + (j >> 1)]; p = c.p->in[2] + ((size_t)page * PAGE + (j & 1) * 64) * 1024 + 512 + kvh * 64; n = 64; }
                else { p = KVO + (size_t)row * 1024 + 512 + kvh * 64; n = 1; }
                if (sidx & 1) { kp[1] = p; cnt[1] = n; } else { kp[0] = p; cnt[0] = n; }
            }
            ++sidx; }
    }
    int total_sel; { const int nsel = __popcll(mask); total_sel = (mask >> 32) & 1ull ? 64 * (nsel - 1) + 1 : 64 * nsel; }
    if (cnt[0] > 0) sw_scores(qs, kp[0], 1024, 0, cnt[0], SCS, 1024, 128 * wave, lane);
    if (cnt[1] > 0) sw_scores(qs, kp[1], 1024, 0, cnt[1], SCS, 1024, 128 * wave + 64, lane);
    __syncthreads();
    if (wave < 4) sw_softmax_row(SCS + wave * 1024, total_sel, lane);
    __syncthreads();
    if (cnt[0] > 0) sw_pv(acc, kp[0] + 256, 1024, 0, cnt[0], SCS, 1024, 128 * wave, lane);
    if (cnt[1] > 0) sw_pv(acc, kp[1] + 256, 1024, 0, cnt[1], SCS, 1024, 128 * wave + 64, lane);
    sw_gate_add(tot, acc, gate, 1);
#pragma unroll
    for (int g = 0; g < 4; ++g) { tot[g].x = sum_q(tot[g].x); tot[g].y = sum_q(tot[g].y); tot[g].z = sum_q(tot[g].z); tot[g].w = sum_q(tot[g].w);
        if (lane < 16) *(float4*)(PART + (wave * 4 + g) * 64 + 4 * l15) = tot[g]; }
    __syncthreads();
    if (tid < 256) { float s = 0.f;
#pragma unroll
        for (int w = 0; w < 8; ++w) s += PART[w * 256 + tid];
        WSP(bf16_t, WS_AMIX)[(size_t)row * DM + kvh * 256 + tid] = f2bf(s); }
}

__device__ __forceinline__ void p6_prep(const Ctx& c) {
    float* wl = (float*)c.lds + c.wave * 4352;
    __syncthreads();
    unsigned long long tp_ = 0; if (PROBE_T >= 341 && PROBE_T <= 343) tp_ = wall_clock64();
#pragma unroll 1
    for (int it = c.bid * NWAVES + c.wave; it < CKN; it += c.G * NWAVES) rwc_prep_item(c, it, wl);
    if (PROBE_T == 341) { __syncthreads(); if (c.tid == 0) atomicMax((unsigned*)(c.ws + WS_CTL) + 6000, (unsigned)(wall_clock64() - tp_)); }
#pragma unroll 1
    for (int it = c.bid * NWAVES + c.wave; it < NSM * 16; it += c.G * NWAVES) scan_sample_item(c, it, wl);
    if (PROBE_T == 342) { __syncthreads(); if (c.tid == 0) atomicMax((unsigned*)(c.ws + WS_CTL) + 6000, (unsigned)(wall_clock64() - tp_)); }
    {
        const size_t per_b = (size_t)511 * 128, total = per_b * NSM, nthr = (size_t)c.G * NTHREADS; const float* sw = c.p->in[4]; float* wo = c.out + O_WINS;
#pragma unroll 1
        for (size_t e0 = (size_t)c.bid * NTHREADS + c.tid; e0 < total; e0 += 8 * nthr) {
            float4 t0, t1, t2, t3, t4, t5, t6, t7;
#define WC_LD(tk, k) { const size_t e_ = e0 + (k) * nthr; const size_t ec = e_ < total ? e_ : total - 1; tk = *(const float4*)(sw + (ec / per_b) * 512 * 512 + 512 + (ec % per_b) * 4); }
#define WC_ST(tk, k) { const size_t e_ = e0 + (k) * nthr; if (e_ < total) *(float4*)(wo + (e_ / per_b) * 512 * 512 + (e_ % per_b) * 4) = tk; }
            WC_LD(t0, 0) WC_LD(t1, 1) WC_LD(t2, 2) WC_LD(t3, 3) WC_LD(t4, 4) WC_LD(t5, 5) WC_LD(t6, 6) WC_LD(t7, 7)
            WC_ST(t0, 0) WC_ST(t1, 1) WC_ST(t2, 2) WC_ST(t3, 3) WC_ST(t4, 4) WC_ST(t5, 5) WC_ST(t6, 6) WC_ST(t7, 7)
#undef WC_LD
#undef WC_ST
        }
    }
}

__device__ __forceinline__ void p6_mixers(const Ctx& c, int qi = 0, unsigned long long* probe_scan_end = nullptr, unsigned long long* probe_acc = nullptr) {
    if (c.bid < 32) { rwc_scan_wg(c, c.bid); if (probe_scan_end && c.bid == 0) *probe_scan_end = wall_clock64(); }
    __syncthreads();
    unsigned* q = (unsigned*)(c.ws + WS_CTL) + CW_QATT + 64 * qi;
    volatile unsigned* sh = (volatile unsigned*)(c.lds + LDS_MISC + 64);
    const int n_mfma = 1024, n_pulls = n_mfma + NSM * 4;
#pragma unroll 1
    for (;;) {
        __syncthreads();
        if (c.tid == 0) sh[0] = atomicAdd(q, 1u);
        __syncthreads();
        const unsigned pull = sh[0];
        if (pull >= (unsigned)n_pulls) break;
        if (pull < (unsigned)n_mfma) nsa_tile_mfma(c, (int)pull, probe_acc);
        else { unsigned long long ps_ = 0; if (PROBE_T == 204 && probe_acc) ps_ = wall_clock64(); nsa_sample_wg(c, (int)pull - n_mfma); if (PROBE_T == 204 && probe_acc) *probe_acc += wall_clock64() - ps_; }
    }
}


constexpr int N_PHASES = 14;

template <class Epi>
__device__ __forceinline__ void run_gemm(const Ctx& c, const bf16_t* A, const bf16_t* Bt, int M, int N, int K, const Epi& E) {
    pg8::Gemm g{A, Bt, M, N, K, K};
    pg8::StaticOrder S; S.init(M, N, c.G, c.bid);
    pg8::gemm_phase<Epi, pg8::StaticOrder, false>((PG8_LAS unsigned char*)c.lds, g, S, E, nullptr);
}
__device__ __forceinline__ void run_gemm_split(const Ctx& c, const bf16_t* A, const bf16_t* Bt, int N, int K, int nsplit) {
    pg8::Gemm g{A + (size_t)NPR * K, Bt, 256, N, K / nsplit, K};
    pg8::SplitOrder S{N / 256, nsplit, K / nsplit, c.G, c.bid};
    pg8::EpiF32 E{WSP(float, WS_OS), N, nullptr, (size_t)256 * N};
    pg8::gemm_phase<pg8::EpiF32, pg8::SplitOrder, false>((PG8_LAS unsigned char*)c.lds, g, S, E, nullptr);
}
__device__ __forceinline__ void reduce_cols_sample(const Ctx& c) {
    const float* os = WSP(const float, WS_OS); float* cols = WSP(float, WS_COLS) + (size_t)NPR * NINP;
    const int n4 = NSM * NINP / 4;
#pragma unroll 1
    for (int e = c.bid * NTHREADS + c.tid; e < n4; e += c.G * NTHREADS) {
        float4 a = *(const float4*)(os + (size_t)e * 4);
#pragma unroll
        for (int sp = 1; sp < 8; ++sp) { const float4 t = *(const float4*)(os + (size_t)sp * 256 * NINP + (size_t)e * 4); a.x += t.x; a.y += t.y; a.z += t.z; a.w += t.w; }
        *(float4*)(cols + (size_t)e * 4) = a;
    }
}

__device__ __forceinline__ bool phase_refresh(Ctx& c) { int t_ = threadIdx.x; asm volatile("" : "+v"(t_)); c.tid = t_; c.lane = t_ & 63; return true; }

__global__ void __launch_bounds__(NTHREADS, 2) hybrid_fwd(Params prm) {
    extern __shared__ __attribute__((aligned(16))) unsigned char shm[];
    Ctx c; c.p = &prm; c.ws = prm.ws; c.out = prm.out; c.lds = shm;
    c.tid = threadIdx.x; c.lane = c.tid & 63; c.wave = __builtin_amdgcn_readfirstlane(c.tid >> 6); c.bid = blockIdx.x; c.G = gridDim.x;
    const int lo = prm.ph_lo, hi = prm.ph_hi;
    if (c.tid < 4) ((volatile unsigned*)(shm + LDS_MISC))[c.tid] = 0u;
    __syncthreads();
    XcdBarrier bar; bar.bar = (unsigned*)(c.ws + WS_CTL) + CW_BAR; bar.x = 0; bar.st = nullptr;
    const bool multi = (hi - lo) > 1;
    if (multi) bar = xcd_barrier_post((unsigned*)(c.ws + WS_CTL) + CW_BAR, (volatile LAS unsigned*)(shm + LDS_MISC));
#ifndef PROBE_PH
#define PROBE_PH -1
#endif
#ifndef PROBE_T
#define PROBE_T -1
#endif
    unsigned long long probe_dt = 0, probe_t0 = 0;
#define PT0(k) do { if (PROBE_T == (k) && c.bid == 0) probe_t0 = wall_clock64(); } while (0)
#define PT1(k) do { if (PROBE_T == (k) && c.bid == 0) probe_dt = wall_clock64() - probe_t0; } while (0)
#define IN(k) (lo <= (k) && (k) < hi && phase_refresh(c))
#define SEAM(k) do { if (lo <= (k) && (k) + 1 < hi) xcd_barrier(bar); } while (0)

    PT0(0);
    if (IN(0)) { p0_prologue(c); } SEAM(0);
    PT1(0);
    PT0(1);
    if (IN(1)) { pg8::EpiSwiGLU E{WSP(bf16_t, WS_ACT), DFF}; run_gemm(c, WSP(const bf16_t, WS_A1), WSP(const bf16_t, WS_WGU1), MP, NGU, DM, E); } SEAM(1);
    PT1(1);
    PT0(2);
    if (IN(2)) { pg8::EpiB16 E{WSP(bf16_t, WS_O), DM}; run_gemm(c, WSP(const bf16_t, WS_ACT), WSP(const bf16_t, WS_WDN1), NPR, DM, DFF, E);
                 run_gemm_split(c, WSP(const bf16_t, WS_ACT), WSP(const bf16_t, WS_WDN1), DM, DFF, 11); } SEAM(2);
    PT1(2);
    PT0(3);
    if (IN(3)) { thin_norm(c, WSP(const float, WS_O), 11, 0, prm.in[8], 0.5f, WSP(float, WS_H1), prm.in[11], WSP(bf16_t, WS_A2)); } SEAM(3);
    PT1(3);
    PT0(4);
    if (IN(4)) { pg8::EpiF32 E{WSP(float, WS_COLS), NINP, nullptr, 0}; run_gemm(c, WSP(const bf16_t, WS_A2), WSP(const bf16_t, WS_WIN), NPR, NINP, DM, E);
                 run_gemm_split(c, WSP(const bf16_t, WS_A2), WSP(const bf16_t, WS_WIN), NINP, DM, 8); } SEAM(4);
    PT1(4);
    PT0(5);
    if (IN(5)) { reduce_cols_sample(c); } SEAM(5);
    PT1(5);
    PT0(6);
    if (IN(6)) {
#if PROBE_T >= 301 && PROBE_T <= 303
        unsigned long long pa_ = 0; p5_queue(c, &pa_); if (c.bid == 255) probe_dt = pa_;
#elif PROBE_T >= 311 && PROBE_T <= 333
        unsigned long long pa_ = wall_clock64(); p5_queue(c, &pa_);
#else
        p5_queue(c);
#endif
    } SEAM(6);
    PT1(6);
#if PROBE_T >= 311 && PROBE_T <= 333
    if (c.bid == 255) probe_dt = (unsigned long long)__hip_atomic_load((unsigned*)(c.ws + WS_CTL) + 6000, __ATOMIC_RELAXED, __HIP_MEMORY_SCOPE_AGENT);
#endif
    PT0(7);
    if (IN(7)) { p6_prep(c); } SEAM(7);
    PT1(7);
#if PROBE_T >= 341 && PROBE_T <= 343
    if (c.bid == 255) probe_dt = (unsigned long long)__hip_atomic_load((unsigned*)(c.ws + WS_CTL) + 6000, __ATOMIC_RELAXED, __HIP_MEMORY_SCOPE_AGENT);
#endif
    PT0(8);
    if (IN(8)) {
#if PROBE_T == 100
        unsigned long long ts0 = wall_clock64(), ts1 = ts0; p6_mixers(c, 0, &ts1); if (c.bid == 0) probe_dt = ts1 - ts0;
#elif PROBE_T >= 201 && PROBE_T <= 212
        unsigned long long pa_ = 0; p6_mixers(c, 0, nullptr, &pa_); if (c.bid == 255) probe_dt = pa_;
#else
        p6_mixers(c, 0);
#endif
    } SEAM(8);
    PT1(8);
    PT0(9);
    if (IN(9)) { pg8::EpiB16 E{WSP(bf16_t, WS_O), DM}; run_gemm(c, WSP(const bf16_t, WS_AMIX), WSP(const bf16_t, WS_WOUT), NPR, DM, DM, E);
                  run_gemm_split(c, WSP(const bf16_t, WS_AMIX), WSP(const bf16_t, WS_WOUT), DM, DM, 8); } SEAM(9);
    PT1(9);
    PT0(10);
    if (IN(10)) { thin_norm(c, WSP(const float, WS_O), 8, 1, prm.in[31], 1.0f, WSP(float, WS_H2), prm.in[32], WSP(bf16_t, WS_A3)); } SEAM(10);
    PT1(10);
    PT0(11);
    if (IN(11)) { pg8::EpiSwiGLU E{WSP(bf16_t, WS_ACT), DFF}; run_gemm(c, WSP(const bf16_t, WS_A3), WSP(const bf16_t, WS_WGU2), MP, NGU, DM, E); } SEAM(11);
    PT1(11);
    PT0(12);
    if (IN(12)) { pg8::EpiB16 E{WSP(bf16_t, WS_O), DM}; run_gemm(c, WSP(const bf16_t, WS_ACT), WSP(const bf16_t, WS_WDN2), NPR, DM, DFF, E);
                  run_gemm_split(c, WSP(const bf16_t, WS_ACT), WSP(const bf16_t, WS_WDN2), DM, DFF, 11); } SEAM(12);
    PT1(12);
    PT0(13);
    if (IN(13)) { thin_norm(c, WSP(const float, WS_O), 11, 2, prm.in[35], 0.5f, c.out + O_Y, nullptr, nullptr); }
    if (PROBE_T >= 0 && c.bid == (PROBE_T >= 201 ? 255 : 0) && c.tid == 0) { const unsigned long long te = wall_clock64(); while (wall_clock64() - te < probe_dt) __builtin_amdgcn_s_sleep(8); }
#undef IN
#undef SEAM
}

extern "C" void kernel_launch(void* const* d_in, const int* in_sizes, int n_in, void* d_out, int out_size, void* d_ws, size_t ws_size, hipStream_t stream) {
    static int grid = 0;
    if (grid == 0) {
        if (n_in != 36 || (size_t)out_size != O_END || ws_size < WS_END) { fprintf(stderr, "kernel_launch: unexpected problem shape (n_in %d, out %d, ws %zu; need 36, %zu, >= %zu)\n", n_in, out_size, ws_size, (size_t)O_END, (size_t)WS_END); grid = -1; return; }
        int dev = 0, cus = 0, per_cu = 0;
        if (hipGetDevice(&dev) != hipSuccess || hipDeviceGetAttribute(&cus, hipDeviceAttributeMultiprocessorCount, dev) != hipSuccess) { grid = -1; return; }
        if (hipFuncSetAttribute((const void*)hybrid_fwd, hipFuncAttributeMaxDynamicSharedMemorySize, LDS_BYTES) != hipSuccess) { fprintf(stderr, "kernel_launch: hipFuncSetAttribute failed\n"); grid = -1; return; }
        if (hipOccupancyMaxActiveBlocksPerMultiprocessor(&per_cu, (const void*)hybrid_fwd, NTHREADS, LDS_BYTES) != hipSuccess || per_cu < 1) { fprintf(stderr, "kernel_launch: occupancy query says %d\n", per_cu); }
        (void)hipGetLastError();
        grid = cus;
        if (grid != 256) fprintf(stderr, "kernel_launch: %d CUs (expected 256)\n", grid);
    }
    if (grid < 0) return;
    if (hipMemsetAsync((char*)d_ws + WS_CTL, 0, CTL_BYTES, stream) != hipSuccess) return;
    Params p{};
    for (int i = 0; i < 36; ++i) p.in[i] = (const float*)d_in[i];
    p.out = (float*)d_out; p.ws = (unsigned char*)d_ws; p.pad0 = 0; p.pad1 = 0;
#if MK_N_LAUNCHES == 1
    p.ph_lo = 0; p.ph_hi = N_PHASES;
    hipLaunchKernelGGL(hybrid_fwd, dim3(grid), dim3(NTHREADS), LDS_BYTES, stream, p);
#else
    for (int ph = 0; ph < N_PHASES; ++ph) { p.ph_lo = ph; p.ph_hi = ph + 1; hipLaunchKernelGGL(hybrid_fwd, dim3(grid), dim3(NTHREADS), LDS_BYTES, stream, p); }
#endif
}
```

```cpp
#include <hip/hip_runtime.h>
#include <cstdio>
#include <cstdint>

#ifndef MK_N_LAUNCHES
#define MK_N_LAUNCHES 1
#endif

constexpr int DM = 2048, SEQ = 4096, NPR = 8192, NSM = 128, NR = NPR + NSM  , MP = 8448  ;
constexpr int DFF = 5632, NGU = 2 * DFF, NIN = 5968, NINP = 6144, NSAC = 2608, RWC = 3360;
constexpr int PAST = 2048, NPAGES = 16, PAGE = 128;
constexpr int NCP = 255  , NCS = 127  ;
constexpr float RMS_EPS = 1e-6f, GN_EPS = 64e-5f, NEGV = -1e30f;

constexpr size_t O_Y = 0, O_KV = 17039360, O_WINP = 25559040, O_WINS = 26083328, O_WKVP = 59637760, O_WKVS = 59768832, O_SHP = 68157440, O_SHS = 68164160, O_END = 68594240;

constexpr size_t al256(size_t x) { return (x + 255) & ~(size_t)255; }
constexpr size_t WS_CTL = 0, CTL_BYTES = 65536;
constexpr size_t WS_WGU1 = al256(WS_CTL + CTL_BYTES);
constexpr size_t WS_WDN1 = al256(WS_WGU1 + (size_t)NGU * DM * 2);
constexpr size_t WS_WIN  = al256(WS_WDN1 + (size_t)DM * DFF * 2);
constexpr size_t WS_WOUT = al256(WS_WIN + (size_t)NINP * DM * 2);
constexpr size_t WS_WGU2 = al256(WS_WOUT + (size_t)DM * DM * 2);
constexpr size_t WS_WDN2 = al256(WS_WGU2 + (size_t)NGU * DM * 2);
constexpr size_t WS_A1   = al256(WS_WDN2 + (size_t)DM * DFF * 2);
constexpr size_t WS_A2   = al256(WS_A1 + (size_t)MP * DM * 2);
constexpr size_t WS_A3   = al256(WS_A2 + (size_t)MP * DM * 2);
constexpr size_t WS_AMIX = al256(WS_A3 + (size_t)MP * DM * 2);
constexpr size_t WS_ACT  = al256(WS_AMIX + (size_t)MP * DM * 2);
constexpr size_t WS_O    = al256(WS_ACT + (size_t)MP * DFF * 2);
constexpr size_t WS_H1   = al256(WS_O + (size_t)MP * DM * 4);
constexpr size_t WS_H2   = al256(WS_H1 + (size_t)NR * DM * 4);
constexpr size_t WS_COLS = al256(WS_H2 + (size_t)NR * DM * 4);
constexpr size_t WS_QRAW = al256(WS_COLS + (size_t)MP * NINP * 4);
constexpr size_t WS_QROT = al256(WS_QRAW + (size_t)NR * 1024 * 4);
constexpr size_t WS_KW   = al256(WS_QROT + (size_t)NR * 1024 * 4);
constexpr size_t WS_GATE = al256(WS_KW + (size_t)NR * 512 * 4);
constexpr size_t WS_RW   = al256(WS_GATE + (size_t)NR * 48 * 4);
constexpr size_t WS_V    = al256(WS_RW + (size_t)NR * 5 * 1024 * 4);
constexpr size_t WS_G    = al256(WS_V + (size_t)NR * 1024 * 4);
constexpr size_t WS_Y    = al256(WS_G + (size_t)NR * 1024 * 4);
constexpr size_t WS_BON  = al256(WS_Y + (size_t)NR * 1024 * 4);
constexpr size_t WS_KCP  = al256(WS_BON + (size_t)NR * 16 * 4);
constexpr size_t WS_VCP  = al256(WS_KCP + (size_t)2 * 256 * 256 * 4);
constexpr size_t WS_KCS  = al256(WS_VCP + (size_t)2 * 256 * 256 * 4);
constexpr size_t WS_VCS  = al256(WS_KCS + (size_t)128 * 128 * 256 * 4);
constexpr size_t WS_ROPE = al256(WS_VCS + (size_t)128 * 128 * 256 * 4);
constexpr size_t WS_QRB  = al256(WS_ROPE + (size_t)4096 * 16 * 4);
constexpr size_t WS_QSB  = al256(WS_QRB + (size_t)NPR * 1024 * 2);
constexpr size_t WS_KSB  = al256(WS_QSB + (size_t)NPR * 1024 * 2);
constexpr size_t WS_VSB  = al256(WS_KSB + (size_t)NPR * 256 * 2);
constexpr size_t WS_KWB  = al256(WS_VSB + (size_t)NPR * 256 * 2);
constexpr size_t WS_VWB  = al256(WS_KWB + (size_t)NPR * 256 * 2);
constexpr size_t WS_KCB  = al256(WS_VWB + (size_t)NPR * 256 * 2);
constexpr size_t WS_VCB  = al256(WS_KCB + (size_t)2 * 256 * 256 * 2);
constexpr size_t WS_W1T  = al256(WS_VCB + (size_t)2 * 256 * 256 * 2);
constexpr size_t WS_W2T  = al256(WS_W1T + (size_t)2 * 16 * 256 * 64 * 2);
constexpr size_t WS_PET  = al256(WS_W2T + (size_t)2 * 64 * 128 * 2);
constexpr size_t WS_DEC  = al256(WS_PET + (size_t)2 * 128 * 4);
constexpr size_t WS_AA   = al256(WS_DEC + (size_t)NR * 1024 * 4);
constexpr size_t WS_LW2T = al256(WS_AA + (size_t)NR * 1024 * 4);
constexpr size_t WS_LA2T = al256(WS_LW2T + (size_t)1024 * 64 * 2);
constexpr size_t WS_LG2T = al256(WS_LA2T + (size_t)1024 * 64 * 2);
constexpr size_t CK_REC = 11520;
constexpr size_t WS_CK   = al256(WS_LG2T + (size_t)1024 * 160 * 2);
constexpr size_t WS_OS   = al256(WS_CK + (size_t)8192 * CK_REC + 4096);
constexpr size_t WS_END  = al256(WS_OS + (size_t)8 * 256 * NINP * 4);

constexpr int CW_BAR = 0;
constexpr int CW_QATT = 4096;
constexpr int CW_QMISC = 4160;

constexpr int NTHREADS = 512, NWAVES = 8;
constexpr int LDS_BYTES = 147456;
constexpr int LDS_MISC = 146432;

typedef unsigned short bf16_t;
typedef float p1_f2 __attribute__((ext_vector_type(2)));
typedef __bf16 p1_b2 __attribute__((ext_vector_type(2)));
__device__ __forceinline__ unsigned pack2bf(float lo, float hi) { const p1_f2 v = {lo, hi}; return __builtin_bit_cast(unsigned, __builtin_convertvector(v, p1_b2)); }
__device__ __forceinline__ bf16_t f2bf(float f) { return (bf16_t)(pack2bf(f, 0.f) & 0xffffu); }

struct Params {
    const float* in[36];
    float* out;
    unsigned char* ws;
    int ph_lo, ph_hi, pad0, pad1;
};

#define XB_TMO      128
#define XB_XCNT(j)  (256  + 64 * (j))
#define XB_XSUB(j)  (1280 + 64 * (j))
#define XB_XGEN(j)  (2304 + 64 * (j))
#define XB_TOP      3328
#define XB_TOPGEN   3392
#define XCD_BAR_WORDS 3456
#define XB_SPIN_CAP (1u << 18)
#define LAS __attribute__((address_space(3)))

__device__ __forceinline__ unsigned xb_ld(unsigned* p)              { return __hip_atomic_load(p, __ATOMIC_RELAXED, __HIP_MEMORY_SCOPE_AGENT); }
__device__ __forceinline__ unsigned xb_add(unsigned* p, unsigned v) { return __hip_atomic_fetch_add(p, v, __ATOMIC_RELAXED, __HIP_MEMORY_SCOPE_AGENT); }
__device__ __forceinline__ unsigned xb_xcc_id() { return (unsigned)__builtin_amdgcn_s_getreg((3 << 11) | 20) & 0xFu; }
#define XB_SPIN(cond, bar) do { unsigned _sp = 0; while (cond) { __builtin_amdgcn_s_sleep(1); \
    if ((++_sp & 255u) == 0u) { if (xb_ld(&(bar)[XB_TMO])) break; if (_sp > XB_SPIN_CAP) { atomicAdd(&(bar)[XB_TMO], 1u); break; } } } } while (0)

struct XcdBarrier {
    unsigned* bar; unsigned x;
    volatile LAS unsigned* st;
};

__device__ __forceinline__ XcdBarrier xcd_barrier_post(unsigned* bar, volatile LAS unsigned* st) {
    XcdBarrier b; b.bar = bar; b.x = xb_xcc_id(); b.st = st;
    if (threadIdx.x == 0) (void)xb_add(&bar[XB_XCNT(b.x)], 1u);
    return b;
}
__device__ __forceinline__ void xcd_barrier_complete(unsigned* bar, unsigned x, unsigned& nloc, unsigned& nx) {
    const unsigned G = gridDim.x * gridDim.y * gridDim.z;
    unsigned sum, cnt, mine, sp = 0u;
    for (;;) {
        sum = 0u; cnt = 0u; mine = 0u;
#pragma unroll
        for (unsigned j = 0; j < 16; ++j) { const unsigned c = xb_ld(&bar[XB_XCNT(j)]); sum += c; cnt += (c > 0u) ? 1u : 0u; mine = (j == x) ? c : mine; }
        if (sum == G) break;
        __builtin_amdgcn_s_sleep(1);
        if ((++sp & 255u) == 0u) { if (xb_ld(&bar[XB_TMO])) break; if (sp > XB_SPIN_CAP) { atomicAdd(&bar[XB_TMO], 1u); break; } }
    }
    nloc = mine > 0u ? mine : 1u; nx = cnt > 0u ? cnt : 1u;
}

__device__ __forceinline__ void xcd_barrier(const XcdBarrier& b) {
    asm volatile("s_waitcnt vmcnt(0)" ::: "memory");
    __syncthreads();
    if (threadIdx.x == 0) {
        unsigned* bar = b.bar;
        __builtin_amdgcn_s_waitcnt(0);
        unsigned nloc = b.st[0], nx = b.st[1];
        if (nloc == 0u) { xcd_barrier_complete(bar, b.x, nloc, nx); b.st[0] = nloc; b.st[1] = nx; }
        const unsigned old = xb_add(&bar[XB_XSUB(b.x)], 1u);
        const unsigned gen = old / nloc;
        if (old + 1u == (gen + 1u) * nloc) {
            __builtin_amdgcn_fence(__ATOMIC_RELEASE, "agent");
            asm volatile("s_waitcnt vmcnt(0)" ::: "memory");
            const unsigned og = xb_add(&bar[XB_TOP], 1u);
            const unsigned tg = og / nx;
            if (og + 1u == (tg + 1u) * nx) xb_add(&bar[XB_TOPGEN], 1u);
            else XB_SPIN(xb_ld(&bar[XB_TOPGEN]) == tg, bar);
            __builtin_amdgcn_fence(__ATOMIC_ACQUIRE, "agent");
            xb_add(&bar[XB_XGEN(b.x)], 1u);
            asm volatile("s_waitcnt vmcnt(0)" ::: "memory");
        } else {
            XB_SPIN(xb_ld(&bar[XB_XGEN(b.x)]) == gen, bar);
            __builtin_amdgcn_fence(__ATOMIC_ACQUIRE, "agent");
            asm volatile("s_waitcnt vmcnt(0)" ::: "memory");
        }
    }
    __syncthreads();
}
namespace pg8 {
#define PG8_LAS __attribute__((address_space(3)))
typedef unsigned short bf16_t;
typedef short bf16x8 __attribute__((ext_vector_type(8)));
typedef float f32x4 __attribute__((ext_vector_type(4)));
typedef unsigned u32x4 __attribute__((ext_vector_type(4)));
constexpr int BM = 256, BK = 64, HALF = 128, HTB = HALF * BK * 2  , STAGE_BYTES = 8 * HTB, NXCD = 8, WGM = 8;

__host__ __device__ __forceinline__ int lds_byte(int r, int c) { const int st = (r >> 4) * 2 + (c >> 5), rr = r & 15, cc = c & 31, ob = rr * 64 + cc * 2; return st * 1024 + (ob ^ (((ob >> 9) & 1) << 5)); }
__host__ __device__ __forceinline__ void stage_rc(int b, int& R, int& C) { const int st = b / 1024, sb = b % 1024, swz = sb ^ (((sb >> 9) & 1) << 5); R = (st >> 1) * 16 + swz / 64; C = (st & 1) * 32 + (swz % 64) / 2; }
__host__ __device__ __forceinline__ int perm32(int rho) { const int n = rho >> 4, i = rho & 15; return 8 * (i >> 2) + 4 * n + (i & 3); }

struct Unit { int pm, pn, ko, ks; };
struct Gemm { const bf16_t* A; const bf16_t* Bt; int M, N, K, ld; };

struct StaticOrder {
    int nM, nN, nwg, G, c;
    __host__ __device__ void init(int M, int N, int G_, int c_) { nM = M / BM; nN = N / BM; nwg = nM * nN; G = G_; c = c_; }
    __host__ __device__ bool next(int i, Unit& u) const {
        const long L = (long)i * G + c; if (L >= nwg) return false;
        int wgid = (int)L; { const int q = nwg / NXCD, r = nwg % NXCD, xcd = wgid % NXCD, off = wgid / NXCD; wgid = (xcd < r ? xcd * (q + 1) : r * (q + 1) + (xcd - r) * q) + off; }
        const int nig = WGM * nN, gid = wgid / nig, fm = gid * WGM, gsz = (nM - fm) < WGM ? (nM - fm) : WGM;
        u.pm = fm + ((wgid % nig) % gsz); u.pn = (wgid % nig) / gsz; u.ko = 0; u.ks = 0; return true;
    }
    __device__ __forceinline__ void a_ready(const Unit&) const {}
    __device__ __forceinline__ void done(const Unit&) const {}
};
struct SplitOrder {
    int nN, nsplit, ksub, G, c;
    __host__ __device__ bool next(int i, Unit& u) const { const long L = (long)i * G + c; if (L >= (long)nN * nsplit) return false; u.pm = 0; u.pn = (int)(L % nN); u.ks = (int)(L / nN); u.ko = u.ks * ksub; return true; }
    __device__ __forceinline__ void a_ready(const Unit&) const {}
    __device__ __forceinline__ void done(const Unit&) const {}
};
typedef float cvt_f2 __attribute__((ext_vector_type(2)));
typedef __bf16 cvt_b2 __attribute__((ext_vector_type(2)));
__device__ __forceinline__ unsigned cvt_pk_bf16(float lo, float hi) { const cvt_f2 v = {lo, hi}; return __builtin_bit_cast(unsigned, __builtin_convertvector(v, cvt_b2)); }
typedef float f32x2 __attribute__((ext_vector_type(2)));
__device__ __forceinline__ f32x2 gelu_pk(f32x2 v) {
    const f32x2 av = __builtin_elementwise_abs(v), d = av * 0.2316418882f + 1.0f;
    f32x2 t; t.x = __builtin_amdgcn_rcpf(d.x); t.y = __builtin_amdgcn_rcpf(d.y);
    f32x2 q = t * 0.5307027145f + (-0.7265760135f); q = q * t + 0.7107068705f; q = q * t + (-0.142248368f); q = q * t + 0.127414796f; q = q * t;
    const f32x2 s = (v * v) * (-0.72134752044f);
    f32x2 e; e.x = __builtin_amdgcn_exp2f(s.x); e.y = __builtin_amdgcn_exp2f(s.y);
    const f32x2 m = v * (q * e), r = v - m;
    f32x2 o; o.x = v.x < 0.f ? m.x : r.x; o.y = v.y < 0.f ? m.y : r.y; return o;
}

struct EpiF32 {
    static constexpr bool PERM = false, AFTER_DRAIN = false;
    float* C0; int ldc; const float* bias; size_t slab;
    __device__ __forceinline__ void operator()(const f32x4 (&acc)[2][2][4][2], const Unit& u, int wr, int wc, int fr, int fq) const {
        float* C = C0 + (size_t)u.ks * slab;
        const int row0 = u.pm * BM + wr * 64 + fr, col0 = u.pn * BM + wc * 32 + 4 * fq;
        f32x4 bv[2][2];
#pragma unroll
        for (int bj = 0; bj < 2; ++bj)
#pragma unroll
            for (int n = 0; n < 2; ++n) bv[bj][n] = bias ? *(const f32x4*)(bias + col0 + bj * HALF + n * 16) : (f32x4){0.f, 0.f, 0.f, 0.f};
#pragma unroll
        for (int ai = 0; ai < 2; ++ai)
#pragma unroll
            for (int m = 0; m < 4; ++m) { float* rowp = C + (size_t)(row0 + ai * HALF + m * 16) * ldc + col0;
#pragma unroll
                for (int bj = 0; bj < 2; ++bj)
#pragma unroll
                    for (int n = 0; n < 2; ++n) *(f32x4*)(rowp + bj * HALF + n * 16) = acc[ai][bj][m][n] + bv[bj][n]; }
    }
};
struct EpiB16 {
    static constexpr bool PERM = true, AFTER_DRAIN = false;
    bf16_t* O; int ldc;
    __device__ __forceinline__ void operator()(const f32x4 (&acc)[2][2][4][2], const Unit& u, int wr, int wc, int fr, int fq) const {
        const int row0 = u.pm * BM + wr * 64 + fr, col0 = u.pn * BM + wc * 32 + 8 * fq;
#pragma unroll
        for (int ai = 0; ai < 2; ++ai)
#pragma unroll
            for (int m = 0; m < 4; ++m) { bf16_t* rowp = O + (size_t)(row0 + ai * HALF + m * 16) * ldc + col0;
#pragma unroll
                for (int bj = 0; bj < 2; ++bj) { const f32x4 v0 = acc[ai][bj][m][0], v1 = acc[ai][bj][m][1];
                    u32x4 w; w.x = cvt_pk_bf16(v0[0], v0[1]); w.y = cvt_pk_bf16(v0[2], v0[3]); w.z = cvt_pk_bf16(v1[0], v1[1]); w.w = cvt_pk_bf16(v1[2], v1[3]);
                    *(u32x4*)(rowp + bj * HALF) = w; } }
    }
};
template <class Epi, class Sched, bool STAMP = false>
__device__ __forceinline__ void gemm_phase(PG8_LAS unsigned char* lds, const Gemm g, const Sched& S, const Epi& E, unsigned long long* stamps) {
    int tid_ = threadIdx.x; asm volatile("" : "+v"(tid_));
    const int tid = tid_, wid = __builtin_amdgcn_readfirstlane(tid >> 6), lane = tid & 63, wr = wid >> 2, wc = wid & 3, fr = lane & 15, fq = lane >> 4;
    const int K = g.K, nt = K / BK;
    int ts_lo = 0, ts_hi = 0, nts = 0; const unsigned long long rt_entry = STAMP ? (unsigned long long)wall_clock64() : 0ull;
#define PG8_STAMP() do { if (STAMP && wid == 0 && nts < 64) { const unsigned long long _c = (unsigned long long)clock64(); \
        ts_lo = (lane == nts) ? (int)(unsigned)_c : ts_lo; ts_hi = (lane == nts) ? (int)(unsigned)(_c >> 32) : ts_hi; ++nts; } } while (0)
    PG8_STAMP();
    unsigned voffA[2], voffB[2];
#pragma unroll
    for (int i = 0; i < 2; ++i) { int R, C; stage_rc(tid * 16 + i * 8192, R, C); const int Rb = Epi::PERM ? ((R & ~31) + perm32(R & 31)) : R;
        voffA[i] = (unsigned)(R * g.ld + C) * 2u; voffB[i] = (unsigned)(Rb * g.ld + C) * 2u; }
    const size_t kstep = (size_t)(BK * 2);
    const size_t hstep = (size_t)HALF * g.ld * 2;
    const size_t tstep = 2 * hstep;
    const unsigned ldsw = (unsigned)wid * 1024u;
    const int aoff = lds_byte(wr * 64 + fr, fq * 8), boff = lds_byte(wc * 32 + fr, fq * 8);
#define PG8_SA(b, h) (((b) * 2 + (h)) * HTB)
#define PG8_SB(b, h) ((4 + (b) * 2 + (h)) * HTB)
#define PG8_STAGE(bufoff, gbase, voff) do { _Pragma("unroll") for (int _i = 0; _i < 2; ++_i) \
        __builtin_amdgcn_global_load_lds((const unsigned*)((const char*)(gbase) + (voff)[_i]), (PG8_LAS unsigned*)(lds + (bufoff) + ldsw + _i * 8192), 16, 0, 0); } while (0)
#define PG8_LDA(dst, b, h) do { _Pragma("unroll") for (int m = 0; m < 4; ++m) _Pragma("unroll") for (int k = 0; k < 2; ++k) dst[m][k] = *(const PG8_LAS bf16x8*)(lds + PG8_SA(b, h) + aoff + m * 2048 + k * 1024); } while (0)
#define PG8_LDB(dst, b, h) do { _Pragma("unroll") for (int n = 0; n < 2; ++n) _Pragma("unroll") for (int k = 0; k < 2; ++k) dst[n][k] = *(const PG8_LAS bf16x8*)(lds + PG8_SB(b, h) + boff + n * 2048 + k * 1024); } while (0)
#define PG8_MMA(ai, bj, At, Bt) do { __builtin_amdgcn_s_setprio(1); _Pragma("unroll") for (int m = 0; m < 4; ++m) _Pragma("unroll") for (int n = 0; n < 2; ++n) _Pragma("unroll") for (int k = 0; k < 2; ++k) \
        acc[ai][bj][m][n] = __builtin_amdgcn_mfma_f32_16x16x32_bf16(Bt[n][k], At[m][k], acc[ai][bj][m][n], 0, 0, 0); __builtin_amdgcn_s_setprio(0); } while (0)
#define PG8_WAIT_V(n) asm volatile("s_waitcnt vmcnt(" #n ")" ::: "memory")
#define PG8_WAIT_L(n) asm volatile("s_waitcnt lgkmcnt(" #n ")" ::: "memory")
#define PG8_BAR __builtin_amdgcn_s_barrier()
#define PG8_SCHED __builtin_amdgcn_sched_barrier(0)
    Unit cur, nxt; int ui = 0;
    if (!S.next(0, cur)) return;
    f32x4 acc[2][2][4][2];
#pragma unroll
    for (int a = 0; a < 2; ++a)
#pragma unroll
        for (int b = 0; b < 2; ++b)
#pragma unroll
            for (int m = 0; m < 4; ++m)
#pragma unroll
                for (int n = 0; n < 2; ++n) acc[a][b][m][n] = (f32x4){0.f, 0.f, 0.f, 0.f};
    bf16x8 At[4][2], B0[2][2], B1[2][2];
    const char* cA = (const char*)g.A + (size_t)cur.pm * tstep + (size_t)cur.ko * 2; const char* cB = (const char*)g.Bt + (size_t)cur.pn * tstep + (size_t)cur.ko * 2;
    S.a_ready(cur);
    PG8_STAGE(PG8_SB(0, 0), cB, voffB); PG8_STAGE(PG8_SA(0, 0), cA, voffA); PG8_STAGE(PG8_SB(0, 1), cB + hstep, voffB); PG8_STAGE(PG8_SA(0, 1), cA + hstep, voffA);
    if (wr == 1) PG8_BAR;
    PG8_WAIT_V(4); PG8_BAR;
    PG8_STAGE(PG8_SB(1, 0), cB + kstep, voffB); PG8_STAGE(PG8_SA(1, 0), cA + kstep, voffA); PG8_STAGE(PG8_SB(1, 1), cB + hstep + kstep, voffB);
    PG8_WAIT_V(6); PG8_BAR;
    PG8_STAMP();
    for (;;) {
        const bool has_next = S.next(ui + 1, nxt);
        const char* nA = has_next ? (const char*)g.A + (size_t)nxt.pm * tstep + (size_t)nxt.ko * 2 : cA; const char* nB = has_next ? (const char*)g.Bt + (size_t)nxt.pn * tstep + (size_t)nxt.ko * 2 : cB;
        for (int t = 0; t < nt; t += 2) {
            const bool last = (t == nt - 2);
            const char* a1 = cA + (size_t)(t + 1) * kstep;
            const char* a2 = last ? nA : cA + (size_t)(t + 2) * kstep; const char* b2 = last ? nB : cB + (size_t)(t + 2) * kstep;
            const char* a3 = a2 + kstep; const char* b3 = b2 + kstep;
            if (last && has_next) S.a_ready(nxt);
            PG8_LDB(B0, 0, 0); PG8_SCHED; PG8_LDA(At, 0, 0); PG8_STAGE(PG8_SA(1, 1), a1 + hstep, voffA);
            PG8_WAIT_L(8); PG8_BAR; PG8_WAIT_L(0); PG8_MMA(0, 0, At, B0); PG8_BAR; PG8_SCHED;
            PG8_LDB(B1, 0, 1); PG8_STAGE(PG8_SB(0, 0), b2, voffB);
            PG8_BAR; PG8_WAIT_L(0); PG8_MMA(0, 1, At, B1); PG8_BAR;
            PG8_LDA(At, 0, 1); PG8_STAGE(PG8_SA(0, 0), a2, voffA);
            PG8_BAR; PG8_WAIT_L(0); PG8_MMA(1, 0, At, B0); PG8_BAR; PG8_SCHED;
            PG8_STAGE(PG8_SB(0, 1), b2 + hstep, voffB);
            PG8_WAIT_V(6); PG8_BAR; PG8_MMA(1, 1, At, B1); PG8_BAR;
            PG8_LDB(B0, 1, 0); PG8_SCHED; PG8_LDA(At, 1, 0); PG8_STAGE(PG8_SA(0, 1), a2 + hstep, voffA);
            PG8_WAIT_L(8); PG8_BAR; PG8_WAIT_L(0); PG8_MMA(0, 0, At, B0); PG8_BAR; PG8_SCHED;
            PG8_LDB(B1, 1, 1); PG8_STAGE(PG8_SB(1, 0), b3, voffB);
            PG8_BAR; PG8_WAIT_L(0); PG8_MMA(0, 1, At, B1); PG8_BAR;
            PG8_LDA(At, 1, 1); PG8_STAGE(PG8_SA(1, 0), a3, voffA);
            PG8_BAR; PG8_WAIT_L(0); PG8_MMA(1, 0, At, B0); PG8_BAR; PG8_SCHED;
            PG8_STAGE(PG8_SB(1, 1), b3 + hstep, voffB);
            PG8_WAIT_V(6); PG8_BAR; PG8_MMA(1, 1, At, B1); PG8_BAR;
        }
        PG8_STAMP();
        if constexpr (!Epi::AFTER_DRAIN) { E(acc, cur, wr, wc, fr, fq); S.done(cur); }
        PG8_STAMP();
        if (!has_next) break;
#pragma unroll
        for (int a = 0; a < 2; ++a)
#pragma unroll
            for (int b = 0; b < 2; ++b)
#pragma unroll
                for (int m = 0; m < 4; ++m)
#pragma unroll
                    for (int n = 0; n < 2; ++n) acc[a][b][m][n] = (f32x4){0.f, 0.f, 0.f, 0.f};
        cur = nxt; cA = nA; cB = nB; ++ui;
    }
    PG8_WAIT_V(0);
    if (wr == 0) PG8_BAR;
    PG8_BAR;
    if constexpr (Epi::AFTER_DRAIN) { E.fused(acc, cur, wr, wc, fr, fq, lds, wid, lane); S.done(cur); }
    PG8_STAMP();
    if (STAMP && wid == 0) { stamps[lane] = lane < nts ? (((unsigned long long)(unsigned)ts_hi << 32) | (unsigned)ts_lo) : 0ull;
        if (lane == 62) stamps[62] = rt_entry; if (lane == 63) stamps[63] = (unsigned long long)wall_clock64(); }
#undef PG8_STAMP
#undef PG8_SA
#undef PG8_SB
#undef PG8_STAGE
#undef PG8_LDA
#undef PG8_LDB
#undef PG8_MMA
#undef PG8_WAIT_V
#undef PG8_WAIT_L
#undef PG8_BAR
#undef PG8_SCHED
}

struct EpiSwiGLU {
    static constexpr bool PERM = true, AFTER_DRAIN = false;
    bf16_t* O; int ldc;
    __device__ __forceinline__ void operator()(const f32x4 (&acc)[2][2][4][2], const Unit& u, int wr, int wc, int fr, int fq) const {
        const int row0 = u.pm * BM + wr * 64 + fr, col0 = u.pn * HALF + wc * 32 + 8 * fq;
#pragma unroll
        for (int ai = 0; ai < 2; ++ai)
#pragma unroll
            for (int m = 0; m < 4; ++m) {
                bf16_t* rowp = O + (size_t)(row0 + ai * HALF + m * 16) * ldc + col0;
                float r[8];
#pragma unroll
                for (int n = 0; n < 2; ++n)
#pragma unroll
                    for (int j = 0; j < 4; ++j) { const float g = acc[ai][0][m][n][j], up = acc[ai][1][m][n][j];
                        r[n * 4 + j] = g * __builtin_amdgcn_rcpf(1.0f + __expf(-g)) * up; }
                u32x4 w; w.x = cvt_pk_bf16(r[0], r[1]); w.y = cvt_pk_bf16(r[2], r[3]); w.z = cvt_pk_bf16(r[4], r[5]); w.w = cvt_pk_bf16(r[6], r[7]);
                *(u32x4*)rowp = w;
            }
    }
};
}

#define WAVE_SYNC() asm volatile("s_waitcnt lgkmcnt(0)" ::: "memory")
template <int CTRL> __device__ __forceinline__ float dpp_mov(float v) { return __builtin_bit_cast(float, __builtin_amdgcn_update_dpp(0, __builtin_bit_cast(int, v), CTRL, 0xF, 0xF, true)); }
__device__ __forceinline__ float xor16_get(float v, float& other) {
    const unsigned u = __builtin_bit_cast(unsigned, v);
    auto r = __builtin_amdgcn_permlane16_swap(u, u, false, false);
    other = __builtin_bit_cast(float, (unsigned)r[1]); return __builtin_bit_cast(float, (unsigned)r[0]);
}
__device__ __forceinline__ float xor32_get(float v, float& other) {
    const unsigned u = __builtin_bit_cast(unsigned, v);
    auto r = __builtin_amdgcn_permlane32_swap(u, u, false, false);
    other = __builtin_bit_cast(float, (unsigned)r[1]); return __builtin_bit_cast(float, (unsigned)r[0]);
}
__device__ __forceinline__ float red16(float v) {
    v += dpp_mov<0xB1>(v);
    v += dpp_mov<0x4E>(v);
    v += dpp_mov<0x124>(v);
    v += dpp_mov<0x128>(v);
    return v;
}
__device__ __forceinline__ float max16(float v) {
    v = fmaxf(v, dpp_mov<0xB1>(v)); v = fmaxf(v, dpp_mov<0x4E>(v)); v = fmaxf(v, dpp_mov<0x124>(v)); v = fmaxf(v, dpp_mov<0x128>(v));
    return v;
}
__device__ __forceinline__ float sum_q(float v) {
    float o; float a = xor16_get(v, o); v = a + o; a = xor32_get(v, o); return a + o;
}
__device__ __forceinline__ float max_q(float v) {
    float o; float a = xor16_get(v, o); v = fmaxf(a, o); a = xor32_get(v, o); return fmaxf(a, o);
}
__device__ __forceinline__ float sum_quad(float v) { v += dpp_mov<0xB1>(v); v += dpp_mov<0x4E>(v); return v; }
__device__ __forceinline__ float wave_sum(float v) { return sum_q(red16(v)); }
__device__ __forceinline__ float wave_max(float v) { return max_q(max16(v)); }
__device__ __forceinline__ float4 ldnt4(const float* p) { typedef float f4v __attribute__((ext_vector_type(4))); const f4v v = __builtin_nontemporal_load((const f4v*)p); return make_float4(v[0], v[1], v[2], v[3]); }
__device__ __forceinline__ float dot4(const float4& a, const float4& b) { return a.x * b.x + a.y * b.y + a.z * b.z + a.w * b.w; }
__device__ __forceinline__ float sigmoidf_(float x) { return 1.0f / (1.0f + __expf(-x)); }
__device__ __forceinline__ float siluf_(float x) { return x / (1.0f + __expf(-x)); }

__constant__ double ROPE_INV[8] = {1.0, 0.19392274474868576, 0.03760603093086393, 0.007292664737217109, 0.001414213562373095, 0.0002742481756762073, 5.318295896944988e-05, 1.031338537721246e-05};

struct Ctx {
    const Params* p;
    unsigned char* ws;
    float* out;
    unsigned char* lds;
    int tid, lane, wave, bid, G;
};
#define WSP(T, off) ((T*)(c.ws + (off)))

struct TileD { const float* src; bf16_t* dst; int ldsrc, c0, nvalid, k0, K, n0; };
constexpr int NT_GU = (DM / 64) * (NGU / 64), NT_DN = (DFF / 64) * (DM / 64), NT_IN = (DM / 64) * (NINP / 64), NT_OUT = (DM / 64) * (DM / 64);
constexpr int NT_ALL = 2 * NT_GU + 2 * NT_DN + NT_IN + NT_OUT;
__device__ __forceinline__ TileD tile_desc(const Ctx& c, int t) {
    TileD d;
    d.src = t < NT_GU ? c.p->in[9] : t < 2 * NT_GU ? c.p->in[33] : t < 2 * NT_GU + NT_DN ? c.p->in[10] : t < 2 * NT_GU + 2 * NT_DN ? c.p->in[34] : t < 2 * NT_GU + 2 * NT_DN + NT_IN ? c.p->in[12] : c.p->in[30];
    if (t < 2 * NT_GU) { const int w = t >= NT_GU; t -= w * NT_GU; const int nkt = DM / 64, kt = t % nkt, rr = (t / nkt) * 64;
         d.dst = (bf16_t*)(c.ws + (w ? WS_WGU2 : WS_WGU1)); d.ldsrc = NGU; d.c0 = ((rr % 256) / 128) * DFF + 128 * (rr / 256) + (rr % 128); d.nvalid = 64; d.k0 = kt * 64; d.K = DM; d.n0 = rr; return d; }
    t -= 2 * NT_GU;
    if (t < 2 * NT_DN) { const int w = t >= NT_DN; t -= w * NT_DN; const int nkt = DFF / 64, kt = t % nkt, nt = t / nkt;
         d.dst = (bf16_t*)(c.ws + (w ? WS_WDN2 : WS_WDN1)); d.ldsrc = DM; d.c0 = nt * 64; d.nvalid = 64; d.k0 = kt * 64; d.K = DFF; d.n0 = nt * 64; return d; }
    t -= 2 * NT_DN;
    if (t < NT_IN) { const int nkt = DM / 64, kt = t % nkt, nt = t / nkt; int nv = NIN - nt * 64; nv = nv < 0 ? 0 : (nv > 64 ? 64 : nv);
        d.dst = (bf16_t*)(c.ws + WS_WIN); d.ldsrc = NIN; d.c0 = nt * 64; d.nvalid = nv; d.k0 = kt * 64; d.K = DM; d.n0 = nt * 64; return d; }
    t -= NT_IN;
    { const int nkt = DM / 64, kt = t % nkt, nt = t / nkt;
        d.dst = (bf16_t*)(c.ws + WS_WOUT); d.ldsrc = DM; d.c0 = nt * 64; d.nvalid = 64; d.k0 = kt * 64; d.K = DM; d.n0 = nt * 64; return d; }
}
__device__ __forceinline__ void tile_load(const TileD& d, int tid, float4& a, float4& b) {
    const int k = tid >> 3, c8 = (tid & 7) * 8;
    const float* s0 = d.src + (size_t)d.k0 * d.ldsrc + (d.nvalid > 0 ? d.c0 : 0);
    const float* s = d.src + (size_t)(d.k0 + k) * d.ldsrc + d.c0 + c8;
    const float* sa = c8 < d.nvalid ? s : s0; const float* sb = c8 + 4 < d.nvalid ? s + 4 : s0;
    a = *(const float4*)sa; b = *(const float4*)sb;
}
__device__ __forceinline__ void convert_weights(const Ctx& c) {
    const int tid = c.tid;
    float* T0 = (float*)c.lds;
    float4 a0, b0, a1, b1, a2, b2, a3, b3;
    int par = 0;
#define CW_LOAD(av, bv, tt) { const int tc_ = (tt) < NT_ALL ? (tt) : NT_ALL - 1; const TileD dl_ = tile_desc(c, tc_); tile_load(dl_, tid, av, bv); }
#define CW_STEP(av, bv, tt) { const int te_ = (tt) < NT_ALL ? (tt) : NT_ALL - 1; const TileD d = tile_desc(c, te_); float* T = T0 + par * (64 * 65); \
        { const int k = tid >> 3, c8 = (tid & 7) * 8; float* tp = T + k * 65 + c8; const bool va_ = c8 < d.nvalid, vb_ = c8 + 4 < d.nvalid; \
          tp[0] = va_ ? av.x : 0.f; tp[1] = va_ ? av.y : 0.f; tp[2] = va_ ? av.z : 0.f; tp[3] = va_ ? av.w : 0.f; tp[4] = vb_ ? bv.x : 0.f; tp[5] = vb_ ? bv.y : 0.f; tp[6] = vb_ ? bv.z : 0.f; tp[7] = vb_ ? bv.w : 0.f; } \
        CW_LOAD(av, bv, (tt) + 4 * c.G) \
        __syncthreads(); \
        { const int kg = tid & 7, n = tid >> 3; unsigned w[4]; \
          _Pragma("unroll") for (int j = 0; j < 4; ++j) w[j] = pack2bf(T[(kg * 8 + 2 * j) * 65 + n], T[(kg * 8 + 2 * j + 1) * 65 + n]); \
          *(uint4*)(d.dst + (size_t)(d.n0 + n) * d.K + d.k0 + kg * 8) = make_uint4(w[0], w[1], w[2], w[3]); } \
        par ^= 1; }
    CW_LOAD(a0, b0, c.bid) CW_LOAD(a1, b1, c.bid + c.G) CW_LOAD(a2, b2, c.bid + 2 * c.G) CW_LOAD(a3, b3, c.bid + 3 * c.G)
#pragma unroll 1
    for (int t = c.bid; t < NT_ALL; t += 4 * c.G) {
        CW_STEP(a0, b0, t)
        CW_STEP(a1, b1, t + c.G)
        CW_STEP(a2, b2, t + 2 * c.G)
        CW_STEP(a3, b3, t + 3 * c.G)
    }
#undef CW_LOAD
#undef CW_STEP
    __syncthreads();
}

__device__ __forceinline__ void row_norm_bf16(const float* x, const float* g, bf16_t* a, int lane) {
    float4 v[8]; float ss = 0.f;
#pragma unroll
    for (int i = 0; i < 8; ++i) { v[i] = *(const float4*)(x + (i * 64 + lane) * 4); ss += dot4(v[i], v[i]); }
    ss = wave_sum(ss);
    const float s = rsqrtf(ss * (1.0f / DM) + RMS_EPS);
#pragma unroll
    for (int i = 0; i < 8; ++i) { const float4 gg = *(const float4*)(g + (i * 64 + lane) * 4);
        *(uint2*)(a + (i * 64 + lane) * 4) = make_uint2(pack2bf(v[i].x * s * gg.x, v[i].y * s * gg.y), pack2bf(v[i].z * s * gg.z, v[i].w * s * gg.w)); }
}

__device__ __forceinline__ const float* x_row(const Ctx& c, int row) { return row < NPR ? c.p->in[0] + (size_t)row * DM : c.p->in[1] + (size_t)(row - NPR) * DM; }

__device__ __forceinline__ void p0_prologue(const Ctx& c) {
    convert_weights(c);
#pragma unroll 1
    for (int r = c.bid * NWAVES + c.wave; r < NR; r += c.G * NWAVES)
        row_norm_bf16(x_row(c, r), c.p->in[7], WSP(bf16_t, WS_A1) + (size_t)r * DM, c.lane);
#pragma unroll 1
    for (int e = c.bid * NTHREADS + c.tid; e < 4096 * 8; e += c.G * NTHREADS) {
        const int pos = e >> 3, i = e & 7;
        const double inv = ROPE_INV[i];
        double rev = (double)pos * inv * 0.15915494309189535;
        rev -= floor(rev);
        const float a = (float)(rev * 6.283185307179586);
        float* rt = WSP(float, WS_ROPE) + pos * 16;
        rt[i] = cosf(a); rt[8 + i] = sinf(a);
    }
#pragma unroll 1
    for (int e = c.bid * NTHREADS + c.tid; e < 2 * 16 * 256 * 64; e += c.G * NTHREADS) {
        const int d = e & 63, n = (e >> 6) & 255, sl = (e >> 14) & 15, kv = e >> 18, hf = n >> 7, h = n & 127;
        WSP(bf16_t, WS_W1T)[e] = f2bf(c.p->in[kv ? 17 : 14][((size_t)(hf * 16 + sl) * 64 + d) * 128 + h]);
    }
#pragma unroll 1
    for (int e = c.bid * NTHREADS + c.tid; e < 2 * 64 * 128; e += c.G * NTHREADS) {
        const int h = e & 127, dd = (e >> 7) & 63, kv = e >> 13;
        WSP(bf16_t, WS_W2T)[e] = f2bf(c.p->in[kv ? 18 : 15][h * 64 + dd]);
    }
#pragma unroll 1
    for (int o = c.bid * NWAVES + c.wave; o < 256; o += c.G * NWAVES) {
        const int kv = o >> 7, h = o & 127; const float* pe = c.p->in[kv ? 16 : 13]; const float* w1 = c.p->in[kv ? 17 : 14];
        float s = 0.f;
#pragma unroll
        for (int i = 0; i < 32; ++i) { const int k = i * 64 + c.lane; s += pe[k] * w1[(size_t)k * 128 + h]; }
        s = wave_sum(s);
        if (c.lane == 0) WSP(float, WS_PET)[o] = s;
    }
#pragma unroll 1
    for (int e = c.bid * NTHREADS + c.tid; e < 1024 * 64; e += c.G * NTHREADS) { const int k = e & 63, n = e >> 6;
        WSP(bf16_t, WS_LW2T)[e] = f2bf(c.p->in[21][k * 1024 + n]); WSP(bf16_t, WS_LA2T)[e] = f2bf(c.p->in[23][k * 1024 + n]); }
#pragma unroll 1
    for (int e = c.bid * NTHREADS + c.tid; e < 1024 * 160; e += c.G * NTHREADS) { const int k = e % 160, n = e / 160;
        WSP(bf16_t, WS_LG2T)[e] = f2bf(c.p->in[24][k * 1024 + n]); }
}

struct ThinRow { float4 v[8]; float ss; };
__device__ __forceinline__ void thin_load(const Ctx& c, ThinRow& t, const float* O, int nsplit, int r) {
    t.ss = 0.f;
#pragma unroll
    for (int i = 0; i < 8; ++i) {
        if (r < NPR) { const uint2 w = *(const uint2*)((const bf16_t*)O + (size_t)r * DM + (i * 64 + c.lane) * 4);
            t.v[i] = make_float4(__uint_as_float(w.x << 16), __uint_as_float(w.x & 0xffff0000u), __uint_as_float(w.y << 16), __uint_as_float(w.y & 0xffff0000u)); }
        else { const float* os = WSP(const float, WS_OS) + (size_t)(r - NPR) * DM + (i * 64 + c.lane) * 4; float4 a = *(const float4*)os;
            for (int sp = 1; sp < nsplit; ++sp) { const float4 x = *(const float4*)(os + (size_t)sp * 256 * DM); a.x += x.x; a.y += x.y; a.z += x.z; a.w += x.w; }
            t.v[i] = a; }
        t.ss += dot4(t.v[i], t.v[i]); }
}
__device__ __forceinline__ void thin_finish(const Ctx& c, ThinRow& t, int r, int base_kind, const float* gpost, float scale, float* hout, const float* gpre, bf16_t* aout) {
    const float* bs = base_kind == 0 ? x_row(c, r) : (base_kind == 1 ? WSP(const float, WS_H1) : WSP(const float, WS_H2)) + (size_t)r * DM;
    float4 b[8];
#pragma unroll
    for (int i = 0; i < 8; ++i) b[i] = *(const float4*)(bs + (i * 64 + c.lane) * 4);
    const float ss = wave_sum(t.ss);
    const float s = rsqrtf(ss * (1.0f / DM) + RMS_EPS) * scale;
    float s2 = 0.f;
#pragma unroll
    for (int i = 0; i < 8; ++i) { const float4 gg = *(const float4*)(gpost + (i * 64 + c.lane) * 4);
        t.v[i].x = b[i].x + t.v[i].x * s * gg.x; t.v[i].y = b[i].y + t.v[i].y * s * gg.y; t.v[i].z = b[i].z + t.v[i].z * s * gg.z; t.v[i].w = b[i].w + t.v[i].w * s * gg.w;
        *(float4*)(hout + (size_t)r * DM + (i * 64 + c.lane) * 4) = t.v[i]; s2 += dot4(t.v[i], t.v[i]); }
    if (aout) {
        s2 = wave_sum(s2);
        const float q = rsqrtf(s2 * (1.0f / DM) + RMS_EPS);
#pragma unroll
        for (int i = 0; i < 8; ++i) { const float4 gg = *(const float4*)(gpre + (i * 64 + c.lane) * 4);
            *(uint2*)(aout + (size_t)r * DM + (i * 64 + c.lane) * 4) = make_uint2(pack2bf(t.v[i].x * q * gg.x, t.v[i].y * q * gg.y), pack2bf(t.v[i].z * q * gg.z, t.v[i].w * q * gg.w)); }
    }
}
__device__ __forceinline__ float block_sum(const Ctx& c, float v, float* red) {
    v = wave_sum(v);
    __syncthreads();
    if (c.lane == 0) red[c.wave] = v;
    __syncthreads();
    return ((red[0] + red[1]) + (red[2] + red[3])) + ((red[4] + red[5]) + (red[6] + red[7]));
}
__device__ __forceinline__ void thin_norm(const Ctx& c, const float* O, int nsplit  , int base_kind  , const float* gpost, float scale, float* hout, const float* gpre, bf16_t* aout) {
    const int stride = c.G * NWAVES;
#pragma unroll 1
    for (int r = c.bid * NWAVES + c.wave; r < NPR; r += 2 * stride) {
        const int r2 = r + stride; const bool two = r2 < NPR;
        ThinRow t0, t1;
        thin_load(c, t0, O, nsplit, r);
        if (two) thin_load(c, t1, O, nsplit, r2);
        thin_finish(c, t0, r, base_kind, gpost, scale, hout, gpre, aout);
        if (two) thin_finish(c, t1, r2, base_kind, gpost, scale, hout, gpre, aout);
    }
    if (c.bid < NSM) {
        const int r = NPR + c.bid, col = c.tid * 4;
        float* red = (float*)c.lds;
        const float* os = WSP(const float, WS_OS) + (size_t)c.bid * DM + col;
        float4 a = *(const float4*)os;
        for (int sp = 1; sp < nsplit; ++sp) { const float4 x = *(const float4*)(os + (size_t)sp * 256 * DM); a.x += x.x; a.y += x.y; a.z += x.z; a.w += x.w; }
        const float* bs = base_kind == 0 ? x_row(c, r) : (base_kind == 1 ? WSP(const float, WS_H1) : WSP(const float, WS_H2)) + (size_t)r * DM;
        const float4 b = *(const float4*)(bs + col), gg = *(const float4*)(gpost + col);
        const float ss = block_sum(c, dot4(a, a), red);
        const float sc = rsqrtf(ss * (1.0f / DM) + RMS_EPS) * scale;
        float4 h; h.x = b.x + a.x * sc * gg.x; h.y = b.y + a.y * sc * gg.y; h.z = b.z + a.z * sc * gg.z; h.w = b.w + a.w * sc * gg.w;
        *(float4*)(hout + (size_t)r * DM + col) = h;
        if (aout) {
            const float s2 = block_sum(c, dot4(h, h), red);
            const float q = rsqrtf(s2 * (1.0f / DM) + RMS_EPS);
            const float4 gp = *(const float4*)(gpre + col);
            *(uint2*)(aout + (size_t)r * DM + col) = make_uint2(pack2bf(h.x * q * gp.x, h.y * q * gp.y), pack2bf(h.z * q * gp.z, h.w * q * gp.w));
        }
    }
}

__device__ __forceinline__ int row_pos(int row) { return row < NPR ? (row & (SEQ - 1)) : PAST; }

__device__ __forceinline__ float rope_elem(const float* h16, const float* cs, int d) {
    return d < 8 ? h16[d] * cs[d] - h16[d + 8] * cs[8 + d] : h16[d] * cs[d - 8] + h16[d - 8] * cs[d];
}

constexpr float QSCALE = 0.18033688011112042f;
__device__ __forceinline__ float4 rope4(float4 x, int c16, float4 cs4, float4 sn4) {
    float4 p; p.x = dpp_mov<0x4E>(x.x); p.y = dpp_mov<0x4E>(x.y); p.z = dpp_mov<0x4E>(x.z); p.w = dpp_mov<0x4E>(x.w);
    const float sg = (c16 & 2) ? 1.0f : -1.0f; const bool rot = c16 < 4;
    float4 o;
    o.x = rot ? x.x * cs4.x + sg * p.x * sn4.x : x.x; o.y = rot ? x.y * cs4.y + sg * p.y * sn4.y : x.y;
    o.z = rot ? x.z * cs4.z + sg * p.z * sn4.z : x.z; o.w = rot ? x.w * cs4.w + sg * p.w * sn4.w : x.w;
    return o;
}
__device__ __forceinline__ uint2 bf4(float4 v, float sc) { return make_uint2(pg8::cvt_pk_bf16(v.x * sc, v.y * sc), pg8::cvt_pk_bf16(v.z * sc, v.w * sc)); }
__device__ __forceinline__ void p5a_nsa_prep(const Ctx& c, int grp) {
    const float* COLS = WSP(const float, WS_COLS);
    const float* ROPE = WSP(const float, WS_ROPE);
    const int lane = c.lane, c16 = lane & 15;
#pragma unroll 1
    for (int row = grp * 32 + c.wave * 4; row < grp * 32 + c.wave * 4 + 4; ++row) {
        const float* cr = COLS + (size_t)row * NINP;
        const int pos = row_pos(row);
        const float4 cs4 = *(const float4*)(ROPE + pos * 16 + 4 * (c16 & 1)), sn4 = *(const float4*)(ROPE + pos * 16 + 8 + 4 * (c16 & 1));
        float* kvo = c.out + O_KV + (size_t)row * 1024;
        const bool pr = row < NPR;
        const float4 q0 = *(const float4*)(cr + lane * 4), q1 = *(const float4*)(cr + (lane + 64) * 4), q2 = *(const float4*)(cr + (lane + 128) * 4), q3 = *(const float4*)(cr + (lane + 192) * 4);
        const float4 kc = *(const float4*)(cr + 1024 + lane * 4), vc = *(const float4*)(cr + 1280 + lane * 4), ksv = *(const float4*)(cr + 1536 + lane * 4),
                     vs = *(const float4*)(cr + 1792 + lane * 4), kwv = *(const float4*)(cr + 2048 + lane * 4), vw = *(const float4*)(cr + 2304 + lane * 4);
        const float4 r0 = rope4(q0, c16, cs4, sn4), r1 = rope4(q1, c16, cs4, sn4), r2 = rope4(q2, c16, cs4, sn4), r3 = rope4(q3, c16, cs4, sn4);
        const float4 ksr = rope4(ksv, c16, cs4, sn4), kwr = rope4(kwv, c16, cs4, sn4);
        *(float4*)(kvo + lane * 4) = kc; *(float4*)(kvo + 256 + lane * 4) = vc; *(float4*)(kvo + 512 + lane * 4) = ksr; *(float4*)(kvo + 768 + lane * 4) = vs;
        if (pr) {
            bf16_t* qrb = WSP(bf16_t, WS_QRB) + (size_t)row * 1024 + lane * 4; bf16_t* qsb = WSP(bf16_t, WS_QSB) + (size_t)row * 1024 + lane * 4;
            *(uint2*)(qrb) = bf4(q0, QSCALE); *(uint2*)(qrb + 256) = bf4(q1, QSCALE); *(uint2*)(qrb + 512) = bf4(q2, QSCALE); *(uint2*)(qrb + 768) = bf4(q3, QSCALE);
            *(uint2*)(qsb) = bf4(r0, QSCALE); *(uint2*)(qsb + 256) = bf4(r1, QSCALE); *(uint2*)(qsb + 512) = bf4(r2, QSCALE); *(uint2*)(qsb + 768) = bf4(r3, QSCALE);
            *(uint2*)(WSP(bf16_t, WS_KSB) + (size_t)row * 256 + lane * 4) = bf4(ksr, 1.0f); *(uint2*)(WSP(bf16_t, WS_VSB) + (size_t)row * 256 + lane * 4) = bf4(vs, 1.0f);
            *(uint2*)(WSP(bf16_t, WS_KWB) + (size_t)row * 256 + lane * 4) = bf4(kwr, 1.0f); *(uint2*)(WSP(bf16_t, WS_VWB) + (size_t)row * 256 + lane * 4) = bf4(vw, 1.0f);
            const int t = row & (SEQ - 1), b = row >> 12;
            if (t >= SEQ - 512) { float* wo = c.out + O_WINP + ((size_t)b * 512 + (t - (SEQ - 512))) * 512; *(float4*)(wo + lane * 4) = kwr; *(float4*)(wo + 256 + lane * 4) = vw; }
        } else {
            float* qra = WSP(float, WS_QRAW) + (size_t)row * 1024 + lane * 4; float* qro = WSP(float, WS_QROT) + (size_t)row * 1024 + lane * 4;
            *(float4*)(qra) = q0; *(float4*)(qra + 256) = q1; *(float4*)(qra + 512) = q2; *(float4*)(qra + 768) = q3;
            *(float4*)(qro) = r0; *(float4*)(qro + 256) = r1; *(float4*)(qro + 512) = r2; *(float4*)(qro + 768) = r3;
            float* kw = WSP(float, WS_KW) + (size_t)row * 512; *(float4*)(kw + lane * 4) = kwr; *(float4*)(kw + 256 + lane * 4) = vw;
            float* wo = c.out + O_WINS + ((size_t)(row - NPR) * 512 + 511) * 512; *(float4*)(wo + lane * 4) = kwr; *(float4*)(wo + 256 + lane * 4) = vw;
        }
        if (lane < 12) { const float4 gl = *(const float4*)(cr + 2560 + lane * 4);
            *(float4*)(WSP(float, WS_GATE) + (size_t)row * 48 + lane * 4) = make_float4(sigmoidf_(gl.x), sigmoidf_(gl.y), sigmoidf_(gl.z), sigmoidf_(gl.w)); }
        float* so = nullptr;
        if (!pr) so = c.out + O_SHS + (size_t)(row - NPR) * RWC; else if ((row & (SEQ - 1)) == SEQ - 1) so = c.out + O_SHP + (size_t)(row >> 12) * RWC;
        if (so) {
            const float* sp = cr + NSAC + lane * 4; float* dp = so + lane * 4;
            float4 t0, t1, t2, t3, t4, t5, t6, t7, t8, t9, t10, t11, t12, t13;
            t0 = *(const float4*)(sp); t1 = *(const float4*)(sp + 256); t2 = *(const float4*)(sp + 512); t3 = *(const float4*)(sp + 768); t4 = *(const float4*)(sp + 1024);
            t5 = *(const float4*)(sp + 1280); t6 = *(const float4*)(sp + 1536); t7 = *(const float4*)(sp + 1792); t8 = *(const float4*)(sp + 2048); t9 = *(const float4*)(sp + 2304);
            t10 = *(const float4*)(sp + 2560); t11 = *(const float4*)(sp + 2816); t12 = *(const float4*)(sp + 3072); t13 = *(const float4*)(sp + (lane < 8 ? 3328 : 3072));
            *(float4*)(dp) = t0; *(float4*)(dp + 256) = t1; *(float4*)(dp + 512) = t2; *(float4*)(dp + 768) = t3; *(float4*)(dp + 1024) = t4; *(float4*)(dp + 1280) = t5; *(float4*)(dp + 1536) = t6;
            *(float4*)(dp + 1792) = t7; *(float4*)(dp + 2048) = t8; *(float4*)(dp + 2304) = t9; *(float4*)(dp + 2560) = t10; *(float4*)(dp + 2816) = t11; *(float4*)(dp + 3072) = t12;
            if (lane < 8) *(float4*)(dp + 3328) = t13;
        }
    }
}

__device__ __forceinline__ void p5b_rwkv_prep(const Ctx& c) {
    const float* COLS = WSP(const float, WS_COLS);
    float* RW = WSP(float, WS_RW); float* V = WSP(float, WS_V); float* Gt = WSP(float, WS_G); float* BON = WSP(float, WS_BON);
    const float* mu = c.p->in[19]; const float* w0 = c.p->in[20]; const float* w2 = c.p->in[21]; const float* a0 = c.p->in[22]; const float* a2 = c.p->in[23];
    const float* g2 = c.p->in[24]; const float* kkw = c.p->in[25]; const float* kaw = c.p->in[26]; const float* rk = c.p->in[27];
    float* L = (float*)c.lds;
    constexpr int RG = 8;
#pragma unroll 1
    for (int it = c.bid; it < NR / RG; it += c.G) {
        const int row0 = it * RG;
        __syncthreads();
        for (int e = c.tid; e < RG * 288; e += NTHREADS) {
            const int r = e / 288, k = e % 288, row = row0 + r, col = 3072 + k;
            const float cur = COLS[(size_t)row * NINP + NSAC + col];
            float prev;
            if (row >= NPR) prev = c.p->in[6][(size_t)(row - NPR) * RWC + col];
            else prev = (row & (SEQ - 1)) == 0 ? 0.f : COLS[(size_t)(row - 1) * NINP + NSAC + col];
            const float xs = cur + (prev - cur) * mu[col];
            L[e] = k < 64 ? tanhf(xs) : (k < 128 ? xs : sigmoidf_(xs));
        }
        __syncthreads();
        float aw[RG][2], aa[RG][2], ag[RG][2];
#pragma unroll
        for (int r = 0; r < RG; ++r) { aw[r][0] = aw[r][1] = aa[r][0] = aa[r][1] = ag[r][0] = ag[r][1] = 0.f; }
        const int n0 = c.tid, n1 = c.tid + 512;
#pragma unroll 4
        for (int k = 0; k < 64; ++k) { const float x0 = w2[k * 1024 + n0], x1 = w2[k * 1024 + n1];
#pragma unroll
            for (int r = 0; r < RG; ++r) { const float l = L[r * 288 + k]; aw[r][0] += l * x0; aw[r][1] += l * x1; } }
#pragma unroll 4
        for (int k = 0; k < 64; ++k) { const float x0 = a2[k * 1024 + n0], x1 = a2[k * 1024 + n1];
#pragma unroll
            for (int r = 0; r < RG; ++r) { const float l = L[r * 288 + 64 + k]; aa[r][0] += l * x0; aa[r][1] += l * x1; } }
#pragma unroll 4
        for (int k = 0; k < 160; ++k) { const float x0 = g2[k * 1024 + n0], x1 = g2[k * 1024 + n1];
#pragma unroll
            for (int r = 0; r < RG; ++r) { const float l = L[r * 288 + 128 + k]; ag[r][0] += l * x0; ag[r][1] += l * x1; } }
#pragma unroll
        for (int r = 0; r < RG; ++r) {
            const int row = row0 + r;
            const float* cr = COLS + (size_t)row * NINP + NSAC;
            const bool first = row < NPR && (row & (SEQ - 1)) == 0;
            const float* pr = row >= NPR ? c.p->in[6] + (size_t)(row - NPR) * RWC : (cr - NINP);
#pragma unroll
            for (int j = 0; j < 2; ++j) {
                const int n = j == 0 ? n0 : n1;
                float xr, xk, xv;
                { const float cu = cr[n], p = first ? 0.f : pr[n]; xr = cu + (p - cu) * mu[n]; }
                { const float cu = cr[1024 + n], p = first ? 0.f : pr[1024 + n]; xk = cu + (p - cu) * mu[1024 + n]; }
                { const float cu = cr[2048 + n], p = first ? 0.f : pr[2048 + n]; xv = cu + (p - cu) * mu[2048 + n]; }
                const float wl = w0[n] + aw[r][j];
                const float nx = -wl; const float sp = fmaxf(nx, 0.f) + log1pf(__expf(-fabsf(nx)));
                const float wlog = -sp - 0.5f;
                const float decay = __expf(-__expf(wlog));
                const float a = sigmoidf_(a0[n] + aa[r][j]);
                const float g = ag[r][j];
                const float kkr = xk * kkw[n];
                const float ssq = wave_sum(kkr * kkr);
                const float kkn = kkr / fmaxf(sqrtf(ssq), 1e-12f);
                const float km = xk * (1.0f + (a - 1.0f) * kaw[n]);
                const float bs = wave_sum(xr * km * rk[n]);
                float* rw = RW + (size_t)row * 5 * 1024;
                rw[n] = xr; rw[1024 + n] = decay; rw[2048 + n] = km; rw[3072 + n] = kkn; rw[4096 + n] = kkn * a;
                V[(size_t)row * 1024 + n] = xv; Gt[(size_t)row * 1024 + n] = g;
                if (c.lane == 0) BON[(size_t)row * 16 + (n >> 6)] = bs;
            }
        }
    }
}

__device__ __forceinline__ void p5c_compress(const Ctx& c) {
    float* X = (float*)c.lds;
    float* HID = X + 80 * 256;
    const int tid = c.tid;
    const int n_items_p = 2 * 64, n_items_s = NSM * 32;
#pragma unroll 1
    for (int it = c.bid; it < n_items_p + n_items_s; it += c.G) {
        const bool smp = it >= n_items_p;
        const int b = smp ? (it - n_items_p) >> 5 : it >> 6;
        const int n0 = smp ? ((it - n_items_p) & 31) * 4 : (it & 63) * 4;
        const int nc = smp ? NCS : NCP;
        const int nb = (nc - n0) < 4 ? (nc - n0) : 4;
        const int nrows = 16 * (nb - 1) + 32;
#pragma unroll 1
        for (int kv = 0; kv < 2; ++kv) {
            const float* pe = c.p->in[kv == 0 ? 13 : 16]; const float* w1 = c.p->in[kv == 0 ? 14 : 17]; const float* w2 = c.p->in[kv == 0 ? 15 : 18];
            __syncthreads();
            for (int e = tid; e < nrows * 64; e += NTHREADS) {
                const int r = e >> 6, q4 = (e & 63) * 4; const int tok = 16 * n0 + r;
                const float* src;
                if (smp) { const int page = ((const int*)c.p->in[3])[b * NPAGES + (tok >> 7)]; src = c.p->in[2] + ((size_t)page * PAGE + (tok & 127)) * 1024 + kv * 256 + q4; }
                else src = WSP(const float, WS_COLS) + (size_t)(b * SEQ + tok) * NINP + 1024 + kv * 256 + q4;
                *(float4*)(X + r * 256 + q4) = *(const float4*)src;
            }
            __syncthreads();
            {
                const int kvh = tid >> 7, h = tid & 127;
                float acc[4] = {0.f, 0.f, 0.f, 0.f};
#pragma unroll 1
                for (int l = 0; l < 32; ++l) {
#pragma unroll 8
                    for (int d = 0; d < 64; ++d) {
                        const float w = w1[(l * 64 + d) * 128 + h], pv = pe[l * 64 + d];
#pragma unroll
                        for (int q = 0; q < 4; ++q) acc[q] += (X[(16 * q + l) * 256 + kvh * 64 + d] + pv) * w;
                    }
                }
#pragma unroll
                for (int q = 0; q < 4; ++q) HID[(q * 4 + kvh) * 128 + h] = siluf_(acc[q]);
            }
            __syncthreads();
            {
#pragma unroll
                for (int j = 0; j < 2; ++j) {
                    const int o = tid + j * 512; const int q = o >> 8, kvh = (o >> 6) & 3, dd = o & 63;
                    float s = 0.f;
#pragma unroll 8
                    for (int h = 0; h < 128; ++h) s += HID[(q * 4 + kvh) * 128 + h] * w2[h * 64 + dd];
                    if (q < nb) {
                        if (smp) WSP(float, kv == 0 ? WS_KCS : WS_VCS)[((size_t)b * 128 + n0 + q) * 256 + kvh * 64 + dd] = s;
                        else WSP(bf16_t, kv == 0 ? WS_KCB : WS_VCB)[((size_t)b * 256 + n0 + q) * 256 + kvh * 64 + dd] = f2bf(s);
                    } else if (!smp && n0 + q == 255) WSP(bf16_t, kv == 0 ? WS_KCB : WS_VCB)[((size_t)b * 256 + 255) * 256 + kvh * 64 + dd] = 0;
                }
            }
        }
    }
}

typedef short bf16x8_t __attribute__((ext_vector_type(8)));
typedef float f32x4_t __attribute__((ext_vector_type(4)));
#define MFMA16(a, b, c) __builtin_amdgcn_mfma_f32_16x16x32_bf16((a), (b), (c), 0, 0, 0)
constexpr int AT_LD = 72;
constexpr int AT_TILE = 64 * AT_LD;
constexpr int AT_OFF_K = 0, AT_OFF_V = 2 * AT_TILE * 2, AT_OFF_MSK = 4 * AT_TILE * 2, AT_OFF_SCO = AT_OFF_MSK + 512;

struct AtStage { uint4 k, v; };
__device__ __forceinline__ void at_load(AtStage& s, const bf16_t* kb, const bf16_t* vb, int row0, int tid) {
    const int key = tid >> 3, dc = tid & 7;
    s.k = *(const uint4*)(kb + (size_t)(row0 + key) * 256 + dc * 8);
    s.v = *(const uint4*)(vb + (size_t)(row0 + key) * 256 + dc * 8);
}
constexpr int AT_VDH = 4096 + 64;
typedef short at_v4i16 __attribute__((ext_vector_type(4)));
__device__ __forceinline__ at_v4i16 at_vtr(const unsigned char* p) { return __builtin_amdgcn_ds_read_tr16_b64_v4i16((__attribute__((address_space(3))) at_v4i16*)p); }
__device__ __forceinline__ void at_store(const AtStage& s, bf16_t* KT, bf16_t* VT, int tid) {
    const int key = tid >> 3, dc = tid & 7;
    *(uint4*)(KT + key * AT_LD + dc * 8) = s.k;
    *(uint4*)((unsigned char*)VT + (dc >> 2) * AT_VDH + key * 64 + (((dc & 3) * 16) ^ (((key >> 3) & 1) * 32))) = make_uint4(s.v.x, s.v.y, s.v.z, s.v.w);
}

__device__ __forceinline__ void at_scores(const bf16_t* KT, const bf16x8_t (&qf)[2], f32x4_t (&S)[2][2], const f32x4_t& nref4, int r, int q) {
    bf16x8_t a[2][2][2];
#pragma unroll
    for (int kg = 0; kg < 2; ++kg)
#pragma unroll
        for (int kt = 0; kt < 2; ++kt) {
            const int krow = 32 * kg + 8 * (r >> 2) + 4 * kt + (r & 3);
            a[kg][kt][0] = *(const bf16x8_t*)(KT + krow * AT_LD + q * 8); a[kg][kt][1] = *(const bf16x8_t*)(KT + krow * AT_LD + 32 + q * 8);
        }
    __builtin_amdgcn_sched_barrier(0);
#pragma unroll
    for (int kg = 0; kg < 2; ++kg)
#pragma unroll
        for (int kt = 0; kt < 2; ++kt) S[kg][kt] = MFMA16(a[kg][kt][1], qf[1], MFMA16(a[kg][kt][0], qf[0], nref4));
}
template <int MODE  >
__device__ __forceinline__ void at_update(const bf16_t* VT, f32x4_t (&S)[2][2], f32x4_t (&O)[4], f32x4_t& L, f32x4_t& nref4, bool& seen, int keybase, int lo, int hi, int r, int q) {
    const int vb0 = (8 * q + (r >> 2)) * 64 + ((8 * (r & 3)) ^ ((q & 1) * 32));
    const unsigned char* vp0 = (const unsigned char*)VT + vb0; const int vsw = (vb0 ^ 32) - vb0;
    bf16x8_t va[4][2];
#pragma unroll
    for (int dt = 0; dt < 4; ++dt)
#pragma unroll
        for (int kg = 0; kg < 2; ++kg) { const unsigned char* ap = vp0 + (dt >> 1) * AT_VDH + (dt & 1) * vsw + 32 * kg * 64;
            const at_v4i16 lo = at_vtr(ap), hi = at_vtr(ap + 4 * 64);
            va[dt][kg] = __builtin_shufflevector(lo, hi, 0, 1, 2, 3, 4, 5, 6, 7); }
    __builtin_amdgcn_sched_barrier(0);
    const int rhi = hi - keybase - 8 * q, rlo = lo - keybase - 8 * q;
    const bool on = hi >= 0;
    float mx = -3.0e38f;
#pragma unroll
    for (int kg = 0; kg < 2; ++kg)
#pragma unroll
        for (int kt = 0; kt < 2; ++kt)
#pragma unroll
            for (int i = 0; i < 4; ++i) {
                const int o = 32 * kg + 4 * kt + i;
                if (MODE == 1) S[kg][kt][i] = on ? S[kg][kt][i] : -3.0e38f;
                if (MODE == 2) S[kg][kt][i] = (o <= rhi) ? S[kg][kt][i] : -3.0e38f;
                if (MODE == 3) S[kg][kt][i] = (o <= rhi && o >= rlo) ? S[kg][kt][i] : -3.0e38f;
                mx = fmaxf(mx, S[kg][kt][i]); }
    mx = max_q(mx);
    const bool valid = mx > -1.0e30f;
    const bool need = valid && (!seen || mx > 24.0f);
    if (__any(need)) {
        const float d = need ? mx : 0.0f, sc = __builtin_amdgcn_exp2f(-d);
#pragma unroll
        for (int kg = 0; kg < 2; ++kg)
#pragma unroll
            for (int kt = 0; kt < 2; ++kt)
#pragma unroll
                for (int i = 0; i < 4; ++i) S[kg][kt][i] -= d;
#pragma unroll
        for (int dt = 0; dt < 4; ++dt) O[dt] *= sc;
        L *= sc;
        nref4 -= d;
    }
    seen = seen || valid;
    bf16x8_t pb[2];
#pragma unroll
    for (int kg = 0; kg < 2; ++kg) {
        float p[8];
#pragma unroll
        for (int kt = 0; kt < 2; ++kt)
#pragma unroll
            for (int i = 0; i < 4; ++i) p[kt * 4 + i] = __builtin_amdgcn_exp2f(S[kg][kt][i]);
        uint4 w; w.x = pg8::cvt_pk_bf16(p[0], p[1]); w.y = pg8::cvt_pk_bf16(p[2], p[3]); w.z = pg8::cvt_pk_bf16(p[4], p[5]); w.w = pg8::cvt_pk_bf16(p[6], p[7]);
        pb[kg] = __builtin_bit_cast(bf16x8_t, w);
    }
    const unsigned ow = (r == 0) ? 0x3F803F80u : 0u;
    const bf16x8_t ones = __builtin_bit_cast(bf16x8_t, make_uint4(ow, ow, ow, ow));
    L = MFMA16(ones, pb[1], MFMA16(ones, pb[0], L));
#pragma unroll
    for (int dt = 0; dt < 4; ++dt) {
        f32x4_t o = O[dt];
#pragma unroll
        for (int kg = 0; kg < 2; ++kg) o = MFMA16(va[dt][kg], pb[kg], o);
        O[dt] = o;
    }
}
__device__ __forceinline__ float at_rowsum(const f32x4_t& L, int q) { return sum_q(q == 0 ? L[0] : 0.0f); }
__device__ __forceinline__ void at_finish(f32x4_t (&OUT)[4], f32x4_t (&O)[4], f32x4_t& L, f32x4_t& nref4, bool& seen, float gate, int q) {
    const float l = at_rowsum(L, q);
    const float f = l > 0.f ? gate / l : 0.f;
#pragma unroll
    for (int dt = 0; dt < 4; ++dt) { OUT[dt] += O[dt] * f; O[dt] = (f32x4_t){0.f, 0.f, 0.f, 0.f}; }
    L = (f32x4_t){0.f, 0.f, 0.f, 0.f}; nref4 = (f32x4_t){0.f, 0.f, 0.f, 0.f}; seen = false;
}

#ifndef PROBE_T
#define PROBE_T -1
#endif
#define PSEC(k, x) do { if (PROBE_T == (k) && pacc) { x; } } while (0)
__device__ __forceinline__ void nsa_tile_mfma(const Ctx& c, int item, unsigned long long* pacc = nullptr) {
    const int tile = 127 - (item >> 3), bk = item & 7, b = bk >> 2, kvh = bk & 3;
    const int s0 = tile * 32;
    int tid = c.tid; asm volatile("" : "+v"(tid));
    const int lane = tid & 63, wave = c.wave, r = lane & 15, q = lane >> 4;
    bf16_t* KT = (bf16_t*)(c.lds + AT_OFF_K); bf16_t* VT = (bf16_t*)(c.lds + AT_OFF_V);
    unsigned long long* MSK = (unsigned long long*)(c.lds + AT_OFF_MSK);
    float* SCO = (float*)(c.lds + AT_OFF_SCO) + wave * 256;
    const int tokl = 4 * wave + (r >> 2), g = r & 3;
    const int t = s0 + tokl;
    const size_t trow = (size_t)b * SEQ + t;
    const size_t rb = (size_t)b * SEQ;
    bf16x8_t qr[2], qs[2];
#pragma unroll
    for (int ks = 0; ks < 2; ++ks) { qr[ks] = *(const bf16x8_t*)(WSP(const bf16_t, WS_QRB) + trow * 1024 + (kvh * 4 + g) * 64 + ks * 32 + q * 8);
                                     qs[ks] = *(const bf16x8_t*)(WSP(const bf16_t, WS_QSB) + trow * 1024 + (kvh * 4 + g) * 64 + ks * 32 + q * 8); }
    const float* gate = WSP(const float, WS_GATE) + trow * 48 + (kvh * 4 + g) * 3;
    const float g0 = gate[0], g1 = gate[1], g2 = gate[2];
    f32x4_t OUT[4], O[4];
#pragma unroll
    for (int dt = 0; dt < 4; ++dt) { OUT[dt] = (f32x4_t){0.f, 0.f, 0.f, 0.f}; O[dt] = (f32x4_t){0.f, 0.f, 0.f, 0.f}; }
    f32x4_t L = {0.f, 0.f, 0.f, 0.f}, nref4 = {0.f, 0.f, 0.f, 0.f}; bool seen = false;
    AtStage st;
    __syncthreads();
    unsigned long long pt_ = 0; PSEC(201, pt_ = wall_clock64());

    const int ntc = (s0 / 16 + 1 + 63) >> 6;
    const int ncr = t >= 31 ? (t - 31) / 16 + 1 : 0;
    f32x4_t SC[4][2][2];
#pragma unroll
    for (int ti = 0; ti < 4; ++ti)
#pragma unroll
        for (int kg = 0; kg < 2; ++kg)
#pragma unroll
            for (int kt = 0; kt < 2; ++kt) SC[ti][kg][kt] = (f32x4_t){0.f, 0.f, 0.f, 0.f};
    {
        const bf16_t* kb = WSP(const bf16_t, WS_KCB) + (size_t)b * 256 * 256 + kvh * 64; const bf16_t* vb = WSP(const bf16_t, WS_VCB) + (size_t)b * 256 * 256 + kvh * 64;
        AtStage c1, c2, c3;
        at_load(st, kb, vb, 0, tid);
        at_load(c1, kb, vb, (1 < ntc ? 1 : ntc - 1) * 64, tid); at_load(c2, kb, vb, (2 < ntc ? 2 : ntc - 1) * 64, tid); at_load(c3, kb, vb, (3 < ntc ? 3 : ntc - 1) * 64, tid);
        at_store(st, KT, VT, tid); __syncthreads();
#define AT_CMP_STEP(ti, nslot) \
            if ((ti) < ntc) { \
                f32x4_t S2[2][2]; \
                at_scores(KT + ((ti) & 1) * AT_TILE, qr, S2, nref4, r, q); \
                _Pragma("unroll") for (int kg = 0; kg < 2; ++kg) _Pragma("unroll") for (int kt = 0; kt < 2; ++kt) SC[ti][kg][kt] = S2[kg][kt] - nref4;          \
                at_update<2>(VT + ((ti) & 1) * AT_TILE, S2, O, L, nref4, seen, (ti) * 64, 0, ncr - 1, r, q); \
                if ((ti) + 1 < ntc) at_store(nslot, KT + (((ti) + 1) & 1) * AT_TILE, VT + (((ti) + 1) & 1) * AT_TILE, tid); \
                __syncthreads(); \
            }
        AT_CMP_STEP(0, c1) AT_CMP_STEP(1, c2) AT_CMP_STEP(2, c3) AT_CMP_STEP(3, c3)
#undef AT_CMP_STEP
    }
    {
        const float ltot = at_rowsum(L, q); const float m = -nref4[0];
        const float inv = ltot > 0.f ? 1.0f / ltot : 0.f;
        float A[8][2], Bv[8];
#pragma unroll
        for (int ti = 0; ti < 4; ++ti)
#pragma unroll
            for (int kg = 0; kg < 2; ++kg) {
                float pa[2][4];
#pragma unroll
                for (int kt = 0; kt < 2; ++kt)
#pragma unroll
                    for (int i = 0; i < 4; ++i) { const int n = ti * 64 + 32 * kg + 8 * q + 4 * kt + i; pa[kt][i] = (ti < ntc && n < ncr) ? __builtin_amdgcn_exp2f(SC[ti][kg][kt][i] - m) * inv : 0.f; }
                A[ti * 2 + kg][0] = 2.0f * (pa[0][0] + pa[0][1] + pa[0][2]) + pa[0][3];
                A[ti * 2 + kg][1] = 2.0f * (pa[1][0] + pa[1][1] + pa[1][2]) + pa[1][3] + pa[0][3];
                Bv[ti * 2 + kg] = pa[1][3];
            }
        float prevB[8];
#pragma unroll
        for (int kgg = 0; kgg < 8; ++kgg) prevB[kgg] = __shfl(Bv[kgg], (lane + 48) & 63);
#pragma unroll
        for (int kgg = 0; kgg < 8; ++kgg) { const float pb = q > 0 ? prevB[kgg] : (kgg > 0 ? prevB[kgg - 1] : 0.f); A[kgg][0] += pb; }
        const int cur = t >> 6;
#pragma unroll
        for (int kgg = 0; kgg < 8; ++kgg)
#pragma unroll
            for (int kt = 0; kt < 2; ++kt) { const float v = sum_quad(A[kgg][kt]);
                const int j = 8 * kgg + 2 * q + kt;
                const bool valid = j <= cur, forced = (j == 0) || (cur - j >= 0 && cur - j < 2);
                if (g == 0) SCO[(r >> 2) * 64 + j] = valid ? v + (forced ? 1.0e4f : 0.0f) : NEGV; }
    }
    at_finish(OUT, O, L, nref4, seen, g0, q);
    WAVE_SYNC();
    {
        const int tk = lane >> 4, jj = lane & 15;
        const float* sc = SCO + tk * 64;
        const float s0v = sc[jj], s1v = sc[jj + 16], s2v = sc[jj + 32], s3v = sc[jj + 48];
        int r0 = 0, r1 = 0, r2 = 0, r3 = 0;
#pragma unroll 8
        for (int jp = 0; jp < 64; ++jp) { const float o = sc[jp];
            r0 += (o > s0v || (o == s0v && jp < jj)) ? 1 : 0; r1 += (o > s1v || (o == s1v && jp < jj + 16)) ? 1 : 0;
            r2 += (o > s2v || (o == s2v && jp < jj + 32)) ? 1 : 0; r3 += (o > s3v || (o == s3v && jp < jj + 48)) ? 1 : 0; }
        const unsigned long long b0 = __ballot(r0 < 16 && s0v > -0.5e30f), b1 = __ballot(r1 < 16 && s1v > -0.5e30f), b2 = __ballot(r2 < 16 && s2v > -0.5e30f), b3 = __ballot(r3 < 16 && s3v > -0.5e30f);
        if (lane < 4) { const int sh = 16 * lane;
            MSK[wave * 4 + lane] = ((b0 >> sh) & 0xffffull) | (((b1 >> sh) & 0xffffull) << 16) | (((b2 >> sh) & 0xffffull) << 32) | (((b3 >> sh) & 0xffffull) << 48); }
    }
    __syncthreads();
    PSEC(201, *pacc += wall_clock64() - pt_); PSEC(202, pt_ = wall_clock64());
    {
        unsigned long long un = 0ull;
#pragma unroll 4
        for (int i = 0; i < 32; ++i) un |= MSK[i];
        const unsigned long long mine = MSK[tokl];
        unsigned long long wany, wall;
        { const unsigned long long m0 = MSK[4 * wave], m1 = MSK[4 * wave + 1], m2 = MSK[4 * wave + 2], m3 = MSK[4 * wave + 3]; const unsigned long long o_ = m0 | m1 | m2 | m3, a_ = m0 & m1 & m2 & m3;
          wany = ((unsigned long long)(unsigned)__builtin_amdgcn_readfirstlane((int)(o_ >> 32)) << 32) | (unsigned)__builtin_amdgcn_readfirstlane((int)o_);
          wall = ((unsigned long long)(unsigned)__builtin_amdgcn_readfirstlane((int)(a_ >> 32)) << 32) | (unsigned)__builtin_amdgcn_readfirstlane((int)a_); }
        const bf16_t* kb = WSP(const bf16_t, WS_KSB) + rb * 256 + kvh * 64; const bf16_t* vb = WSP(const bf16_t, WS_VSB) + rb * 256 + kvh * 64;
        int j = __ffsll((long long)un) - 1; un &= un - 1;
#define AT_NEXT(dst) do { dst = un ? (__ffsll((long long)un) - 1) : -1; un &= un - 1; } while (0)
#define AT_SEL_STEP(slot, jslot) { \
            if (j >= 0 && ((wany >> j) & 1ull)) { f32x4_t S[2][2]; const bool on_ = (mine >> j) & 1ull; \
                if (64 * j + 63 <= s0 + 4 * wave) {         \
                    f32x4_t cin_; cin_[0] = on_ ? nref4[0] : -3.0e38f; cin_[1] = on_ ? nref4[1] : -3.0e38f; cin_[2] = on_ ? nref4[2] : -3.0e38f; cin_[3] = on_ ? nref4[3] : -3.0e38f; \
                    at_scores(KT + buf * AT_TILE, qs, S, cin_, r, q); at_update<0>(VT + buf * AT_TILE, S, O, L, nref4, seen, j * 64, 0, 0, r, q); } \
                else { at_scores(KT + buf * AT_TILE, qs, S, nref4, r, q); at_update<2>(VT + buf * AT_TILE, S, O, L, nref4, seen, j * 64, 0, on_ ? t : -1, r, q); } } \
            at_store(slot, KT + (buf ^ 1) * AT_TILE, VT + (buf ^ 1) * AT_TILE, tid); __syncthreads(); \
            j = jslot; buf ^= 1; AT_NEXT(jslot); at_load(slot, kb, vb, (jslot >= 0 ? jslot : 0) * 64, tid); }
        at_load(st, kb, vb, j * 64, tid);
        int j0_, j1_, j2_, j3_; AT_NEXT(j0_); AT_NEXT(j1_); AT_NEXT(j2_); AT_NEXT(j3_);
        AtStage q0, q1, q2, q3;
        at_load(q0, kb, vb, (j0_ >= 0 ? j0_ : 0) * 64, tid);
        at_load(q1, kb, vb, (j1_ >= 0 ? j1_ : 0) * 64, tid);
        at_load(q2, kb, vb, (j2_ >= 0 ? j2_ : 0) * 64, tid);
        at_load(q3, kb, vb, (j3_ >= 0 ? j3_ : 0) * 64, tid);
        at_store(st, KT, VT, tid); __syncthreads();
        int buf = 0;
#pragma unroll 1
        do {
            AT_SEL_STEP(q0, j0_)
            AT_SEL_STEP(q1, j1_)
            AT_SEL_STEP(q2, j2_)
            AT_SEL_STEP(q3, j3_)
        } while (j >= 0);
#undef AT_SEL_STEP
#undef AT_NEXT
    }
    at_finish(OUT, O, L, nref4, seen, g1, q);
    PSEC(202, *pacc += wall_clock64() - pt_); PSEC(203, pt_ = wall_clock64());
    {
        const bf16_t* kb = WSP(const bf16_t, WS_KWB) + rb * 256 + kvh * 64; const bf16_t* vb = WSP(const bf16_t, WS_VWB) + rb * 256 + kvh * 64;
        const int j0 = (s0 > 512 ? s0 - 512 : 0) >> 6, j1 = (s0 + 31) >> 6;
        unsigned long long un = ((2ull << j1) - 1ull) & ~((1ull << j0) - 1ull);
        int j = j0; un &= un - 1;
#define AT_NEXT(dst) do { dst = un ? (__ffsll((long long)un) - 1) : -1; un &= un - 1; } while (0)
#define AT_WIN_STEP(slot, jslot) { \
            if (j >= 0) { f32x4_t S[2][2]; at_scores(KT + buf * AT_TILE, qs, S, nref4, r, q); \
                if (64 * j >= s0 + 4 * wave + 3 - 512 && 64 * j + 63 <= s0 + 4 * wave) at_update<0>(VT + buf * AT_TILE, S, O, L, nref4, seen, j * 64, 0, 0, r, q);     \
                else at_update<3>(VT + buf * AT_TILE, S, O, L, nref4, seen, j * 64, t - 512, t, r, q); } \
            at_store(slot, KT + (buf ^ 1) * AT_TILE, VT + (buf ^ 1) * AT_TILE, tid); __syncthreads(); \
            j = jslot; buf ^= 1; AT_NEXT(jslot); at_load(slot, kb, vb, (jslot >= 0 ? jslot : 0) * 64, tid); }
        at_load(st, kb, vb, j * 64, tid);
        int j0_, j1_, j2_, j3_; AT_NEXT(j0_); AT_NEXT(j1_); AT_NEXT(j2_); AT_NEXT(j3_);
        AtStage q0, q1, q2, q3;
        at_load(q0, kb, vb, (j0_ >= 0 ? j0_ : 0) * 64, tid);
        at_load(q1, kb, vb, (j1_ >= 0 ? j1_ : 0) * 64, tid);
        at_load(q2, kb, vb, (j2_ >= 0 ? j2_ : 0) * 64, tid);
        at_load(q3, kb, vb, (j3_ >= 0 ? j3_ : 0) * 64, tid);
        at_store(st, KT, VT, tid); __syncthreads();
        int buf = 0;
#pragma unroll 1
        do {
            AT_WIN_STEP(q0, j0_)
            AT_WIN_STEP(q1, j1_)
            AT_WIN_STEP(q2, j2_)
            AT_WIN_STEP(q3, j3_)
        } while (j >= 0);
#undef AT_WIN_STEP
#undef AT_NEXT
    }
    at_finish(OUT, O, L, nref4, seen, g2, q);
    PSEC(203, *pacc += wall_clock64() - pt_);
    {
        bf16_t* dst = WSP(bf16_t, WS_AMIX) + trow * DM + (kvh * 4 + g) * 64 + 4 * q;
#pragma unroll
        for (int dt = 0; dt < 4; ++dt) *(uint2*)(dst + 16 * dt) = make_uint2(pg8::cvt_pk_bf16(OUT[dt][0], OUT[dt][1]), pg8::cvt_pk_bf16(OUT[dt][2], OUT[dt][3]));
    }
}

constexpr int CP_LD = 72, CP_ABUF = 144 * CP_LD;
constexpr int CP_X1_OFF = 0, CP_HID_OFF = 73728, CP_HLD = 136;

__device__ __forceinline__ void cp_cvt_store(bf16_t* A, int u, const float4& x, const float4& y) {
    const int s = u >> 5, kvh = (u & 31) >> 3, d8 = (u & 7) * 8;
    *(uint4*)(A + (s * 4 + kvh) * CP_LD + d8) = make_uint4(pg8::cvt_pk_bf16(x.x, x.y), pg8::cvt_pk_bf16(x.z, x.w), pg8::cvt_pk_bf16(y.x, y.y), pg8::cvt_pk_bf16(y.z, y.w));
}

__device__ __forceinline__ void compress_mfma(const Ctx& c, int it) {
    const int tid = c.tid, lane = c.lane, wave = c.wave, r = lane & 15, q = lane >> 4;
    bf16_t* Abuf = (bf16_t*)c.lds;
    float* X1 = (float*)(c.lds + CP_X1_OFF);
    bf16_t* HID = (bf16_t*)(c.lds + CP_HID_OFF);
    const bf16_t* W1T = WSP(const bf16_t, WS_W1T); const bf16_t* W2T = WSP(const bf16_t, WS_W2T); const float* PET = WSP(const float, WS_PET);
    const int n_items_p = 2 * 8 * 2;
    {
        unsigned long long ps_ = 0; if (PROBE_T >= 331 && PROBE_T <= 333) ps_ = wall_clock64();
        const bool smp = it >= n_items_p;
        const int kv = it & 1;
        const int b = smp ? (it - n_items_p) >> 3 : it >> 4;
        const int g = smp ? ((it - n_items_p) >> 1) & 3 : (it >> 1) & 7;
        const int nseg = smp ? 128 : 256;
        const float* src[3]; const size_t tstride = smp ? 1024 : NINP;
#pragma unroll
        for (int k = 0; k < 3; ++k) {
            int u = k < 2 ? tid + k * 512 : (tid < 32 ? 1024 + tid : tid); if (k == 2) asm volatile("" : "+v"(u));
            int seg = 32 * g + (u >> 5); if (seg > nseg - 1) seg = nseg - 1;
            const int kvh = (u & 31) >> 3, d8 = (u & 7) * 8;
            if (smp) { const int page = ((const int*)c.p->in[3])[b * NPAGES + (seg >> 3)]; src[k] = c.p->in[2] + ((size_t)page * PAGE + ((16 * seg) & 127)) * 1024 + kv * 256 + kvh * 64 + d8; }
            else src[k] = WSP(const float, WS_COLS) + ((size_t)b * SEQ + 16 * seg) * NINP + 1024 + kv * 256 + kvh * 64 + d8;
        }
        const bool has3 = tid < 32;
        const bf16_t* wb = W1T + (size_t)kv * 16 * 256 * 64 + (size_t)(32 * wave + r) * 64 + q * 8;
        f32x4_t acc[9][2];
#pragma unroll
        for (int mt = 0; mt < 9; ++mt) { acc[mt][0] = (f32x4_t){0.f, 0.f, 0.f, 0.f}; acc[mt][1] = (f32x4_t){0.f, 0.f, 0.f, 0.f}; }
        float4 pf[2][3][2];
        bf16x8_t bc[2][2], bn[2][2];
        __syncthreads();
#define CP_LOADA(sl, L) do { _Pragma("unroll") for (int k = 0; k < 3; ++k) { pf[sl][k][0] = *(const float4*)(src[k] + (size_t)(L) * tstride); pf[sl][k][1] = *(const float4*)(src[k] + (size_t)(L) * tstride + 4); } } while (0)
#define CP_STOREA(sl, Ap) do { cp_cvt_store(Ap, tid, pf[sl][0][0], pf[sl][0][1]); cp_cvt_store(Ap, tid + 512, pf[sl][1][0], pf[sl][1][1]); cp_cvt_store(Ap, has3 ? 1024 + tid : 1056 + (tid & 31), pf[sl][2][0], pf[sl][2][1]); } while (0)
#define CP_LOADB(bb, L) do { _Pragma("unroll") for (int nt = 0; nt < 2; ++nt) _Pragma("unroll") for (int ks = 0; ks < 2; ++ks) bb[nt][ks] = *(const bf16x8_t*)(wb + (size_t)(L) * 256 * 64 + nt * 16 * 64 + ks * 32); } while (0)
#define CP_MMA(Ap, bb) do { _Pragma("unroll") for (int mg = 0; mg < 3; ++mg) { _Pragma("unroll") for (int ks = 0; ks < 2; ++ks) _Pragma("unroll") for (int mm = 0; mm < 3; ++mm) { const int mt = mg * 3 + mm; \
            const bf16x8_t a = *(const bf16x8_t*)((Ap) + (16 * mt + r) * CP_LD + ks * 32 + q * 8); acc[mt][0] = MFMA16(a, bb[0][ks], acc[mt][0]); acc[mt][1] = MFMA16(a, bb[1][ks], acc[mt][1]); } \
            } } while (0)
        CP_LOADA(0, 0); CP_LOADA(1, 1); CP_LOADB(bc, 0);
        CP_STOREA(0, Abuf); CP_STOREA(1, Abuf + CP_ABUF);
        __syncthreads();
        if (PROBE_T == 331) { if (c.tid == 0) atomicMax((unsigned*)(c.ws + WS_CTL) + 6000, (unsigned)(wall_clock64() - ps_)); }
        if (PROBE_T == 332) ps_ = wall_clock64();
#pragma unroll 1
        for (int lp = 0; lp < 7; ++lp) {
            const bf16_t* A0 = Abuf + ((lp & 1) * 2) * CP_ABUF;
            CP_LOADA(0, 2 * lp + 2); CP_LOADA(1, 2 * lp + 3);
            CP_LOADB(bn, 2 * lp + 1);
            __builtin_amdgcn_sched_barrier(0);
            CP_MMA(A0, bc);
            CP_LOADB(bc, 2 * lp + 2);
            __builtin_amdgcn_sched_barrier(0);
            CP_MMA(A0 + CP_ABUF, bn);
            { bf16_t* An = Abuf + (((lp + 1) & 1) * 2) * CP_ABUF; CP_STOREA(0, An); CP_STOREA(1, An + CP_ABUF); }
            __syncthreads();
        }
        { const bf16_t* A0 = Abuf + 2 * CP_ABUF;
            CP_LOADB(bn, 15);
            CP_MMA(A0, bc);
            CP_MMA(A0 + CP_ABUF, bn);
            __syncthreads(); }
#undef CP_LOADA
#undef CP_STOREA
#undef CP_LOADB
#undef CP_MMA
        if (PROBE_T == 332) { if (c.tid == 0) atomicMax((unsigned*)(c.ws + WS_CTL) + 6000, (unsigned)(wall_clock64() - ps_)); }
        if (PROBE_T == 333) ps_ = wall_clock64();
        if (wave >= 4) {
            int xw = 4 * q * 128 + 32 * (wave - 4) + r; asm volatile("" : "+v"(xw));
            float* xp = X1 + xw; float* xp8 = xp + 128 * 128;
#pragma unroll
            for (int mt = 0; mt < 9; ++mt)
#pragma unroll
                for (int nt = 0; nt < 2; ++nt)
#pragma unroll
                    for (int i = 0; i < 4; ++i) { if (mt < 8) xp[(16 * mt + i) * 128 + 16 * nt] = acc[mt][nt][i]; else xp8[i * 128 + 16 * nt] = acc[mt][nt][i]; }
        }
        __syncthreads();
        if (wave < 4) {
            int xr = (4 * q + 4) * 128 + 32 * wave + r, hw = 4 * q * CP_HLD + 32 * wave + r; asm volatile("" : "+v"(xr), "+v"(hw));
            const float* xp = X1 + xr; bf16_t* hp = HID + hw;
#pragma unroll
            for (int nt = 0; nt < 2; ++nt) {
                const float pt = PET[kv * 128 + 32 * wave + 16 * nt + r];
#pragma unroll
                for (int mt = 0; mt < 8; ++mt)
#pragma unroll
                    for (int i = 0; i < 4; ++i) { const float v = acc[mt][nt][i] + xp[(16 * mt + i) * 128 + 16 * nt] + pt;
                        hp[(16 * mt + i) * CP_HLD + 16 * nt] = f2bf(v * __builtin_amdgcn_rcpf(1.0f + __expf(-v))); }
            }
        }
        __syncthreads();
        {
            f32x4_t o2[4];
#pragma unroll
            for (int nt = 0; nt < 4; ++nt) o2[nt] = (f32x4_t){0.f, 0.f, 0.f, 0.f};
#pragma unroll
            for (int ks = 0; ks < 4; ++ks) { const bf16x8_t a = *(const bf16x8_t*)(HID + (16 * wave + r) * CP_HLD + ks * 32 + q * 8);
#pragma unroll
                for (int nt = 0; nt < 4; ++nt) { const bf16x8_t bb = *(const bf16x8_t*)(W2T + (size_t)kv * 64 * 128 + (16 * nt + r) * 128 + ks * 32 + q * 8); o2[nt] = MFMA16(a, bb, o2[nt]); } }
#pragma unroll
            for (int i = 0; i < 4; ++i) { const int row = 16 * wave + 4 * q + i, sl = row >> 2, kvh = row & 3, n = 32 * g + sl;
#pragma unroll
                for (int nt = 0; nt < 4; ++nt) { const int dd = 16 * nt + r;
                    if (smp) { if (n <= nseg - 2) WSP(float, kv == 0 ? WS_KCS : WS_VCS)[((size_t)b * 128 + n) * 256 + kvh * 64 + dd] = o2[nt][i]; }
                    else WSP(bf16_t, kv == 0 ? WS_KCB : WS_VCB)[((size_t)b * 256 + n) * 256 + kvh * 64 + dd] = n <= nseg - 2 ? f2bf(o2[nt][i]) : (bf16_t)0; } }
        }
        if (PROBE_T == 333) { __syncthreads(); if (c.tid == 0) atomicMax((unsigned*)(c.ws + WS_CTL) + 6000, (unsigned)(wall_clock64() - ps_)); }
    }
}

constexpr int LR_LD = 296;
__device__ __forceinline__ void p5_lora(const Ctx& c, int it) {
    const float* COLS = WSP(const float, WS_COLS);
    const float* mu = c.p->in[19]; const float* w0 = c.p->in[20]; const float* a0 = c.p->in[22];
    bf16_t* LA = (bf16_t*)c.lds;
    const int tid = c.tid, lane = c.lane, wave = c.wave, r = lane & 15, q = lane >> 4;
    {
        const int row0 = it * 32;
        __syncthreads();
        float4 cu_[5], pv_[5], m4_[5];
#pragma unroll
        for (int k = 0; k < 5; ++k) {
            int u = tid + k * NTHREADS; u = u < 32 * 72 ? u : 32 * 72 - 1;
            const int rr = u / 72, c4 = u - rr * 72, row = row0 + rr, col = 3072 + 4 * c4;
            cu_[k] = *(const float4*)(COLS + (size_t)row * NINP + NSAC + col);
            const float* pp = row >= NPR ? c.p->in[6] + (size_t)(row - NPR) * RWC + col : COLS + (size_t)((row & (SEQ - 1)) == 0 ? row : row - 1) * NINP + NSAC + col;
            pv_[k] = *(const float4*)pp;
            m4_[k] = *(const float4*)(mu + col);
        }
#pragma unroll
        for (int k = 0; k < 5; ++k) {
            const int u0 = tid + k * NTHREADS; const int u = u0 < 32 * 72 ? u0 : 32 * 72 - 1;
            const int rr = u / 72, c4 = u - rr * 72, row = row0 + rr;
            const float4 cu = cu_[k], m4 = m4_[k]; float4 pv = pv_[k];
            if (row < NPR && (row & (SEQ - 1)) == 0) pv = make_float4(0.f, 0.f, 0.f, 0.f);
            float x[4] = {cu.x + (pv.x - cu.x) * m4.x, cu.y + (pv.y - cu.y) * m4.y, cu.z + (pv.z - cu.z) * m4.z, cu.w + (pv.w - cu.w) * m4.w};
            if (c4 < 16) { for (int j = 0; j < 4; ++j) x[j] = tanhf(x[j]); }
            else if (c4 >= 32) { for (int j = 0; j < 4; ++j) x[j] = sigmoidf_(x[j]); }
            if (u0 < 32 * 72) *(uint2*)(LA + rr * LR_LD + 4 * c4) = make_uint2(pack2bf(x[0], x[1]), pack2bf(x[2], x[3]));
        }
        __syncthreads();
        int lao = r * LR_LD + 8 * q; asm volatile("" : "+v"(lao));
#pragma unroll
        for (int lo = 0; lo < 3; ++lo) {
            const int Kl = lo == 2 ? 160 : 64, koff = lo == 0 ? 0 : (lo == 1 ? 64 : 128);
            unsigned loff = (unsigned)((128 * wave + r) * Kl + 8 * q); asm volatile("" : "+v"(loff));
            const bf16_t* Wt = WSP(const bf16_t, lo == 0 ? WS_LW2T : (lo == 1 ? WS_LA2T : WS_LG2T)) + loff;
            f32x4_t acc[8][2];
#pragma unroll
            for (int nt = 0; nt < 8; ++nt) { acc[nt][0] = (f32x4_t){0.f, 0.f, 0.f, 0.f}; acc[nt][1] = (f32x4_t){0.f, 0.f, 0.f, 0.f}; }
#pragma unroll
            for (int ks = 0; ks < (lo == 2 ? 5 : 2); ++ks) {
                const bf16x8_t b0 = *(const bf16x8_t*)(LA + lao + koff + 32 * ks), b1 = *(const bf16x8_t*)(LA + lao + 16 * LR_LD + koff + 32 * ks);
#pragma unroll
                for (int nt = 0; nt < 8; ++nt) { const bf16x8_t a = *(const bf16x8_t*)(Wt + (size_t)(16 * nt) * Kl + 32 * ks);
                    acc[nt][0] = MFMA16(a, b0, acc[nt][0]); acc[nt][1] = MFMA16(a, b1, acc[nt][1]); }
            }
            float* dst = WSP(float, lo == 0 ? WS_DEC : (lo == 1 ? WS_AA : WS_G));
#pragma unroll
            for (int nt = 0; nt < 8; ++nt) {
                const int n4 = 128 * wave + 16 * nt + 4 * q;
                float4 bias = make_float4(0.f, 0.f, 0.f, 0.f);
                if (lo == 0) bias = *(const float4*)(w0 + n4); else if (lo == 1) bias = *(const float4*)(a0 + n4);
#pragma unroll
                for (int ct = 0; ct < 2; ++ct) {
                    float v[4] = {acc[nt][ct][0] + bias.x, acc[nt][ct][1] + bias.y, acc[nt][ct][2] + bias.z, acc[nt][ct][3] + bias.w};
                    if (lo == 0) {
#pragma unroll
                        for (int j = 0; j < 4; ++j) { const float nx = -v[j]; const float sp = fmaxf(nx, 0.f) + log1pf(__expf(-fabsf(nx))); v[j] = __expf(-__expf(-sp - 0.5f)); }
                    } else if (lo == 1) {
#pragma unroll
                        for (int j = 0; j < 4; ++j) v[j] = sigmoidf_(v[j]);
                    }
                    *(float4*)(dst + (size_t)(row0 + 16 * ct + r) * 1024 + n4) = make_float4(v[0], v[1], v[2], v[3]);
                }
            }
        }
    }
}

#define P5_QUEUE(word, n_items, BODY, PK) do { unsigned* q_ = (unsigned*)(c.ws + WS_CTL) + (word); unsigned nx_ = 0u; \
    __syncthreads(); if (c.tid == 0) sh[0] = atomicAdd(q_, 1u); __syncthreads(); int pull = (int)sh[0]; \
    _Pragma("unroll 1") while (pull < (n_items)) { if (c.tid == 0) nx_ = atomicAdd(q_, 1u); \
        unsigned long long ti_ = 0; if (PROBE_T == (PK)) ti_ = wall_clock64(); BODY; if (PROBE_T == (PK)) { __syncthreads(); if (c.tid == 0) atomicMax((unsigned*)(c.ws + WS_CTL) + 6000, (unsigned)(wall_clock64() - ti_)); } \
        __syncthreads(); if (c.tid == 0) sh[0] = nx_; __syncthreads(); pull = (int)sh[0]; } } while (0)
__device__ __forceinline__ void p5_queue(const Ctx& c, unsigned long long* pacc = nullptr) {
    volatile unsigned* sh = (volatile unsigned*)(c.lds + LDS_MISC + 64);
    unsigned long long t0_ = 0;
    if (PROBE_T == 301 && pacc) t0_ = wall_clock64();
    if (PROBE_T == 302 && pacc) t0_ = wall_clock64();
    P5_QUEUE(CW_QMISC + 64, NR / 32, p5_lora(c, pull), 322);
    if (PROBE_T == 302 && pacc) *pacc = wall_clock64() - t0_;
    if (PROBE_T == 312 && c.tid == 0) atomicMax((unsigned*)(c.ws + WS_CTL) + 6000, (unsigned)(wall_clock64() - *pacc));
    P5_QUEUE(CW_QMISC, 2 * 8 * 2 + NSM * 4 * 2, compress_mfma(c, pull), 323);
    if (PROBE_T == 301 && pacc) *pacc = wall_clock64() - t0_;
    if (PROBE_T == 311 && c.tid == 0) atomicMax((unsigned*)(c.ws + WS_CTL) + 6000, (unsigned)(wall_clock64() - *pacc));
    if (PROBE_T == 303 && pacc) t0_ = wall_clock64();
    P5_QUEUE(CW_QMISC + 128, NR / 32, p5a_nsa_prep(c, NR / 32 - 1 - pull), 321);
    if (PROBE_T == 303 && pacc) *pacc = wall_clock64() - t0_;
    if (PROBE_T == 313 && c.tid == 0) atomicMax((unsigned*)(c.ws + WS_CTL) + 6000, (unsigned)(wall_clock64() - *pacc));
}


struct RwConst { float mur, muk, muv, kkw, kaw, rkw; };
__device__ __forceinline__ RwConst rw_const(const Ctx& c, int h, int j) {
    const int n = h * 64 + j; RwConst k;
    k.mur = c.p->in[19][n]; k.muk = c.p->in[19][1024 + n]; k.muv = c.p->in[19][2048 + n]; k.kkw = c.p->in[25][n]; k.kaw = c.p->in[26][n]; k.rkw = c.p->in[27][n];
    return k;
}
struct RwStep { float r, d, km, kk, ka, v, bon; };
__device__ __forceinline__ RwStep rw_prep(const RwConst& k, float cr, float ck, float cv, float pr, float pk, float pv, float dec, float a) {
    RwStep o;
    o.r = cr + (pr - cr) * k.mur; const float xk = ck + (pk - ck) * k.muk; o.v = cv + (pv - cv) * k.muv;
    const float kkr = xk * k.kkw;
    const float ssq = wave_sum(kkr * kkr);
    o.kk = kkr * rsqrtf(fmaxf(ssq, 1e-24f));
    o.km = xk * (1.0f + (a - 1.0f) * k.kaw);
    o.ka = o.kk * a; o.d = dec;
    o.bon = wave_sum(o.r * o.km * k.rkw);
    return o;
}


constexpr int CKN = 32 * 256;
__device__ __forceinline__ void sm_mul(const float (&X)[4], const float (&Y)[4], float (&Z)[4], float* SA, float* SB, int q, int r) {
    WAVE_SYNC();
#pragma unroll
    for (int e = 0; e < 4; ++e) { SA[(4 * q + e) * 16 + r] = X[e]; SB[(4 * q + e) * 16 + r] = Y[e]; }
    WAVE_SYNC();
#pragma unroll
    for (int e = 0; e < 4; ++e) Z[e] = 0.f;
#pragma unroll
    for (int u4 = 0; u4 < 4; ++u4) {
        const float y0 = SB[(4 * u4) * 16 + r], y1 = SB[(4 * u4 + 1) * 16 + r], y2 = SB[(4 * u4 + 2) * 16 + r], y3 = SB[(4 * u4 + 3) * 16 + r];
#pragma unroll
        for (int e = 0; e < 4; ++e) { const float4 x = *(const float4*)(SA + (4 * q + e) * 16 + 4 * u4); Z[e] += x.x * y0 + x.y * y1 + x.z * y2 + x.w * y3; }
    }
}

__device__ __forceinline__ void rwc_prep_item(const Ctx& c, int item, float* wl) {
    const int chain = item >> 8, cc = item & 255, b = chain >> 4, h = chain & 15;
    const int lane = c.lane, q = lane >> 4, r = lane & 15;
    constexpr int XP = 68;
    float* XB = wl; float* XX = wl + 16 * XP; float* XA = wl + 32 * XP; float* XR = wl + 48 * XP;
    const float* COLS = WSP(const float, WS_COLS); const float* DEC = WSP(const float, WS_DEC); const float* AA = WSP(const float, WS_AA);
    const RwConst kc = rw_const(c, h, lane);
    const int hcol = h * 64 + lane;
    const size_t r0 = (size_t)b * SEQ + (size_t)cc * 16;
    float al[16], rh[16], vv[16];
    float gam = 1.0f, pr = 0.f, pk = 0.f, pv = 0.f;
    if (cc != 0) { const float* pp = COLS + (r0 - 1) * NINP + NSAC + hcol; pr = pp[0]; pk = pp[1024]; pv = pp[2048]; }
    WAVE_SYNC();
#pragma unroll
    for (int hf = 0; hf < 2; ++hf) {
        float cr[8], ck[8], cv[8], de[8], aa[8];
#pragma unroll
        for (int s_ = 0; s_ < 8; ++s_) { const size_t row = r0 + hf * 8 + s_; const float* cp = COLS + row * NINP + NSAC + hcol; cr[s_] = cp[0]; ck[s_] = cp[1024]; cv[s_] = cp[2048];
            de[s_] = DEC[row * 1024 + hcol]; aa[s_] = AA[row * 1024 + hcol]; }
#pragma unroll
        for (int s_ = 0; s_ < 8; ++s_) { const int t = hf * 8 + s_;
            const RwStep o = rw_prep(kc, cr[s_], ck[s_], cv[s_], pr, pk, pv, de[s_], aa[s_]); pr = cr[s_]; pk = ck[s_]; pv = cv[s_];
            if (lane == 0) WSP(float, WS_BON)[(r0 + t) * 16 + h] = o.bon;
            const float gp = gam; gam *= o.d; const float ig = __builtin_amdgcn_rcpf(gam);
            al[t] = gp * o.kk; rh[t] = gam * o.r; vv[t] = o.v;
            XB[t * XP + lane] = o.ka * ig; XX[t * XP + lane] = o.km * ig; XA[t * XP + lane] = al[t]; XR[t * XP + lane] = rh[t]; }
    }
    WAVE_SYNC();
    float mb[4], mx[4], nb[4], nx[4];
#pragma unroll
    for (int e = 0; e < 4; ++e) { mb[e] = 0.f; mx[e] = 0.f; nb[e] = 0.f; nx[e] = 0.f; }
#pragma unroll 4
    for (int j4 = 0; j4 < 16; ++j4) {
        const float4 a = *(const float4*)(XA + r * XP + 4 * j4), p = *(const float4*)(XR + r * XP + 4 * j4);
#pragma unroll
        for (int e = 0; e < 4; ++e) { const float4 be = *(const float4*)(XB + (4 * q + e) * XP + 4 * j4), xe = *(const float4*)(XX + (4 * q + e) * XP + 4 * j4);
            mb[e] += dot4(be, a); nb[e] += dot4(be, p); mx[e] += dot4(xe, a); nx[e] += dot4(xe, p); }
    }
#pragma unroll
    for (int e = 0; e < 4; ++e) { const int s = 4 * q + e; if (!(s < r)) { mb[e] = 0.f; mx[e] = 0.f; } if (!(s <= r)) { nb[e] = 0.f; nx[e] = 0.f; } }
    float* SA = XA; float* SB = XA + 256; float* TL = XA + 512; float* NL = XA + 768;
    float id[4], m2[4], m4[4], m8[4], t0[4], t1[4], f1[4], T[4], mh[4], nh[4], tmp[4];
#pragma unroll
    for (int e = 0; e < 4; ++e) id[e] = (4 * q + e == r) ? 1.0f : 0.0f;
    sm_mul(mb, mb, m2, SA, SB, q, r); sm_mul(m2, m2, m4, SA, SB, q, r); sm_mul(m4, m4, m8, SA, SB, q, r);
#pragma unroll
    for (int e = 0; e < 4; ++e) { t0[e] = id[e] - mb[e]; f1[e] = id[e] + m2[e]; }
    sm_mul(t0, f1, t1, SA, SB, q, r);
#pragma unroll
    for (int e = 0; e < 4; ++e) f1[e] = id[e] + m4[e];
    sm_mul(t1, f1, t0, SA, SB, q, r);
#pragma unroll
    for (int e = 0; e < 4; ++e) f1[e] = id[e] + m8[e];
    sm_mul(t0, f1, T, SA, SB, q, r);
    sm_mul(mx, T, mh, SA, SB, q, r);
    sm_mul(mh, nb, tmp, SA, SB, q, r);
#pragma unroll
    for (int e = 0; e < 4; ++e) nh[e] = nx[e] - tmp[e];
    WAVE_SYNC();
#pragma unroll
    for (int e = 0; e < 4; ++e) { TL[(4 * q + e) * 16 + r] = T[e]; NL[(4 * q + e) * 16 + r] = nb[e]; }
    WAVE_SYNC();
    float ah[16], ph[16];
#pragma unroll
    for (int t = 0; t < 16; ++t) { float a = 0.f;
#pragma unroll
        for (int s = 0; s <= t; ++s) a += al[s] * TL[s * 16 + t];
        ah[t] = a; }
#pragma unroll
    for (int t = 0; t < 16; ++t) { float p = rh[t];
#pragma unroll
        for (int s = 0; s <= t; ++s) p -= ah[s] * NL[s * 16 + t];
        ph[t] = p; }
    constexpr int AP = 72;
    bf16_t* ALa = (bf16_t*)XA; bf16_t* ALp = ALa + 16 * AP;
    WAVE_SYNC();
#pragma unroll
    for (int t = 0; t < 16; ++t) { ALa[t * AP + lane] = f2bf(ah[t]); ALp[t * AP + lane] = f2bf(ph[t]); }
    WAVE_SYNC();
    unsigned char* rec = c.ws + WS_CK + (size_t)item * CK_REC;
#pragma unroll
    for (int ks = 0; ks < 2; ++ks) {
        const uint2 alo = *(const uint2*)(ALa + r * AP + 32 * ks + 4 * q), ahi = *(const uint2*)(ALa + r * AP + 32 * ks + 16 + 4 * q);
        const uint2 plo = *(const uint2*)(ALp + r * AP + 32 * ks + 4 * q), phi = *(const uint2*)(ALp + r * AP + 32 * ks + 16 + 4 * q);
        ((uint4*)rec)[ks * 64 + lane] = make_uint4(alo.x, alo.y, ahi.x, ahi.y);
        ((uint4*)(rec + 2048))[ks * 64 + lane] = make_uint4(plo.x, plo.y, phi.x, phi.y);
    }
    ((uint2*)(rec + 4096))[lane] = make_uint2(pack2bf(mh[0], mh[1]), pack2bf(mh[2], mh[3]));
    ((uint2*)(rec + 4608))[lane] = make_uint2(pack2bf(nh[0], nh[1]), pack2bf(nh[2], nh[3]));
#pragma unroll
    for (int mt = 0; mt < 4; ++mt) { const float g16 = __shfl(gam, 16 * mt + r);
        const float b0 = XB[(4 * q) * XP + 16 * mt + r], b1 = XB[(4 * q + 1) * XP + 16 * mt + r], b2 = XB[(4 * q + 2) * XP + 16 * mt + r], b3 = XB[(4 * q + 3) * XP + 16 * mt + r];
        const float x0 = XX[(4 * q) * XP + 16 * mt + r], x1 = XX[(4 * q + 1) * XP + 16 * mt + r], x2 = XX[(4 * q + 2) * XP + 16 * mt + r], x3 = XX[(4 * q + 3) * XP + 16 * mt + r];
        ((uint2*)(rec + 5120))[mt * 64 + lane] = make_uint2(pack2bf(-b0 * g16, -b1 * g16), pack2bf(-b2 * g16, -b3 * g16));
        ((uint2*)(rec + 7168))[mt * 64 + lane] = make_uint2(pack2bf(x0 * g16, x1 * g16), pack2bf(x2 * g16, x3 * g16)); }
    ((float*)(rec + 9216))[lane] = gam;
    { uint4 v0, v1; v0.x = pack2bf(vv[0], vv[1]); v0.y = pack2bf(vv[2], vv[3]); v0.z = pack2bf(vv[4], vv[5]); v0.w = pack2bf(vv[6], vv[7]);
      v1.x = pack2bf(vv[8], vv[9]); v1.y = pack2bf(vv[10], vv[11]); v1.z = pack2bf(vv[12], vv[13]); v1.w = pack2bf(vv[14], vv[15]);
      uint4* vp = (uint4*)(rec + 9472) + lane * 2; vp[0] = v0; vp[1] = v1; }
    WAVE_SYNC();
}

__device__ __forceinline__ bf16x8_t half_frag(const uint2& v) { return __builtin_bit_cast(bf16x8_t, make_uint4(v.x, v.y, 0u, 0u)); }

__device__ __forceinline__ void rwc_fill(const unsigned char* src, unsigned char* dst, int lt) {
    constexpr int NU = 4 * (int)CK_REC / 16;
    const uint4* s4 = (const uint4*)src; uint4* d4 = (uint4*)dst;
    uint4 t0, t1, t2, t3, t4, t5, t6, t7, t8, t9, t10, t11;
    { const int u11 = lt + 2816 < NU ? lt + 2816 : NU - 1;
      t0 = s4[lt]; t1 = s4[lt + 256]; t2 = s4[lt + 512]; t3 = s4[lt + 768]; t4 = s4[lt + 1024]; t5 = s4[lt + 1280]; t6 = s4[lt + 1536]; t7 = s4[lt + 1792];
      t8 = s4[lt + 2048]; t9 = s4[lt + 2304]; t10 = s4[lt + 2560]; t11 = s4[u11]; }
    d4[lt] = t0; d4[lt + 256] = t1; d4[lt + 512] = t2; d4[lt + 768] = t3; d4[lt + 1024] = t4; d4[lt + 1280] = t5; d4[lt + 1536] = t6; d4[lt + 1792] = t7;
    d4[lt + 2048] = t8; d4[lt + 2304] = t9; d4[lt + 2560] = t10; if (lt + 2816 < NU) d4[lt + 2816] = t11;
}

__device__ __forceinline__ void rwc_wincopy(const Ctx& c, int slot, int lt) {
    const size_t per_b = (size_t)511 * 128, total = per_b * NSM; const float* sw = c.p->in[4]; float* wo = c.out + O_WINS;
#pragma unroll
    for (int hb = 0; hb < 2; ++hb) {
        float4 t0, t1, t2, t3, t4, t5, t6, t7;
        const size_t e0 = (size_t)slot * 4096 + lt + 2048 * hb;
#define WC_LD(tk, k) { const size_t e_ = e0 + 256 * (k); const size_t ec = e_ < total ? e_ : total - 1; tk = *(const float4*)(sw + (ec / per_b) * 512 * 512 + 512 + (ec % per_b) * 4); }
#define WC_ST(tk, k) { const size_t e_ = e0 + 256 * (k); if (e_ < total) *(float4*)(wo + (e_ / per_b) * 512 * 512 + (e_ % per_b) * 4) = tk; }
        WC_LD(t0, 0) WC_LD(t1, 1) WC_LD(t2, 2) WC_LD(t3, 3) WC_LD(t4, 4) WC_LD(t5, 5) WC_LD(t6, 6) WC_LD(t7, 7)
        WC_ST(t0, 0) WC_ST(t1, 1) WC_ST(t2, 2) WC_ST(t3, 3) WC_ST(t4, 4) WC_ST(t5, 5) WC_ST(t6, 6) WC_ST(t7, 7)
#undef WC_LD
#undef WC_ST
    }
}
__device__ __forceinline__ void rwc_gn(const Ctx& c, int chain, int g, const float* yb, int lw, int lane) {
    const int b = chain >> 4, h = chain & 15, hcol = h * 64 + lane;
    const float* COLS = WSP(const float, WS_COLS); const float* Gt = WSP(const float, WS_G); const float* BON = WSP(const float, WS_BON);
    const float gw = c.p->in[28][hcol], gb = c.p->in[29][hcol], muv = c.p->in[19][2048 + hcol];
    bf16_t* AM = WSP(bf16_t, WS_AMIX);
#pragma unroll
    for (int hb = 0; hb < 2; ++hb) {
        float cu[9], gg[8], bo[8];
        const size_t r0 = (size_t)b * SEQ + (size_t)g * 64 + lw * 16 + hb * 8;
        cu[0] = ((r0 & (SEQ - 1)) == 0) ? 0.f : COLS[(r0 - 1) * NINP + NSAC + 2048 + hcol];
#pragma unroll
        for (int k = 0; k < 8; ++k) { cu[k + 1] = COLS[(r0 + k) * NINP + NSAC + 2048 + hcol]; gg[k] = Gt[(r0 + k) * 1024 + hcol]; bo[k] = BON[(r0 + k) * 16 + h]; }
#pragma unroll
        for (int k = 0; k < 8; ++k) {
            const float y = yb[(lw * 16 + hb * 8 + k) * 64 + lane];
            const float mean = wave_sum(y) * (1.0f / 64.0f); const float d = y - mean; const float var = wave_sum(d * d) * (1.0f / 64.0f);
            const float yn = d * rsqrtf(var + GN_EPS) * gw + gb;
            const float xv = cu[k + 1] + (cu[k] - cu[k + 1]) * muv;
            AM[(r0 + k) * DM + 1024 + hcol] = f2bf((yn + bo[k] * xv) * gg[k]);
        }
    }
}

__device__ __forceinline__ void rwc_scan_wg(const Ctx& c, int chain) {
    constexpr int NB = 4, BUFB = NB * (int)CK_REC, NU = BUFB / 16;
    const int tid = c.tid, wave = c.wave, lane = c.lane, q = lane >> 4, r = lane & 15;
    unsigned char* buf0 = c.lds;
    const unsigned char* recs = c.ws + WS_CK + (size_t)chain * 256 * CK_REC;
    f32x4_t ST[4];
#pragma unroll
    for (int mt = 0; mt < 4; ++mt) ST[mt] = (f32x4_t){0.f, 0.f, 0.f, 0.f};
    float* YB = (float*)(c.lds + 2 * BUFB);
    const int lt = tid - 256;
    __syncthreads();
    if (wave >= 4) rwc_fill(recs, buf0, lt);
    __syncthreads();
#pragma unroll 1
    for (int g = 0; g < 256 / NB; ++g) {
        if (wave < 4) {
            const unsigned char* bb = buf0 + (g & 1) * BUFB;
            float* yb = YB + (g & 1) * 4096;
#pragma unroll
            for (int u4 = 0; u4 < NB; ++u4) {
                const int cc = g * NB + u4;
                const unsigned char* sl = bb + u4 * CK_REC;
                const uint4 at0 = ((const uint4*)sl)[lane], at1 = ((const uint4*)sl)[64 + lane], pt0 = ((const uint4*)(sl + 2048))[lane], pt1 = ((const uint4*)(sl + 2048))[64 + lane];
                const uint2 mhf = ((const uint2*)(sl + 4096))[lane], nhf = ((const uint2*)(sl + 4608))[lane];
                const uint2 vtf = *(const uint2*)(sl + 9472 + ((16 * wave + r) * 16 + 4 * q) * 2);
                bf16x8_t sb[2];
#pragma unroll
                for (int ks = 0; ks < 2; ++ks) { uint4 u; u.x = pg8::cvt_pk_bf16(ST[2 * ks][0], ST[2 * ks][1]); u.y = pg8::cvt_pk_bf16(ST[2 * ks][2], ST[2 * ks][3]);
                    u.z = pg8::cvt_pk_bf16(ST[2 * ks + 1][0], ST[2 * ks + 1][1]); u.w = pg8::cvt_pk_bf16(ST[2 * ks + 1][2], ST[2 * ks + 1][3]); sb[ks] = __builtin_bit_cast(bf16x8_t, u); }
                const bf16x8_t vb = half_frag(vtf);
                f32x4_t UT = {0.f, 0.f, 0.f, 0.f}, YT = {0.f, 0.f, 0.f, 0.f};
                UT = MFMA16(__builtin_bit_cast(bf16x8_t, at0), sb[0], UT); UT = MFMA16(__builtin_bit_cast(bf16x8_t, at1), sb[1], UT); UT = MFMA16(half_frag(mhf), vb, UT);
                YT = MFMA16(__builtin_bit_cast(bf16x8_t, pt0), sb[0], YT); YT = MFMA16(__builtin_bit_cast(bf16x8_t, pt1), sb[1], YT); YT = MFMA16(half_frag(nhf), vb, YT);
#pragma unroll
                for (int e = 0; e < 4; ++e) yb[(u4 * 16 + 4 * q + e) * 64 + 16 * wave + r] = YT[e];
                const bf16x8_t ub = __builtin_bit_cast(bf16x8_t, make_uint4(pg8::cvt_pk_bf16(UT[0], UT[1]), pg8::cvt_pk_bf16(UT[2], UT[3]), 0u, 0u));
#pragma unroll
                for (int mt = 0; mt < 4; ++mt) { const uint2 bgf = ((const uint2*)(sl + 5120))[mt * 64 + lane], xgf = ((const uint2*)(sl + 7168))[mt * 64 + lane];
                    const float4 gm = *(const float4*)(sl + 9216 + (16 * mt + 4 * q) * 4);
                    f32x4_t s = ST[mt]; s[0] *= gm.x; s[1] *= gm.y; s[2] *= gm.z; s[3] *= gm.w;
                    s = MFMA16(half_frag(bgf), ub, s); s = MFMA16(half_frag(xgf), vb, s); ST[mt] = s; }
            }
        } else {
            if (g + 1 < 256 / NB) rwc_fill(recs + (size_t)(g + 1) * BUFB, buf0 + ((g + 1) & 1) * BUFB, lt);
            if (g > 0) rwc_gn(c, chain, g - 1, YB + ((g - 1) & 1) * 4096, wave - 4, lane);
        }
        __syncthreads();
    }
    if (wave >= 4) rwc_gn(c, chain, 256 / NB - 1, YB + ((256 / NB - 1) & 1) * 4096, wave - 4, lane);
    if (wave < 4) {
        float* so = c.out + O_WKVP + ((size_t)chain * 64 + 16 * wave + r) * 64 + 4 * q;
#pragma unroll
        for (int mt = 0; mt < 4; ++mt) *(float4*)(so + 16 * mt) = make_float4(ST[mt][0], ST[mt][1], ST[mt][2], ST[mt][3]);
    }
}

__device__ __forceinline__ void scan_sample_item(const Ctx& c, int item, float* wl) {
    const int b = item >> 4, h = item & 15, lane = c.lane, lq = lane >> 4, c4 = lane & 15;
    const size_t row = (size_t)NPR + b; const int hcol = h * 64 + lane;
    float bon_s;
    {
        const RwConst kc = rw_const(c, h, lane);
        const float* cp = WSP(const float, WS_COLS) + row * NINP + NSAC + hcol; const float* pp = c.p->in[6] + (size_t)b * RWC + hcol;
        const RwStep o = rw_prep(kc, cp[0], cp[1024], cp[2048], pp[0], pp[1024], pp[2048], WSP(const float, WS_DEC)[row * 1024 + hcol], WSP(const float, WS_AA)[row * 1024 + hcol]);
        WAVE_SYNC();
        wl[lane] = o.r; wl[64 + lane] = o.d; wl[128 + lane] = o.km; wl[192 + lane] = o.kk; wl[256 + lane] = o.ka; wl[320 + lane] = o.v;
        bon_s = o.bon;
        WAVE_SYNC();
    }
    const float4 r4 = *(const float4*)(wl + c4 * 4), d4 = *(const float4*)(wl + 64 + c4 * 4), km4 = *(const float4*)(wl + 128 + c4 * 4), kk4 = *(const float4*)(wl + 192 + c4 * 4), ka4 = *(const float4*)(wl + 256 + c4 * 4);
    const float* S0 = c.p->in[5] + (size_t)item * 4096; float* S1 = c.out + O_WKVS + (size_t)item * 4096;
    float4 Sv[16];
#pragma unroll
    for (int itr = 0; itr < 16; ++itr) Sv[itr] = *(const float4*)(S0 + (itr * 4 + lq) * 64 + c4 * 4);
#pragma unroll
    for (int itr = 0; itr < 16; ++itr) {
        const int i = itr * 4 + lq;
        float4 S = Sv[itr];
        const float v = wl[320 + i];
        const float sa = -red16(dot4(S, kk4));
        S.x = S.x * d4.x + sa * ka4.x + v * km4.x; S.y = S.y * d4.y + sa * ka4.y + v * km4.y;
        S.z = S.z * d4.z + sa * ka4.z + v * km4.z; S.w = S.w * d4.w + sa * ka4.w + v * km4.w;
        *(float4*)(S1 + i * 64 + c4 * 4) = S;
        const float y = red16(dot4(S, r4));
        if (c4 == 0) wl[384 + i] = y;
    }
    WAVE_SYNC();
    {
        const float y = wl[384 + lane];
        const float mean = wave_sum(y) * (1.0f / 64.0f); const float d = y - mean; const float var = wave_sum(d * d) * (1.0f / 64.0f);
        const float yn = d * rsqrtf(var + GN_EPS) * c.p->in[28][hcol] + c.p->in[29][hcol];
        WSP(bf16_t, WS_AMIX)[row * DM + 1024 + hcol] = f2bf((yn + bon_s * wl[320 + lane]) * WSP(const float, WS_G)[row * 1024 + hcol]);
    }
    WAVE_SYNC();
}

__device__ __forceinline__ void seg_scores(const float4 (&q)[4], const float* kb, int stride, int count, float* sc, int off, int lane) {
    const int l15 = lane & 15, lq = lane >> 4;
#pragma unroll 1
    for (int k0 = 0; k0 < count; k0 += 4) {
        const int key = k0 + lq;
        float4 kv = make_float4(0.f, 0.f, 0.f, 0.f);
        if (key < count) kv = *(const float4*)(kb + (size_t)key * stride + 4 * l15);
        float s0 = red16(dot4(q[0], kv)), s1 = red16(dot4(q[1], kv)), s2 = red16(dot4(q[2], kv)), s3 = red16(dot4(q[3], kv));
        if (l15 == 0 && key < count) { sc[off + key] = s0 * 0.125f; sc[1024 + off + key] = s1 * 0.125f; sc[2048 + off + key] = s2 * 0.125f; sc[3072 + off + key] = s3 * 0.125f; }
    }
}
__device__ __forceinline__ void seg_pv(float4 (&acc)[4], const float* vb, int stride, int count, const float* sc, int off, int lane) {
    const int l15 = lane & 15, lq = lane >> 4;
#pragma unroll 1
    for (int k0 = 0; k0 < count; k0 += 4) {
        const int key = k0 + lq;
        if (key < count) {
            const float4 vv = *(const float4*)(vb + (size_t)key * stride + 4 * l15);
#pragma unroll
            for (int g = 0; g < 4; ++g) { const float pp = sc[g * 1024 + off + key]; acc[g].x += pp * vv.x; acc[g].y += pp * vv.y; acc[g].z += pp * vv.z; acc[g].w += pp * vv.w; }
        }
    }
}
__device__ __forceinline__ void softmax_rows(float* sc, int total, int lane) {
#pragma unroll 1
    for (int g = 0; g < 4; ++g) {
        float* r = sc + g * 1024;
        float m = -3.0e38f;
        for (int i = lane; i < total; i += 64) m = fmaxf(m, r[i]);
        m = wave_max(m);
        float s = 0.f;
        for (int i = lane; i < total; i += 64) { const float e = __expf(r[i] - m); r[i] = e; s += e; }
        s = wave_sum(s);
        const float inv = 1.0f / s;
        for (int i = lane; i < total; i += 64) r[i] *= inv;
    }
}
__device__ __forceinline__ void acc_finish(float4 (&o)[4], float4 (&acc)[4], const float* gate, int gi) {
#pragma unroll
    for (int g = 0; g < 4; ++g) {
        float4 a = acc[g];
        a.x = sum_q(a.x); a.y = sum_q(a.y); a.z = sum_q(a.z); a.w = sum_q(a.w);
        const float gt = gate[g * 3 + gi];
        o[g].x += gt * a.x; o[g].y += gt * a.y; o[g].z += gt * a.z; o[g].w += gt * a.w;
        acc[g] = make_float4(0.f, 0.f, 0.f, 0.f);
    }
}

__device__ __forceinline__ void nsa_item_naive(const Ctx& c, int row, int kvh, float* sc) {
    const int lane = c.lane, l15 = lane & 15;
    const bool smp = row >= NPR;
    const int b = smp ? row - NPR : row >> 12;
    const int t = smp ? PAST : (row & (SEQ - 1));
    const float* KVO = c.out + O_KV;
    const float* KWp = WSP(const float, WS_KW);
    float4 qr[4], qs[4];
#pragma unroll
    for (int g = 0; g < 4; ++g) { qr[g] = *(const float4*)(WSP(const float, WS_QRAW) + (size_t)row * 1024 + (kvh * 4 + g) * 64 + 4 * l15);
                                  qs[g] = *(const float4*)(WSP(const float, WS_QROT) + (size_t)row * 1024 + (kvh * 4 + g) * 64 + 4 * l15); }
    const float* gate = WSP(const float, WS_GATE) + (size_t)row * 48 + kvh * 12;
    float4 o[4], acc[4];
#pragma unroll
    for (int g = 0; g < 4; ++g) { o[g] = make_float4(0.f, 0.f, 0.f, 0.f); acc[g] = make_float4(0.f, 0.f, 0.f, 0.f); }
    WAVE_SYNC();
    int ncmp = smp ? NCS : (t >= 31 ? (t - 31) / 16 + 1 : 0); if (ncmp > NCP) ncmp = NCP;
    const float* kc = (smp ? WSP(const float, WS_KCS) + (size_t)b * 128 * 256 : WSP(const float, WS_KCP) + (size_t)b * 256 * 256) + kvh * 64;
    const float* vc = (smp ? WSP(const float, WS_VCS) + (size_t)b * 128 * 256 : WSP(const float, WS_VCP) + (size_t)b * 256 * 256) + kvh * 64;
    if (ncmp > 0) {
        seg_scores(qr, kc, 256, ncmp, sc, 0, lane); WAVE_SYNC();
        softmax_rows(sc, ncmp, lane); WAVE_SYNC();
        seg_pv(acc, vc, 256, ncmp, sc, 0, lane);
        acc_finish(o, acc, gate, 0);
    }
    unsigned long long mask;
    {
        const int j = lane;
        float imp = 0.f;
#pragma unroll
        for (int r = -1; r <= 3; ++r) { const int n = 4 * j + r; if (n >= 0 && n < ncmp) { const float P = sc[n] + sc[1024 + n] + sc[2048 + n] + sc[3072 + n]; imp += (r == -1 || r == 3) ? P : 2.0f * P; } }
        const int cur = t >> 6;
        const bool valid = j <= cur;
        const bool forced = (j == 0) || (cur - j >= 0 && cur - j < 2);
        const float score = valid ? imp + (forced ? 1.0e4f : 0.0f) : NEGV;
        int rank = 0;
#pragma unroll 1
        for (int jp = 0; jp < 64; ++jp) { const float o2 = __shfl(score, jp); rank += (o2 > score || (o2 == score && jp < j)) ? 1 : 0; }
        mask = __ballot(valid && rank < 16);
    }
    WAVE_SYNC();
    {
        int off = 0;
        unsigned long long m = mask;
#pragma unroll 1
        while (m) { const int j = __ffsll((long long)m) - 1; m &= m - 1;
            const float* kp; int cnt;
            if (!smp) { kp = KVO + ((size_t)(b * SEQ + 64 * j)) * 1024 + 512 + kvh * 64; cnt = t - 64 * j + 1; cnt = cnt > 64 ? 64 : cnt; }
            else if (j < 32) { const int page = ((const int*)c.p->in[3])[b * NPAGES + (j >> 1)]; kp = c.p->in[2] + ((size_t)page * PAGE + (j & 1) * 64) * 1024 + 512 + kvh * 64; cnt = 64; }
            else { kp = KVO + (size_t)row * 1024 + 512 + kvh * 64; cnt = 1; }
            seg_scores(qs, kp, 1024, cnt, sc, off, lane); off += cnt; }
        WAVE_SYNC();
        softmax_rows(sc, off, lane); WAVE_SYNC();
        off = 0; m = mask;
#pragma unroll 1
        while (m) { const int j = __ffsll((long long)m) - 1; m &= m - 1;
            const float* kp; int cnt;
            if (!smp) { kp = KVO + ((size_t)(b * SEQ + 64 * j)) * 1024 + 512 + kvh * 64; cnt = t - 64 * j + 1; cnt = cnt > 64 ? 64 : cnt; }
            else if (j < 32) { const int page = ((const int*)c.p->in[3])[b * NPAGES + (j >> 1)]; kp = c.p->in[2] + ((size_t)page * PAGE + (j & 1) * 64) * 1024 + 512 + kvh * 64; cnt = 64; }
            else { kp = KVO + (size_t)row * 1024 + 512 + kvh * 64; cnt = 1; }
            seg_pv(acc, kp + 256, 1024, cnt, sc, off, lane); off += cnt; }
        acc_finish(o, acc, gate, 1);
    }
    WAVE_SYNC();
    {
        int total;
        if (!smp) { const int start = t > 512 ? t - 512 : 0; const float* kp = KWp + ((size_t)(b * SEQ + start)) * 512 + kvh * 64; total = t - start + 1;
            seg_scores(qs, kp, 512, total, sc, 0, lane); WAVE_SYNC(); softmax_rows(sc, total, lane); WAVE_SYNC(); seg_pv(acc, kp + 256, 512, total, sc, 0, lane); }
        else { const float* k1 = c.p->in[4] + (size_t)b * 512 * 512 + kvh * 64; const float* k2 = KWp + (size_t)row * 512 + kvh * 64; total = 513;
            seg_scores(qs, k1, 512, 512, sc, 0, lane); seg_scores(qs, k2, 512, 1, sc, 512, lane); WAVE_SYNC(); softmax_rows(sc, total, lane); WAVE_SYNC();
            seg_pv(acc, k1 + 256, 512, 512, sc, 0, lane); seg_pv(acc, k2 + 256, 512, 1, sc, 512, lane); }
        acc_finish(o, acc, gate, 2);
    }
    WAVE_SYNC();
    if (lane < 16) {
        bf16_t* dst = WSP(bf16_t, WS_AMIX) + (size_t)row * DM + kvh * 256 + 4 * l15;
#pragma unroll
        for (int g = 0; g < 4; ++g) *(uint2*)(dst + g * 64) = make_uint2(pack2bf(o[g].x, o[g].y), pack2bf(o[g].z, o[g].w));
    }
}

#define SW_LOAD(dst, base, kb_) _Pragma("unroll") for (int u = 0; u < 8; ++u) { int key = (kb_) + 4 * u + lq; key = key < k1 ? key : k1 - 1; dst[u] = *(const float4*)((base) + (size_t)key * stride + 4 * l15); }
__device__ __forceinline__ void sw_scores(const float4 (&q)[4], const float* kb, int stride, int k0, int k1, float* sc, int ld, int off, int lane) {
    const int l15 = lane & 15, lq = lane >> 4;
#define SW_SCORE(kv, kb_) _Pragma("unroll") for (int u = 0; u < 8; ++u) { const int key = (kb_) + 4 * u + lq; \
            const float s0 = red16(dot4(q[0], kv[u])), s1 = red16(dot4(q[1], kv[u])), s2 = red16(dot4(q[2], kv[u])), s3 = red16(dot4(q[3], kv[u])); \
            if (l15 == 0 && key < k1) { sc[off + key] = s0 * 0.125f; sc[ld + off + key] = s1 * 0.125f; sc[2 * ld + off + key] = s2 * 0.125f; sc[3 * ld + off + key] = s3 * 0.125f; } }
    float4 ka[8], kc_[8];
    SW_LOAD(ka, kb, k0)
#pragma unroll 1
    for (int kb0 = k0; kb0 < k1; kb0 += 64) {
        SW_LOAD(kc_, kb, kb0 + 32)
        SW_SCORE(ka, kb0)
        SW_LOAD(ka, kb, kb0 + 64)
        if (kb0 + 32 < k1) { SW_SCORE(kc_, kb0 + 32) }
    }
#undef SW_SCORE
}
__device__ __forceinline__ void sw_pv(float4 (&acc)[4], const float* vb, int stride, int k0, int k1, const float* sc, int ld, int off, int lane) {
    const int l15 = lane & 15, lq = lane >> 4;
#define SW_PV(vv, kb_) _Pragma("unroll") for (int u = 0; u < 8; ++u) { const int key = (kb_) + 4 * u + lq; \
            if (key < k1) { \
                _Pragma("unroll") for (int g = 0; g < 4; ++g) { const float pp = sc[g * ld + off + key]; acc[g].x += pp * vv[u].x; acc[g].y += pp * vv[u].y; acc[g].z += pp * vv[u].z; acc[g].w += pp * vv[u].w; } } }
    float4 va[8], vc_[8];
    SW_LOAD(va, vb, k0)
#pragma unroll 1
    for (int kb0 = k0; kb0 < k1; kb0 += 64) {
        SW_LOAD(vc_, vb, kb0 + 32)
        SW_PV(va, kb0)
        SW_LOAD(va, vb, kb0 + 64)
        if (kb0 + 32 < k1) { SW_PV(vc_, kb0 + 32) }
    }
#undef SW_PV
}
#undef SW_LOAD
__device__ __forceinline__ void sw_softmax_row(float* r, int total, int lane) {
    float m = -3.0e38f;
    for (int i = lane; i < total; i += 64) m = fmaxf(m, r[i]);
    m = wave_max(m);
    float s = 0.f;
    for (int i = lane; i < total; i += 64) { const float e = __expf(r[i] - m); r[i] = e; s += e; }
    s = wave_sum(s);
    const float inv = 1.0f / s;
    for (int i = lane; i < total; i += 64) r[i] *= inv;
}
__device__ __forceinline__ void sw_gate_add(float4 (&tot)[4], float4 (&acc)[4], const float* gate, int gi) {
#pragma unroll
    for (int g = 0; g < 4; ++g) { const float gt = gate[g * 3 + gi]; tot[g].x += gt * acc[g].x; tot[g].y += gt * acc[g].y; tot[g].z += gt * acc[g].z; tot[g].w += gt * acc[g].w; acc[g] = make_float4(0.f, 0.f, 0.f, 0.f); }
}

__device__ __forceinline__ void nsa_sample_wg(const Ctx& c, int item) {
    const int b = item >> 2, kvh = item & 3, row = NPR + b;
    int tid = c.tid; asm volatile("" : "+v"(tid));
    const int lane = tid & 63, wave = c.wave, l15 = lane & 15;
    float* L = (float*)c.lds;
    float* SCC = L;
    float* SCS = L + 512;
    float* SCW = L + 512 + 4096;
    float* SCO = SCW + 4 * 576;
    float* PART = SCO + 64;
    unsigned long long* MSKp = (unsigned long long*)(PART + 8 * 256);
    const float* KVO = c.out + O_KV;
    const float* gate = WSP(const float, WS_GATE) + (size_t)row * 48 + kvh * 12;
    float4 qr[4], qs[4];
#pragma unroll
    for (int g = 0; g < 4; ++g) { qr[g] = *(const float4*)(WSP(const float, WS_QRAW) + (size_t)row * 1024 + (kvh * 4 + g) * 64 + 4 * l15);
                                  qs[g] = *(const float4*)(WSP(const float, WS_QROT) + (size_t)row * 1024 + (kvh * 4 + g) * 64 + 4 * l15); }
    float4 tot[4], acc[4];
#pragma unroll
    for (int g = 0; g < 4; ++g) { tot[g] = make_float4(0.f, 0.f, 0.f, 0.f); acc[g] = make_float4(0.f, 0.f, 0.f, 0.f); }
    const float* kc = WSP(const float, WS_KCS) + (size_t)b * 128 * 256 + kvh * 64;
    const float* vc = WSP(const float, WS_VCS) + (size_t)b * 128 * 256 + kvh * 64;
    const float* kw1 = c.p->in[4] + (size_t)b * 512 * 512 + kvh * 64;
    const float* kw2 = WSP(const float, WS_KW) + (size_t)row * 512 + kvh * 64;
    __syncthreads();
    { const int k0 = 16 * wave, k1 = (16 * wave + 16) < NCS ? 16 * wave + 16 : NCS; if (k0 < k1) sw_scores(qr, kc, 256, k0, k1, SCC, 128, 0, lane); }
    sw_scores(qs, kw1, 512, 64 * wave, 64 * wave + 64, SCW, 576, 0, lane);
    if (wave == 7) sw_scores(qs, kw2, 512, 0, 1, SCW, 576, 512, lane);
    __syncthreads();
    if (wave < 4) sw_softmax_row(SCC + wave * 128, NCS, lane); else sw_softmax_row(SCW + (wave - 4) * 576, 513, lane);
    __syncthreads();
    if (wave == 0) {
        const int j = lane;
        float imp = 0.f;
#pragma unroll
        for (int r = -1; r <= 3; ++r) { const int n = 4 * j + r; if (n >= 0 && n < NCS) { const float P = SCC[n] + SCC[128 + n] + SCC[256 + n] + SCC[384 + n]; imp += (r == -1 || r == 3) ? P : 2.0f * P; } }
        const bool valid = j <= 32, forced = (j == 0) || (j == 31) || (j == 32);
        const float score = valid ? imp + (forced ? 1.0e4f : 0.0f) : NEGV;
        SCO[j] = score;
        WAVE_SYNC();
        int rank = 0;
#pragma unroll 8
        for (int jp = 0; jp < 64; ++jp) { const float o2 = SCO[jp]; rank += (o2 > score || (o2 == score && jp < j)) ? 1 : 0; }
        const unsigned long long mk = __ballot(valid && rank < 16);
        if (lane == 0) MSKp[0] = mk;
    }
    { const int k0 = 16 * wave, k1 = (16 * wave + 16) < NCS ? 16 * wave + 16 : NCS; if (k0 < k1) sw_pv(acc, vc, 256, k0, k1, SCC, 128, 0, lane); }
    sw_gate_add(tot, acc, gate, 0);
    sw_pv(acc, kw1 + 256, 512, 64 * wave, 64 * wave + 64, SCW, 576, 0, lane);
    if (wave == 7) sw_pv(acc, kw2 + 256, 512, 0, 1, SCW, 576, 512, lane);
    sw_gate_add(tot, acc, gate, 2);
    __syncthreads();
    const unsigned long long mask = MSKp[0];
    const float* kp[2]; int cnt[2];
    {
        unsigned long long m = mask; int sidx = 0;
        kp[0] = KVO; kp[1] = KVO; cnt[0] = 0; cnt[1] = 0;
#pragma unroll 1
        while (m) { const int j = __ffsll((long long)m) - 1; m &= m - 1;
            if ((sidx >> 1) == wave) {
                const float* p; int n;
                if (j < 32) { const int page = ((const int*)c.p->in[3])[b * NPAGES + (j >> 1)]; p = c.p->in[2] + ((size_t)page * PAGE + (j & 1) * 64) * 1024 + 512 + kvh * 64; n = 64; }
                else { p = KVO + (size_t)row * 1024 + 512 + kvh * 64; n = 1; }
                if (sidx & 1) { kp[1] = p; cnt[1] = n; } else { kp[0] = p; cnt[0] = n; }
            }
            ++sidx; }
    }
    int total_sel; { const int nsel = __popcll(mask); total_sel = (mask >> 32) & 1ull ? 64 * (nsel - 1) + 1 : 64 * nsel; }
    if (cnt[0] > 0) sw_scores(qs, kp[0], 1024, 0, cnt[0], SCS, 1024, 128 * wave, lane);
    if (cnt[1] > 0) sw_scores(qs, kp[1], 1024, 0, cnt[1], SCS, 1024, 128 * wave + 64, lane);
    __syncthreads();
    if (wave < 4) sw_softmax_row(SCS + wave * 1024, total_sel, lane);
    __syncthreads();
    if (cnt[0] > 0) sw_pv(acc, kp[0] + 256, 1024, 0, cnt[0], SCS, 1024, 128 * wave, lane);
    if (cnt[1] > 0) sw_pv(acc, kp[1] + 256, 1024, 0, cnt[1], SCS, 1024, 128 * wave + 64, lane);
    sw_gate_add(tot, acc, gate, 1);
#pragma unroll
    for (int g = 0; g < 4; ++g) { tot[g].x = sum_q(tot[g].x); tot[g].y = sum_q(tot[g].y); tot[g].z = sum_q(tot[g].z); tot[g].w = sum_q(tot[g].w);
        if (lane < 16) *(float4*)(PART + (wave * 4 + g) * 64 + 4 * l15) = tot[g]; }
    __syncthreads();
    if (tid < 256) { float s = 0.f;
#pragma unroll
        for (int w = 0; w < 8; ++w) s += PART[w * 256 + tid];
        WSP(bf16_t, WS_AMIX)[(size_t)row * DM + kvh * 256 + tid] = f2bf(s); }
}

__device__ __forceinline__ void p6_prep(const Ctx& c) {
    float* wl = (float*)c.lds + c.wave * 4352;
    __syncthreads();
    unsigned long long tp_ = 0; if (PROBE_T >= 341 && PROBE_T <= 343) tp_ = wall_clock64();
#pragma unroll 1
    for (int it = c.bid * NWAVES + c.wave; it < CKN; it += c.G * NWAVES) rwc_prep_item(c, it, wl);
    if (PROBE_T == 341) { __syncthreads(); if (c.tid == 0) atomicMax((unsigned*)(c.ws + WS_CTL) + 6000, (unsigned)(wall_clock64() - tp_)); }
#pragma unroll 1
    for (int it = c.bid * NWAVES + c.wave; it < NSM * 16; it += c.G * NWAVES) scan_sample_item(c, it, wl);
    if (PROBE_T == 342) { __syncthreads(); if (c.tid == 0) atomicMax((unsigned*)(c.ws + WS_CTL) + 6000, (unsigned)(wall_clock64() - tp_)); }
    {
        const size_t per_b = (size_t)511 * 128, total = per_b * NSM, nthr = (size_t)c.G * NTHREADS; const float* sw = c.p->in[4]; float* wo = c.out + O_WINS;
#pragma unroll 1
        for (size_t e0 = (size_t)c.bid * NTHREADS + c.tid; e0 < total; e0 += 8 * nthr) {
            float4 t0, t1, t2, t3, t4, t5, t6, t7;
#define WC_LD(tk, k) { const size_t e_ = e0 + (k) * nthr; const size_t ec = e_ < total ? e_ : total - 1; tk = *(const float4*)(sw + (ec / per_b) * 512 * 512 + 512 + (ec % per_b) * 4); }
#define WC_ST(tk, k) { const size_t e_ = e0 + (k) * nthr; if (e_ < total) *(float4*)(wo + (e_ / per_b) * 512 * 512 + (e_ % per_b) * 4) = tk; }
            WC_LD(t0, 0) WC_LD(t1, 1) WC_LD(t2, 2) WC_LD(t3, 3) WC_LD(t4, 4) WC_LD(t5, 5) WC_LD(t6, 6) WC_LD(t7, 7)
            WC_ST(t0, 0) WC_ST(t1, 1) WC_ST(t2, 2) WC_ST(t3, 3) WC_ST(t4, 4) WC_ST(t5, 5) WC_ST(t6, 6) WC_ST(t7, 7)
#undef WC_LD
#undef WC_ST
        }
    }
}

__device__ __forceinline__ void p6_mixers(const Ctx& c, int qi = 0, unsigned long long* probe_scan_end = nullptr, unsigned long long* probe_acc = nullptr) {
    if (c.bid < 32) { rwc_scan_wg(c, c.bid); if (probe_scan_end && c.bid == 0) *probe_scan_end = wall_clock64(); }
    __syncthreads();
    unsigned* q = (unsigned*)(c.ws + WS_CTL) + CW_QATT + 64 * qi;
    volatile unsigned* sh = (volatile unsigned*)(c.lds + LDS_MISC + 64);
    const int n_mfma = 1024, n_pulls = n_mfma + NSM * 4;
    unsigned nx_ = 0u;
    __syncthreads();
    if (c.tid == 0) sh[0] = atomicAdd(q, 1u);
    __syncthreads();
    unsigned pull = sh[0];
#pragma unroll 1
    while (pull < (unsigned)n_pulls) {
        if (c.tid == 0) nx_ = atomicAdd(q, 1u);
        if (pull < (unsigned)n_mfma) nsa_tile_mfma(c, (int)pull, probe_acc);
        else { unsigned long long ps_ = 0; if (PROBE_T == 204 && probe_acc) ps_ = wall_clock64(); nsa_sample_wg(c, (int)pull - n_mfma); if (PROBE_T == 204 && probe_acc) *probe_acc += wall_clock64() - ps_; }
        __syncthreads();
        if (c.tid == 0) sh[0] = nx_;
        __syncthreads();
        pull = sh[0];
    }
}


constexpr int N_PHASES = 14;

template <class Epi>
__device__ __forceinline__ void run_gemm(const Ctx& c, const bf16_t* A, const bf16_t* Bt, int M, int N, int K, const Epi& E) {
    pg8::Gemm g{A, Bt, M, N, K, K};
    pg8::StaticOrder S; S.init(M, N, c.G, c.bid);
    pg8::gemm_phase<Epi, pg8::StaticOrder, false>((PG8_LAS unsigned char*)c.lds, g, S, E, nullptr);
}
__device__ __forceinline__ void run_gemm_split(const Ctx& c, const bf16_t* A, const bf16_t* Bt, int N, int K, int nsplit) {
    pg8::Gemm g{A + (size_t)NPR * K, Bt, 256, N, K / nsplit, K};
    pg8::SplitOrder S{N / 256, nsplit, K / nsplit, c.G, c.bid};
    pg8::EpiF32 E{WSP(float, WS_OS), N, nullptr, (size_t)256 * N};
    pg8::gemm_phase<pg8::EpiF32, pg8::SplitOrder, false>((PG8_LAS unsigned char*)c.lds, g, S, E, nullptr);
}
__device__ __forceinline__ void reduce_cols_sample(const Ctx& c) {
    const float* os = WSP(const float, WS_OS); float* cols = WSP(float, WS_COLS) + (size_t)NPR * NINP;
    const int n4 = NSM * NINP / 4;
#pragma unroll 1
    for (int e = c.bid * NTHREADS + c.tid; e < n4; e += c.G * NTHREADS) {
        float4 a = *(const float4*)(os + (size_t)e * 4);
#pragma unroll
        for (int sp = 1; sp < 8; ++sp) { const float4 t = *(const float4*)(os + (size_t)sp * 256 * NINP + (size_t)e * 4); a.x += t.x; a.y += t.y; a.z += t.z; a.w += t.w; }
        *(float4*)(cols + (size_t)e * 4) = a;
    }
}

__device__ __forceinline__ bool phase_refresh(Ctx& c) { int t_ = threadIdx.x; asm volatile("" : "+v"(t_)); c.tid = t_; c.lane = t_ & 63; return true; }

__global__ void __launch_bounds__(NTHREADS, 2) hybrid_fwd(Params prm) {
    extern __shared__ __attribute__((aligned(16))) unsigned char shm[];
    Ctx c; c.p = &prm; c.ws = prm.ws; c.out = prm.out; c.lds = shm;
    c.tid = threadIdx.x; c.lane = c.tid & 63; c.wave = __builtin_amdgcn_readfirstlane(c.tid >> 6); c.bid = blockIdx.x; c.G = gridDim.x;
    const int lo = prm.ph_lo, hi = prm.ph_hi;
    if (c.tid < 4) ((volatile unsigned*)(shm + LDS_MISC))[c.tid] = 0u;
    __syncthreads();
    XcdBarrier bar; bar.bar = (unsigned*)(c.ws + WS_CTL) + CW_BAR; bar.x = 0; bar.st = nullptr;
    const bool multi = (hi - lo) > 1;
    if (multi) bar = xcd_barrier_post((unsigned*)(c.ws + WS_CTL) + CW_BAR, (volatile LAS unsigned*)(shm + LDS_MISC));
#ifndef PROBE_PH
#define PROBE_PH -1
#endif
#ifndef PROBE_T
#define PROBE_T -1
#endif
    unsigned long long probe_dt = 0, probe_t0 = 0;
#define PT0(k) do { if (PROBE_T == (k) && c.bid == 0) probe_t0 = wall_clock64(); } while (0)
#define PT1(k) do { if (PROBE_T == (k) && c.bid == 0) probe_dt = wall_clock64() - probe_t0; } while (0)
#define IN(k) (lo <= (k) && (k) < hi && phase_refresh(c))
#define SEAM(k) do { if (lo <= (k) && (k) + 1 < hi) xcd_barrier(bar); } while (0)

    PT0(0);
    if (IN(0)) { p0_prologue(c); } SEAM(0);
    PT1(0);
    PT0(1);
    if (IN(1)) { pg8::EpiSwiGLU E{WSP(bf16_t, WS_ACT), DFF}; run_gemm(c, WSP(const bf16_t, WS_A1), WSP(const bf16_t, WS_WGU1), MP, NGU, DM, E); } SEAM(1);
    PT1(1);
    PT0(2);
    if (IN(2)) { pg8::EpiB16 E{WSP(bf16_t, WS_O), DM}; run_gemm(c, WSP(const bf16_t, WS_ACT), WSP(const bf16_t, WS_WDN1), NPR, DM, DFF, E);
                 run_gemm_split(c, WSP(const bf16_t, WS_ACT), WSP(const bf16_t, WS_WDN1), DM, DFF, 11); } SEAM(2);
    PT1(2);
    PT0(3);
    if (IN(3)) { thin_norm(c, WSP(const float, WS_O), 11, 0, prm.in[8], 0.5f, WSP(float, WS_H1), prm.in[11], WSP(bf16_t, WS_A2)); } SEAM(3);
    PT1(3);
    PT0(4);
    if (IN(4)) { pg8::EpiF32 E{WSP(float, WS_COLS), NINP, nullptr, 0}; run_gemm(c, WSP(const bf16_t, WS_A2), WSP(const bf16_t, WS_WIN), NPR, NINP, DM, E);
                 run_gemm_split(c, WSP(const bf16_t, WS_A2), WSP(const bf16_t, WS_WIN), NINP, DM, 8); } SEAM(4);
    PT1(4);
    PT0(5);
    if (IN(5)) { reduce_cols_sample(c); } SEAM(5);
    PT1(5);
    PT0(6);
    if (IN(6)) {
#if PROBE_T >= 301 && PROBE_T <= 303
        unsigned long long pa_ = 0; p5_queue(c, &pa_); if (c.bid == 255) probe_dt = pa_;
#elif PROBE_T >= 311 && PROBE_T <= 333
        unsigned long long pa_ = wall_clock64(); p5_queue(c, &pa_);
#else
        p5_queue(c);
#endif
    } SEAM(6);
    PT1(6);
#if PROBE_T >= 311 && PROBE_T <= 333
    if (c.bid == 255) probe_dt = (unsigned long long)__hip_atomic_load((unsigned*)(c.ws + WS_CTL) + 6000, __ATOMIC_RELAXED, __HIP_MEMORY_SCOPE_AGENT);
#endif
    PT0(7);
    if (IN(7)) { p6_prep(c); } SEAM(7);
    PT1(7);
#if PROBE_T >= 341 && PROBE_T <= 343
    if (c.bid == 255) probe_dt = (unsigned long long)__hip_atomic_load((unsigned*)(c.ws + WS_CTL) + 6000, __ATOMIC_RELAXED, __HIP_MEMORY_SCOPE_AGENT);
#endif
    PT0(8);
    if (IN(8)) {
#if PROBE_T == 100
        unsigned long long ts0 = wall_clock64(), ts1 = ts0; p6_mixers(c, 0, &ts1); if (c.bid == 0) probe_dt = ts1 - ts0;
#elif PROBE_T >= 201 && PROBE_T <= 212
        unsigned long long pa_ = 0; p6_mixers(c, 0, nullptr, &pa_); if (c.bid == 255) probe_dt = pa_;
#else
        p6_mixers(c, 0);
#endif
    } SEAM(8);
    PT1(8);
    PT0(9);
    if (IN(9)) { pg8::EpiB16 E{WSP(bf16_t, WS_O), DM}; run_gemm(c, WSP(const bf16_t, WS_AMIX), WSP(const bf16_t, WS_WOUT), NPR, DM, DM, E);
                  run_gemm_split(c, WSP(const bf16_t, WS_AMIX), WSP(const bf16_t, WS_WOUT), DM, DM, 8); } SEAM(9);
    PT1(9);
    PT0(10);
    if (IN(10)) { thin_norm(c, WSP(const float, WS_O), 8, 1, prm.in[31], 1.0f, WSP(float, WS_H2), prm.in[32], WSP(bf16_t, WS_A3)); } SEAM(10);
    PT1(10);
    PT0(11);
    if (IN(11)) { pg8::EpiSwiGLU E{WSP(bf16_t, WS_ACT), DFF}; run_gemm(c, WSP(const bf16_t, WS_A3), WSP(const bf16_t, WS_WGU2), MP, NGU, DM, E); } SEAM(11);
    PT1(11);
    PT0(12);
    if (IN(12)) { pg8::EpiB16 E{WSP(bf16_t, WS_O), DM}; run_gemm(c, WSP(const bf16_t, WS_ACT), WSP(const bf16_t, WS_WDN2), NPR, DM, DFF, E);
                  run_gemm_split(c, WSP(const bf16_t, WS_ACT), WSP(const bf16_t, WS_WDN2), DM, DFF, 11); } SEAM(12);
    PT1(12);
    PT0(13);
    if (IN(13)) { thin_norm(c, WSP(const float, WS_O), 11, 2, prm.in[35], 0.5f, c.out + O_Y, nullptr, nullptr); }
    if (PROBE_T >= 0 && c.bid == (PROBE_T >= 201 ? 255 : 0) && c.tid == 0) { const unsigned long long te = wall_clock64(); while (wall_clock64() - te < probe_dt) __builtin_amdgcn_s_sleep(8); }
#undef IN
#undef SEAM
}

extern "C" void kernel_launch(void* const* d_in, const int* in_sizes, int n_in, void* d_out, int out_size, void* d_ws, size_t ws_size, hipStream_t stream) {
    static int grid = 0;
    if (grid == 0) {
        if (n_in != 36 || (size_t)out_size != O_END || ws_size < WS_END) { fprintf(stderr, "kernel_launch: unexpected problem shape (n_in %d, out %d, ws %zu; need 36, %zu, >= %zu)\n", n_in, out_size, ws_size, (size_t)O_END, (size_t)WS_END); grid = -1; return; }
        int dev = 0, cus = 0, per_cu = 0;
        if (hipGetDevice(&dev) != hipSuccess || hipDeviceGetAttribute(&cus, hipDeviceAttributeMultiprocessorCount, dev) != hipSuccess) { grid = -1; return; }
        if (hipFuncSetAttribute((const void*)hybrid_fwd, hipFuncAttributeMaxDynamicSharedMemorySize, LDS_BYTES) != hipSuccess) { fprintf(stderr, "kernel_launch: hipFuncSetAttribute failed\n"); grid = -1; return; }
        if (hipOccupancyMaxActiveBlocksPerMultiprocessor(&per_cu, (const void*)hybrid_fwd, NTHREADS, LDS_BYTES) != hipSuccess || per_cu < 1) { fprintf(stderr, "kernel_launch: occupancy query says %d\n", per_cu); }
        (void)hipGetLastError();
        grid = cus;
        if (grid != 256) fprintf(stderr, "kernel_launch: %d CUs (expected 256)\n", grid);
    }
    if (grid < 0) return;
    if (hipMemsetAsync((char*)d_ws + WS_CTL, 0, CTL_BYTES, stream) != hipSuccess) return;
    Params p{};
    for (int i = 0; i < 36; ++i) p.in[i] = (const float*)d_in[i];
    p.out = (float*)d_out; p.ws = (unsigned char*)d_ws; p.pad0 = 0; p.pad1 = 0;
#if MK_N_LAUNCHES == 1
    p.ph_lo = 0; p.ph_hi = N_PHASES;
    hipLaunchKernelGGL(hybrid_fwd, dim3(grid), dim3(NTHREADS), LDS_BYTES, stream, p);
#else
    for (int ph = 0; ph < N_PHASES; ++ph) { p.ph_lo = ph; p.ph_hi = ph + 1; hipLaunchKernelGGL(hybrid_fwd, dim3(grid), dim3(NTHREADS), LDS_BYTES, stream, p); }
#endif
}
```

```cpp
#include <hip/hip_runtime.h>
#include <cstdio>
#include <cstdint>

#ifndef MK_N_LAUNCHES
#define MK_N_LAUNCHES 1
#endif

constexpr int DM = 2048, SEQ = 4096, NPR = 8192, NSM = 128, NR = NPR + NSM  , MP = 8448  ;
constexpr int DFF = 5632, NGU = 2 * DFF, NIN = 5968, NINP = 6144, NSAC = 2608, RWC = 3360;
constexpr int PAST = 2048, NPAGES = 16, PAGE = 128;
constexpr int NCP = 255  , NCS = 127  ;
constexpr float RMS_EPS = 1e-6f, GN_EPS = 64e-5f, NEGV = -1e30f;

constexpr size_t O_Y = 0, O_KV = 17039360, O_WINP = 25559040, O_WINS = 26083328, O_WKVP = 59637760, O_WKVS = 59768832, O_SHP = 68157440, O_SHS = 68164160, O_END = 68594240;

constexpr size_t al256(size_t x) { return (x + 255) & ~(size_t)255; }
constexpr size_t WS_CTL = 0, CTL_BYTES = 65536;
constexpr size_t WS_WGU1 = al256(WS_CTL + CTL_BYTES);
constexpr size_t WS_WDN1 = al256(WS_WGU1 + (size_t)NGU * DM * 2);
constexpr size_t WS_WIN  = al256(WS_WDN1 + (size_t)DM * DFF * 2);
constexpr size_t WS_WOUT = al256(WS_WIN + (size_t)NINP * DM * 2);
constexpr size_t WS_WGU2 = al256(WS_WOUT + (size_t)DM * DM * 2);
constexpr size_t WS_WDN2 = al256(WS_WGU2 + (size_t)NGU * DM * 2);
constexpr size_t WS_A1   = al256(WS_WDN2 + (size_t)DM * DFF * 2);
constexpr size_t WS_A2   = al256(WS_A1 + (size_t)MP * DM * 2);
constexpr size_t WS_A3   = al256(WS_A2 + (size_t)MP * DM * 2);
constexpr size_t WS_AMIX = al256(WS_A3 + (size_t)MP * DM * 2);
constexpr size_t WS_ACT  = al256(WS_AMIX + (size_t)MP * DM * 2);
constexpr size_t WS_O    = al256(WS_ACT + (size_t)MP * DFF * 2);
constexpr size_t WS_H1   = al256(WS_O + (size_t)MP * DM * 4);
constexpr size_t WS_H2   = al256(WS_H1 + (size_t)NR * DM * 4);
constexpr size_t WS_COLS = al256(WS_H2 + (size_t)NR * DM * 4);
constexpr size_t WS_QRAW = al256(WS_COLS + (size_t)MP * NINP * 4);
constexpr size_t WS_QROT = al256(WS_QRAW + (size_t)NR * 1024 * 4);
constexpr size_t WS_KW   = al256(WS_QROT + (size_t)NR * 1024 * 4);
constexpr size_t WS_GATE = al256(WS_KW + (size_t)NR * 512 * 4);
constexpr size_t WS_RW   = al256(WS_GATE + (size_t)NR * 48 * 4);
constexpr size_t WS_V    = al256(WS_RW + (size_t)NR * 5 * 1024 * 4);
constexpr size_t WS_G    = al256(WS_V + (size_t)NR * 1024 * 4);
constexpr size_t WS_Y    = al256(WS_G + (size_t)NR * 1024 * 4);
constexpr size_t WS_BON  = al256(WS_Y + (size_t)NR * 1024 * 4);
constexpr size_t WS_KCP  = al256(WS_BON + (size_t)NR * 16 * 4);
constexpr size_t WS_VCP  = al256(WS_KCP + (size_t)2 * 256 * 256 * 4);
constexpr size_t WS_KCS  = al256(WS_VCP + (size_t)2 * 256 * 256 * 4);
constexpr size_t WS_VCS  = al256(WS_KCS + (size_t)128 * 128 * 256 * 4);
constexpr size_t WS_ROPE = al256(WS_VCS + (size_t)128 * 128 * 256 * 4);
constexpr size_t WS_QRB  = al256(WS_ROPE + (size_t)4096 * 16 * 4);
constexpr size_t WS_QSB  = al256(WS_QRB + (size_t)NPR * 1024 * 2);
constexpr size_t WS_KSB  = al256(WS_QSB + (size_t)NPR * 1024 * 2);
constexpr size_t WS_VSB  = al256(WS_KSB + (size_t)NPR * 256 * 2);
constexpr size_t WS_KWB  = al256(WS_VSB + (size_t)NPR * 256 * 2);
constexpr size_t WS_VWB  = al256(WS_KWB + (size_t)NPR * 256 * 2);
constexpr size_t WS_KCB  = al256(WS_VWB + (size_t)NPR * 256 * 2);
constexpr size_t WS_VCB  = al256(WS_KCB + (size_t)2 * 256 * 256 * 2);
constexpr size_t WS_W1T  = al256(WS_VCB + (size_t)2 * 256 * 256 * 2);
constexpr size_t WS_W2T  = al256(WS_W1T + (size_t)2 * 16 * 256 * 64 * 2);
constexpr size_t WS_PET  = al256(WS_W2T + (size_t)2 * 64 * 128 * 2);
constexpr size_t WS_DEC  = al256(WS_PET + (size_t)2 * 128 * 4);
constexpr size_t WS_AA   = al256(WS_DEC + (size_t)NR * 1024 * 4);
constexpr size_t WS_LW2T = al256(WS_AA + (size_t)NR * 1024 * 4);
constexpr size_t WS_LA2T = al256(WS_LW2T + (size_t)1024 * 64 * 2);
constexpr size_t WS_LG2T = al256(WS_LA2T + (size_t)1024 * 64 * 2);
constexpr size_t CK_REC = 11520;
constexpr size_t WS_CK   = al256(WS_LG2T + (size_t)1024 * 160 * 2);
constexpr size_t WS_OS   = al256(WS_CK + (size_t)8192 * CK_REC + 4096);
constexpr size_t WS_END  = al256(WS_OS + (size_t)8 * 256 * NINP * 4);

constexpr int CW_BAR = 0;
constexpr int CW_QATT = 4096;
constexpr int CW_QMISC = 4160;

constexpr int NTHREADS = 512, NWAVES = 8;
constexpr int LDS_BYTES = 147456;
constexpr int LDS_MISC = 146432;

typedef unsigned short bf16_t;
typedef float p1_f2 __attribute__((ext_vector_type(2)));
typedef __bf16 p1_b2 __attribute__((ext_vector_type(2)));
__device__ __forceinline__ unsigned pack2bf(float lo, float hi) { const p1_f2 v = {lo, hi}; return __builtin_bit_cast(unsigned, __builtin_convertvector(v, p1_b2)); }
__device__ __forceinline__ bf16_t f2bf(float f) { return (bf16_t)(pack2bf(f, 0.f) & 0xffffu); }

struct Params {
    const float* in[36];
    float* out;
    unsigned char* ws;
    int ph_lo, ph_hi, pad0, pad1;
};

#define XB_TMO      128
#define XB_XCNT(j)  (256  + 64 * (j))
#define XB_XSUB(j)  (1280 + 64 * (j))
#define XB_XGEN(j)  (2304 + 64 * (j))
#define XB_TOP      3328
#define XB_TOPGEN   3392
#define XCD_BAR_WORDS 3456
#define XB_SPIN_CAP (1u << 18)
#define LAS __attribute__((address_space(3)))

__device__ __forceinline__ unsigned xb_ld(unsigned* p)              { return __hip_atomic_load(p, __ATOMIC_RELAXED, __HIP_MEMORY_SCOPE_AGENT); }
__device__ __forceinline__ unsigned xb_add(unsigned* p, unsigned v) { return __hip_atomic_fetch_add(p, v, __ATOMIC_RELAXED, __HIP_MEMORY_SCOPE_AGENT); }
__device__ __forceinline__ unsigned xb_xcc_id() { return (unsigned)__builtin_amdgcn_s_getreg((3 << 11) | 20) & 0xFu; }
#define XB_SPIN(cond, bar) do { unsigned _sp = 0; while (cond) { __builtin_amdgcn_s_sleep(1); \
    if ((++_sp & 255u) == 0u) { if (xb_ld(&(bar)[XB_TMO])) break; if (_sp > XB_SPIN_CAP) { atomicAdd(&(bar)[XB_TMO], 1u); break; } } } } while (0)

struct XcdBarrier {
    unsigned* bar; unsigned x;
    volatile LAS unsigned* st;
};

__device__ __forceinline__ XcdBarrier xcd_barrier_post(unsigned* bar, volatile LAS unsigned* st) {
    XcdBarrier b; b.bar = bar; b.x = xb_xcc_id(); b.st = st;
    if (threadIdx.x == 0) (void)xb_add(&bar[XB_XCNT(b.x)], 1u);
    return b;
}
__device__ __forceinline__ void xcd_barrier_complete(unsigned* bar, unsigned x, unsigned& nloc, unsigned& nx) {
    const unsigned G = gridDim.x * gridDim.y * gridDim.z;
    unsigned sum, cnt, mine, sp = 0u;
    for (;;) {
        sum = 0u; cnt = 0u; mine = 0u;
#pragma unroll
        for (unsigned j = 0; j < 16; ++j) { const unsigned c = xb_ld(&bar[XB_XCNT(j)]); sum += c; cnt += (c > 0u) ? 1u : 0u; mine = (j == x) ? c : mine; }
        if (sum == G) break;
        __builtin_amdgcn_s_sleep(1);
        if ((++sp & 255u) == 0u) { if (xb_ld(&bar[XB_TMO])) break; if (sp > XB_SPIN_CAP) { atomicAdd(&bar[XB_TMO], 1u); break; } }
    }
    nloc = mine > 0u ? mine : 1u; nx = cnt > 0u ? cnt : 1u;
}

__device__ __forceinline__ void xcd_barrier(const XcdBarrier& b) {
    asm volatile("s_waitcnt vmcnt(0)" ::: "memory");
    __syncthreads();
    if (threadIdx.x == 0) {
        unsigned* bar = b.bar;
        __builtin_amdgcn_s_waitcnt(0);
        unsigned nloc = b.st[0], nx = b.st[1];
        if (nloc == 0u) { xcd_barrier_complete(bar, b.x, nloc, nx); b.st[0] = nloc; b.st[1] = nx; }
        const unsigned old = xb_add(&bar[XB_XSUB(b.x)], 1u);
        const unsigned gen = old / nloc;
        if (old + 1u == (gen + 1u) * nloc) {
            __builtin_amdgcn_fence(__ATOMIC_RELEASE, "agent");
            asm volatile("s_waitcnt vmcnt(0)" ::: "memory");
            const unsigned og = xb_add(&bar[XB_TOP], 1u);
            const unsigned tg = og / nx;
            if (og + 1u == (tg + 1u) * nx) xb_add(&bar[XB_TOPGEN], 1u);
            else XB_SPIN(xb_ld(&bar[XB_TOPGEN]) == tg, bar);
            __builtin_amdgcn_fence(__ATOMIC_ACQUIRE, "agent");
            xb_add(&bar[XB_XGEN(b.x)], 1u);
            asm volatile("s_waitcnt vmcnt(0)" ::: "memory");
        } else {
            XB_SPIN(xb_ld(&bar[XB_XGEN(b.x)]) == gen, bar);
            __builtin_amdgcn_fence(__ATOMIC_ACQUIRE, "agent");
            asm volatile("s_waitcnt vmcnt(0)" ::: "memory");
        }
    }
    __syncthreads();
}
namespace pg8 {
#define PG8_LAS __attribute__((address_space(3)))
typedef unsigned short bf16_t;
typedef short bf16x8 __attribute__((ext_vector_type(8)));
typedef float f32x4 __attribute__((ext_vector_type(4)));
typedef unsigned u32x4 __attribute__((ext_vector_type(4)));
constexpr int BM = 256, BK = 64, HALF = 128, HTB = HALF * BK * 2  , STAGE_BYTES = 8 * HTB, NXCD = 8, WGM = 8;

__host__ __device__ __forceinline__ int lds_byte(int r, int c) { const int st = (r >> 4) * 2 + (c >> 5), rr = r & 15, cc = c & 31, ob = rr * 64 + cc * 2; return st * 1024 + (ob ^ (((ob >> 9) & 1) << 5)); }
__host__ __device__ __forceinline__ void stage_rc(int b, int& R, int& C) { const int st = b / 1024, sb = b % 1024, swz = sb ^ (((sb >> 9) & 1) << 5); R = (st >> 1) * 16 + swz / 64; C = (st & 1) * 32 + (swz % 64) / 2; }
__host__ __device__ __forceinline__ int perm32(int rho) { const int n = rho >> 4, i = rho & 15; return 8 * (i >> 2) + 4 * n + (i & 3); }

struct Unit { int pm, pn, ko, ks; };
struct Gemm { const bf16_t* A; const bf16_t* Bt; int M, N, K, ld; };

struct StaticOrder {
    int nM, nN, nwg, G, c;
    __host__ __device__ void init(int M, int N, int G_, int c_) { nM = M / BM; nN = N / BM; nwg = nM * nN; G = G_; c = c_; }
    __host__ __device__ bool next(int i, Unit& u) const {
        const long L = (long)i * G + c; if (L >= nwg) return false;
        int wgid = (int)L; { const int q = nwg / NXCD, r = nwg % NXCD, xcd = wgid % NXCD, off = wgid / NXCD; wgid = (xcd < r ? xcd * (q + 1) : r * (q + 1) + (xcd - r) * q) + off; }
        const int nig = WGM * nN, gid = wgid / nig, fm = gid * WGM, gsz = (nM - fm) < WGM ? (nM - fm) : WGM;
        u.pm = fm + ((wgid % nig) % gsz); u.pn = (wgid % nig) / gsz; u.ko = 0; u.ks = 0; return true;
    }
    __device__ __forceinline__ void a_ready(const Unit&) const {}
    __device__ __forceinline__ void done(const Unit&) const {}
};
struct SplitOrder {
    int nN, nsplit, ksub, G, c;
    __host__ __device__ bool next(int i, Unit& u) const { const long L = (long)i * G + c; if (L >= (long)nN * nsplit) return false; u.pm = 0; u.pn = (int)(L % nN); u.ks = (int)(L / nN); u.ko = u.ks * ksub; return true; }
    __device__ __forceinline__ void a_ready(const Unit&) const {}
    __device__ __forceinline__ void done(const Unit&) const {}
};
typedef float cvt_f2 __attribute__((ext_vector_type(2)));
typedef __bf16 cvt_b2 __attribute__((ext_vector_type(2)));
__device__ __forceinline__ unsigned cvt_pk_bf16(float lo, float hi) { const cvt_f2 v = {lo, hi}; return __builtin_bit_cast(unsigned, __builtin_convertvector(v, cvt_b2)); }
typedef float f32x2 __attribute__((ext_vector_type(2)));
__device__ __forceinline__ f32x2 gelu_pk(f32x2 v) {
    const f32x2 av = __builtin_elementwise_abs(v), d = av * 0.2316418882f + 1.0f;
    f32x2 t; t.x = __builtin_amdgcn_rcpf(d.x); t.y = __builtin_amdgcn_rcpf(d.y);
    f32x2 q = t * 0.5307027145f + (-0.7265760135f); q = q * t + 0.7107068705f; q = q * t + (-0.142248368f); q = q * t + 0.127414796f; q = q * t;
    const f32x2 s = (v * v) * (-0.72134752044f);
    f32x2 e; e.x = __builtin_amdgcn_exp2f(s.x); e.y = __builtin_amdgcn_exp2f(s.y);
    const f32x2 m = v * (q * e), r = v - m;
    f32x2 o; o.x = v.x < 0.f ? m.x : r.x; o.y = v.y < 0.f ? m.y : r.y; return o;
}

struct EpiF32 {
    static constexpr bool PERM = false, AFTER_DRAIN = false;
    float* C0; int ldc; const float* bias; size_t slab;
    __device__ __forceinline__ void operator()(const f32x4 (&acc)[2][2][4][2], const Unit& u, int wr, int wc, int fr, int fq) const {
        float* C = C0 + (size_t)u.ks * slab;
        const int row0 = u.pm * BM + wr * 64 + fr, col0 = u.pn * BM + wc * 32 + 4 * fq;
        f32x4 bv[2][2];
#pragma unroll
        for (int bj = 0; bj < 2; ++bj)
#pragma unroll
            for (int n = 0; n < 2; ++n) bv[bj][n] = bias ? *(const f32x4*)(bias + col0 + bj * HALF + n * 16) : (f32x4){0.f, 0.f, 0.f, 0.f};
#pragma unroll
        for (int ai = 0; ai < 2; ++ai)
#pragma unroll
            for (int m = 0; m < 4; ++m) { float* rowp = C + (size_t)(row0 + ai * HALF + m * 16) * ldc + col0;
#pragma unroll
                for (int bj = 0; bj < 2; ++bj)
#pragma unroll
                    for (int n = 0; n < 2; ++n) *(f32x4*)(rowp + bj * HALF + n * 16) = acc[ai][bj][m][n] + bv[bj][n]; }
    }
};
struct EpiB16 {
    static constexpr bool PERM = true, AFTER_DRAIN = false;
    bf16_t* O; int ldc;
    __device__ __forceinline__ void operator()(const f32x4 (&acc)[2][2][4][2], const Unit& u, int wr, int wc, int fr, int fq) const {
        const int row0 = u.pm * BM + wr * 64 + fr, col0 = u.pn * BM + wc * 32 + 8 * fq;
#pragma unroll
        for (int ai = 0; ai < 2; ++ai)
#pragma unroll
            for (int m = 0; m < 4; ++m) { bf16_t* rowp = O + (size_t)(row0 + ai * HALF + m * 16) * ldc + col0;
#pragma unroll
                for (int bj = 0; bj < 2; ++bj) { const f32x4 v0 = acc[ai][bj][m][0], v1 = acc[ai][bj][m][1];
                    u32x4 w; w.x = cvt_pk_bf16(v0[0], v0[1]); w.y = cvt_pk_bf16(v0[2], v0[3]); w.z = cvt_pk_bf16(v1[0], v1[1]); w.w = cvt_pk_bf16(v1[2], v1[3]);
                    *(u32x4*)(rowp + bj * HALF) = w; } }
    }
};
template <class Epi, class Sched, bool STAMP = false>
__device__ __forceinline__ void gemm_phase(PG8_LAS unsigned char* lds, const Gemm g, const Sched& S, const Epi& E, unsigned long long* stamps) {
    int tid_ = threadIdx.x; asm volatile("" : "+v"(tid_));
    const int tid = tid_, wid = __builtin_amdgcn_readfirstlane(tid >> 6), lane = tid & 63, wr = wid >> 2, wc = wid & 3, fr = lane & 15, fq = lane >> 4;
    const int K = g.K, nt = K / BK;
    int ts_lo = 0, ts_hi = 0, nts = 0; const unsigned long long rt_entry = STAMP ? (unsigned long long)wall_clock64() : 0ull;
#define PG8_STAMP() do { if (STAMP && wid == 0 && nts < 64) { const unsigned long long _c = (unsigned long long)clock64(); \
        ts_lo = (lane == nts) ? (int)(unsigned)_c : ts_lo; ts_hi = (lane == nts) ? (int)(unsigned)(_c >> 32) : ts_hi; ++nts; } } while (0)
    PG8_STAMP();
    unsigned voffA[2], voffB[2];
#pragma unroll
    for (int i = 0; i < 2; ++i) { int R, C; stage_rc(tid * 16 + i * 8192, R, C); const int Rb = Epi::PERM ? ((R & ~31) + perm32(R & 31)) : R;
        voffA[i] = (unsigned)(R * g.ld + C) * 2u; voffB[i] = (unsigned)(Rb * g.ld + C) * 2u; }
    const size_t kstep = (size_t)(BK * 2);
    const size_t hstep = (size_t)HALF * g.ld * 2;
    const size_t tstep = 2 * hstep;
    const unsigned ldsw = (unsigned)wid * 1024u;
    const int aoff = lds_byte(wr * 64 + fr, fq * 8), boff = lds_byte(wc * 32 + fr, fq * 8);
#define PG8_SA(b, h) (((b) * 2 + (h)) * HTB)
#define PG8_SB(b, h) ((4 + (b) * 2 + (h)) * HTB)
#define PG8_STAGE(bufoff, gbase, voff) do { _Pragma("unroll") for (int _i = 0; _i < 2; ++_i) \
        __builtin_amdgcn_global_load_lds((const unsigned*)((const char*)(gbase) + (voff)[_i]), (PG8_LAS unsigned*)(lds + (bufoff) + ldsw + _i * 8192), 16, 0, 0); } while (0)
#define PG8_LDA(dst, b, h) do { _Pragma("unroll") for (int m = 0; m < 4; ++m) _Pragma("unroll") for (int k = 0; k < 2; ++k) dst[m][k] = *(const PG8_LAS bf16x8*)(lds + PG8_SA(b, h) + aoff + m * 2048 + k * 1024); } while (0)
#define PG8_LDB(dst, b, h) do { _Pragma("unroll") for (int n = 0; n < 2; ++n) _Pragma("unroll") for (int k = 0; k < 2; ++k) dst[n][k] = *(const PG8_LAS bf16x8*)(lds + PG8_SB(b, h) + boff + n * 2048 + k * 1024); } while (0)
#define PG8_MMA(ai, bj, At, Bt) do { __builtin_amdgcn_s_setprio(1); _Pragma("unroll") for (int m = 0; m < 4; ++m) _Pragma("unroll") for (int n = 0; n < 2; ++n) _Pragma("unroll") for (int k = 0; k < 2; ++k) \
        acc[ai][bj][m][n] = __builtin_amdgcn_mfma_f32_16x16x32_bf16(Bt[n][k], At[m][k], acc[ai][bj][m][n], 0, 0, 0); __builtin_amdgcn_s_setprio(0); } while (0)
#define PG8_WAIT_V(n) asm volatile("s_waitcnt vmcnt(" #n ")" ::: "memory")
#define PG8_WAIT_L(n) asm volatile("s_waitcnt lgkmcnt(" #n ")" ::: "memory")
#define PG8_BAR __builtin_amdgcn_s_barrier()
#define PG8_SCHED __builtin_amdgcn_sched_barrier(0)
    Unit cur, nxt; int ui = 0;
    if (!S.next(0, cur)) return;
    f32x4 acc[2][2][4][2];
#pragma unroll
    for (int a = 0; a < 2; ++a)
#pragma unroll
        for (int b = 0; b < 2; ++b)
#pragma unroll
            for (int m = 0; m < 4; ++m)
#pragma unroll
                for (int n = 0; n < 2; ++n) acc[a][b][m][n] = (f32x4){0.f, 0.f, 0.f, 0.f};
    bf16x8 At[4][2], B0[2][2], B1[2][2];
    const char* cA = (const char*)g.A + (size_t)cur.pm * tstep + (size_t)cur.ko * 2; const char* cB = (const char*)g.Bt + (size_t)cur.pn * tstep + (size_t)cur.ko * 2;
    S.a_ready(cur);
    PG8_STAGE(PG8_SB(0, 0), cB, voffB); PG8_STAGE(PG8_SA(0, 0), cA, voffA); PG8_STAGE(PG8_SB(0, 1), cB + hstep, voffB); PG8_STAGE(PG8_SA(0, 1), cA + hstep, voffA);
    if (wr == 1) PG8_BAR;
    PG8_WAIT_V(4); PG8_BAR;
    PG8_STAGE(PG8_SB(1, 0), cB + kstep, voffB); PG8_STAGE(PG8_SA(1, 0), cA + kstep, voffA); PG8_STAGE(PG8_SB(1, 1), cB + hstep + kstep, voffB);
    PG8_WAIT_V(6); PG8_BAR;
    PG8_STAMP();
    for (;;) {
        const bool has_next = S.next(ui + 1, nxt);
        const char* nA = has_next ? (const char*)g.A + (size_t)nxt.pm * tstep + (size_t)nxt.ko * 2 : cA; const char* nB = has_next ? (const char*)g.Bt + (size_t)nxt.pn * tstep + (size_t)nxt.ko * 2 : cB;
        for (int t = 0; t < nt; t += 2) {
            const bool last = (t == nt - 2);
            const char* a1 = cA + (size_t)(t + 1) * kstep;
            const char* a2 = last ? nA : cA + (size_t)(t + 2) * kstep; const char* b2 = last ? nB : cB + (size_t)(t + 2) * kstep;
            const char* a3 = a2 + kstep; const char* b3 = b2 + kstep;
            if (last && has_next) S.a_ready(nxt);
            PG8_LDB(B0, 0, 0); PG8_SCHED; PG8_LDA(At, 0, 0); PG8_STAGE(PG8_SA(1, 1), a1 + hstep, voffA);
            PG8_WAIT_L(8); PG8_BAR; PG8_WAIT_L(0); PG8_MMA(0, 0, At, B0); PG8_BAR; PG8_SCHED;
            PG8_LDB(B1, 0, 1); PG8_STAGE(PG8_SB(0, 0), b2, voffB);
            PG8_BAR; PG8_WAIT_L(0); PG8_MMA(0, 1, At, B1); PG8_BAR;
            PG8_LDA(At, 0, 1); PG8_STAGE(PG8_SA(0, 0), a2, voffA);
            PG8_BAR; PG8_WAIT_L(0); PG8_MMA(1, 0, At, B0); PG8_BAR; PG8_SCHED;
            PG8_STAGE(PG8_SB(0, 1), b2 + hstep, voffB);
            PG8_WAIT_V(6); PG8_BAR; PG8_MMA(1, 1, At, B1); PG8_BAR;
            PG8_LDB(B0, 1, 0); PG8_SCHED; PG8_LDA(At, 1, 0); PG8_STAGE(PG8_SA(0, 1), a2 + hstep, voffA);
            PG8_WAIT_L(8); PG8_BAR; PG8_WAIT_L(0); PG8_MMA(0, 0, At, B0); PG8_BAR; PG8_SCHED;
            PG8_LDB(B1, 1, 1); PG8_STAGE(PG8_SB(1, 0), b3, voffB);
            PG8_BAR; PG8_WAIT_L(0); PG8_MMA(0, 1, At, B1); PG8_BAR;
            PG8_LDA(At, 1, 1); PG8_STAGE(PG8_SA(1, 0), a3, voffA);
            PG8_BAR; PG8_WAIT_L(0); PG8_MMA(1, 0, At, B0); PG8_BAR; PG8_SCHED;
            PG8_STAGE(PG8_SB(1, 1), b3 + hstep, voffB);
            PG8_WAIT_V(6); PG8_BAR; PG8_MMA(1, 1, At, B1); PG8_BAR;
        }
        PG8_STAMP();
        if constexpr (!Epi::AFTER_DRAIN) { E(acc, cur, wr, wc, fr, fq); S.done(cur); }
        PG8_STAMP();
        if (!has_next) break;
#pragma unroll
        for (int a = 0; a < 2; ++a)
#pragma unroll
            for (int b = 0; b < 2; ++b)
#pragma unroll
                for (int m = 0; m < 4; ++m)
#pragma unroll
                    for (int n = 0; n < 2; ++n) acc[a][b][m][n] = (f32x4){0.f, 0.f, 0.f, 0.f};
        cur = nxt; cA = nA; cB = nB; ++ui;
    }
    PG8_WAIT_V(0);
    if (wr == 0) PG8_BAR;
    PG8_BAR;
    if constexpr (Epi::AFTER_DRAIN) { E.fused(acc, cur, wr, wc, fr, fq, lds, wid, lane); S.done(cur); }
    PG8_STAMP();
    if (STAMP && wid == 0) { stamps[lane] = lane < nts ? (((unsigned long long)(unsigned)ts_hi << 32) | (unsigned)ts_lo) : 0ull;
        if (lane == 62) stamps[62] = rt_entry; if (lane == 63) stamps[63] = (unsigned long long)wall_clock64(); }
#undef PG8_STAMP
#undef PG8_SA
#undef PG8_SB
#undef PG8_STAGE
#undef PG8_LDA
#undef PG8_LDB
#undef PG8_MMA
#undef PG8_WAIT_V
#undef PG8_WAIT_L
#undef PG8_BAR
#undef PG8_SCHED
}

struct EpiSwiGLU {
    static constexpr bool PERM = true, AFTER_DRAIN = false;
    bf16_t* O; int ldc;
    __device__ __forceinline__ void operator()(const f32x4 (&acc)[2][2][4][2], const Unit& u, int wr, int wc, int fr, int fq) const {
        const int row0 = u.pm * BM + wr * 64 + fr, col0 = u.pn * HALF + wc * 32 + 8 * fq;
#pragma unroll
        for (int ai = 0; ai < 2; ++ai)
#pragma unroll
            for (int m = 0; m < 4; ++m) {
                bf16_t* rowp = O + (size_t)(row0 + ai * HALF + m * 16) * ldc + col0;
                float r[8];
#pragma unroll
                for (int n = 0; n < 2; ++n)
#pragma unroll
                    for (int j = 0; j < 4; ++j) { const float g = acc[ai][0][m][n][j], up = acc[ai][1][m][n][j];
                        r[n * 4 + j] = g * __builtin_amdgcn_rcpf(1.0f + __expf(-g)) * up; }
                u32x4 w; w.x = cvt_pk_bf16(r[0], r[1]); w.y = cvt_pk_bf16(r[2], r[3]); w.z = cvt_pk_bf16(r[4], r[5]); w.w = cvt_pk_bf16(r[6], r[7]);
                *(u32x4*)rowp = w;
            }
    }
};
}

#define WAVE_SYNC() asm volatile("s_waitcnt lgkmcnt(0)" ::: "memory")
template <int CTRL> __device__ __forceinline__ float dpp_mov(float v) { return __builtin_bit_cast(float, __builtin_amdgcn_update_dpp(0, __builtin_bit_cast(int, v), CTRL, 0xF, 0xF, true)); }
__device__ __forceinline__ float xor16_get(float v, float& other) {
    const unsigned u = __builtin_bit_cast(unsigned, v);
    auto r = __builtin_amdgcn_permlane16_swap(u, u, false, false);
    other = __builtin_bit_cast(float, (unsigned)r[1]); return __builtin_bit_cast(float, (unsigned)r[0]);
}
__device__ __forceinline__ float xor32_get(float v, float& other) {
    const unsigned u = __builtin_bit_cast(unsigned, v);
    auto r = __builtin_amdgcn_permlane32_swap(u, u, false, false);
    other = __builtin_bit_cast(float, (unsigned)r[1]); return __builtin_bit_cast(float, (unsigned)r[0]);
}
__device__ __forceinline__ float red16(float v) {
    v += dpp_mov<0xB1>(v);
    v += dpp_mov<0x4E>(v);
    v += dpp_mov<0x124>(v);
    v += dpp_mov<0x128>(v);
    return v;
}
__device__ __forceinline__ float max16(float v) {
    v = fmaxf(v, dpp_mov<0xB1>(v)); v = fmaxf(v, dpp_mov<0x4E>(v)); v = fmaxf(v, dpp_mov<0x124>(v)); v = fmaxf(v, dpp_mov<0x128>(v));
    return v;
}
__device__ __forceinline__ float sum_q(float v) {
    float o; float a = xor16_get(v, o); v = a + o; a = xor32_get(v, o); return a + o;
}
__device__ __forceinline__ float max_q(float v) {
    float o; float a = xor16_get(v, o); v = fmaxf(a, o); a = xor32_get(v, o); return fmaxf(a, o);
}
__device__ __forceinline__ float sum_quad(float v) { v += dpp_mov<0xB1>(v); v += dpp_mov<0x4E>(v); return v; }
__device__ __forceinline__ float wave_sum(float v) { return sum_q(red16(v)); }
__device__ __forceinline__ float wave_max(float v) { return max_q(max16(v)); }
__device__ __forceinline__ float4 ldnt4(const float* p) { typedef float f4v __attribute__((ext_vector_type(4))); const f4v v = __builtin_nontemporal_load((const f4v*)p); return make_float4(v[0], v[1], v[2], v[3]); }
__device__ __forceinline__ float dot4(const float4& a, const float4& b) { return a.x * b.x + a.y * b.y + a.z * b.z + a.w * b.w; }
__device__ __forceinline__ float sigmoidf_(float x) { return 1.0f / (1.0f + __expf(-x)); }
__device__ __forceinline__ float siluf_(float x) { return x / (1.0f + __expf(-x)); }

__constant__ double ROPE_INV[8] = {1.0, 0.19392274474868576, 0.03760603093086393, 0.007292664737217109, 0.001414213562373095, 0.0002742481756762073, 5.318295896944988e-05, 1.031338537721246e-05};

struct Ctx {
    const Params* p;
    unsigned char* ws;
    float* out;
    unsigned char* lds;
    int tid, lane, wave, bid, G;
};
#define WSP(T, off) ((T*)(c.ws + (off)))

struct TileD { const float* src; bf16_t* dst; int ldsrc, c0, nvalid, k0, K, n0; };
constexpr int NT_GU = (DM / 64) * (NGU / 64), NT_DN = (DFF / 64) * (DM / 64), NT_IN = (DM / 64) * (NINP / 64), NT_OUT = (DM / 64) * (DM / 64);
constexpr int NT_ALL = 2 * NT_GU + 2 * NT_DN + NT_IN + NT_OUT;
__device__ __forceinline__ TileD tile_desc(const Ctx& c, int t) {
    TileD d;
    d.src = t < NT_GU ? c.p->in[9] : t < 2 * NT_GU ? c.p->in[33] : t < 2 * NT_GU + NT_DN ? c.p->in[10] : t < 2 * NT_GU + 2 * NT_DN ? c.p->in[34] : t < 2 * NT_GU + 2 * NT_DN + NT_IN ? c.p->in[12] : c.p->in[30];
    if (t < 2 * NT_GU) { const int w = t >= NT_GU; t -= w * NT_GU; const int nkt = DM / 64, kt = t % nkt, rr = (t / nkt) * 64;
         d.dst = (bf16_t*)(c.ws + (w ? WS_WGU2 : WS_WGU1)); d.ldsrc = NGU; d.c0 = ((rr % 256) / 128) * DFF + 128 * (rr / 256) + (rr % 128); d.nvalid = 64; d.k0 = kt * 64; d.K = DM; d.n0 = rr; return d; }
    t -= 2 * NT_GU;
    if (t < 2 * NT_DN) { const int w = t >= NT_DN; t -= w * NT_DN; const int nkt = DFF / 64, kt = t % nkt, nt = t / nkt;
         d.dst = (bf16_t*)(c.ws + (w ? WS_WDN2 : WS_WDN1)); d.ldsrc = DM; d.c0 = nt * 64; d.nvalid = 64; d.k0 = kt * 64; d.K = DFF; d.n0 = nt * 64; return d; }
    t -= 2 * NT_DN;
    if (t < NT_IN) { const int nkt = DM / 64, kt = t % nkt, nt = t / nkt; int nv = NIN - nt * 64; nv = nv < 0 ? 0 : (nv > 64 ? 64 : nv);
        d.dst = (bf16_t*)(c.ws + WS_WIN); d.ldsrc = NIN; d.c0 = nt * 64; d.nvalid = nv; d.k0 = kt * 64; d.K = DM; d.n0 = nt * 64; return d; }
    t -= NT_IN;
    { const int nkt = DM / 64, kt = t % nkt, nt = t / nkt;
        d.dst = (bf16_t*)(c.ws + WS_WOUT); d.ldsrc = DM; d.c0 = nt * 64; d.nvalid = 64; d.k0 = kt * 64; d.K = DM; d.n0 = nt * 64; return d; }
}
__device__ __forceinline__ void tile_load(const TileD& d, int tid, float4& a, float4& b) {
    const int k = tid >> 3, c8 = (tid & 7) * 8;
    const float* s0 = d.src + (size_t)d.k0 * d.ldsrc + (d.nvalid > 0 ? d.c0 : 0);
    const float* s = d.src + (size_t)(d.k0 + k) * d.ldsrc + d.c0 + c8;
    const float* sa = c8 < d.nvalid ? s : s0; const float* sb = c8 + 4 < d.nvalid ? s + 4 : s0;
    a = *(const float4*)sa; b = *(const float4*)sb;
}
__device__ __forceinline__ void convert_weights(const Ctx& c) {
    const int tid = c.tid;
    float* T0 = (float*)c.lds;
    float4 a0, b0, a1, b1, a2, b2, a3, b3;
    int par = 0;
#define CW_LOAD(av, bv, tt) { const int tc_ = (tt) < NT_ALL ? (tt) : NT_ALL - 1; const TileD dl_ = tile_desc(c, tc_); tile_load(dl_, tid, av, bv); }
#define CW_STEP(av, bv, tt) { const int te_ = (tt) < NT_ALL ? (tt) : NT_ALL - 1; const TileD d = tile_desc(c, te_); float* T = T0 + par * (64 * 65); \
        { const int k = tid >> 3, c8 = (tid & 7) * 8; float* tp = T + k * 65 + c8; const bool va_ = c8 < d.nvalid, vb_ = c8 + 4 < d.nvalid; \
          tp[0] = va_ ? av.x : 0.f; tp[1] = va_ ? av.y : 0.f; tp[2] = va_ ? av.z : 0.f; tp[3] = va_ ? av.w : 0.f; tp[4] = vb_ ? bv.x : 0.f; tp[5] = vb_ ? bv.y : 0.f; tp[6] = vb_ ? bv.z : 0.f; tp[7] = vb_ ? bv.w : 0.f; } \
        CW_LOAD(av, bv, (tt) + 4 * c.G) \
        __syncthreads(); \
        { const int kg = tid & 7, n = tid >> 3; unsigned w[4]; \
          _Pragma("unroll") for (int j = 0; j < 4; ++j) w[j] = pack2bf(T[(kg * 8 + 2 * j) * 65 + n], T[(kg * 8 + 2 * j + 1) * 65 + n]); \
          *(uint4*)(d.dst + (size_t)(d.n0 + n) * d.K + d.k0 + kg * 8) = make_uint4(w[0], w[1], w[2], w[3]); } \
        par ^= 1; }
    CW_LOAD(a0, b0, c.bid) CW_LOAD(a1, b1, c.bid + c.G) CW_LOAD(a2, b2, c.bid + 2 * c.G) CW_LOAD(a3, b3, c.bid + 3 * c.G)
#pragma unroll 1
    for (int t = c.bid; t < NT_ALL; t += 4 * c.G) {
        CW_STEP(a0, b0, t)
        CW_STEP(a1, b1, t + c.G)
        CW_STEP(a2, b2, t + 2 * c.G)
        CW_STEP(a3, b3, t + 3 * c.G)
    }
#undef CW_LOAD
#undef CW_STEP
    __syncthreads();
}

__device__ __forceinline__ void row_norm_bf16(const float* x, const float* g, bf16_t* a, int lane) {
    float4 v[8]; float ss = 0.f;
#pragma unroll
    for (int i = 0; i < 8; ++i) { v[i] = *(const float4*)(x + (i * 64 + lane) * 4); ss += dot4(v[i], v[i]); }
    ss = wave_sum(ss);
    const float s = rsqrtf(ss * (1.0f / DM) + RMS_EPS);
#pragma unroll
    for (int i = 0; i < 8; ++i) { const float4 gg = *(const float4*)(g + (i * 64 + lane) * 4);
        *(uint2*)(a + (i * 64 + lane) * 4) = make_uint2(pack2bf(v[i].x * s * gg.x, v[i].y * s * gg.y), pack2bf(v[i].z * s * gg.z, v[i].w * s * gg.w)); }
}

__device__ __forceinline__ const float* x_row(const Ctx& c, int row) { return row < NPR ? c.p->in[0] + (size_t)row * DM : c.p->in[1] + (size_t)(row - NPR) * DM; }

__device__ __forceinline__ void p0_prologue(const Ctx& c) {
    convert_weights(c);
#pragma unroll 1
    for (int r = c.bid * NWAVES + c.wave; r < NR; r += c.G * NWAVES)
        row_norm_bf16(x_row(c, r), c.p->in[7], WSP(bf16_t, WS_A1) + (size_t)r * DM, c.lane);
#pragma unroll 1
    for (int e = c.bid * NTHREADS + c.tid; e < 4096 * 8; e += c.G * NTHREADS) {
        const int pos = e >> 3, i = e & 7;
        const double inv = ROPE_INV[i];
        double rev = (double)pos * inv * 0.15915494309189535;
        rev -= floor(rev);
        const float a = (float)(rev * 6.283185307179586);
        float* rt = WSP(float, WS_ROPE) + pos * 16;
        rt[i] = cosf(a); rt[8 + i] = sinf(a);
    }
#pragma unroll 1
    for (int e = c.bid * NTHREADS + c.tid; e < 2 * 16 * 256 * 64; e += c.G * NTHREADS) {
        const int d = e & 63, n = (e >> 6) & 255, sl = (e >> 14) & 15, kv = e >> 18, hf = n >> 7, h = n & 127;
        WSP(bf16_t, WS_W1T)[e] = f2bf(c.p->in[kv ? 17 : 14][((size_t)(hf * 16 + sl) * 64 + d) * 128 + h]);
    }
#pragma unroll 1
    for (int e = c.bid * NTHREADS + c.tid; e < 2 * 64 * 128; e += c.G * NTHREADS) {
        const int h = e & 127, dd = (e >> 7) & 63, kv = e >> 13;
        WSP(bf16_t, WS_W2T)[e] = f2bf(c.p->in[kv ? 18 : 15][h * 64 + dd]);
    }
#pragma unroll 1
    for (int o = c.bid * NWAVES + c.wave; o < 256; o += c.G * NWAVES) {
        const int kv = o >> 7, h = o & 127; const float* pe = c.p->in[kv ? 16 : 13]; const float* w1 = c.p->in[kv ? 17 : 14];
        float s = 0.f;
#pragma unroll
        for (int i = 0; i < 32; ++i) { const int k = i * 64 + c.lane; s += pe[k] * w1[(size_t)k * 128 + h]; }
        s = wave_sum(s);
        if (c.lane == 0) WSP(float, WS_PET)[o] = s;
    }
#pragma unroll 1
    for (int e = c.bid * NTHREADS + c.tid; e < 1024 * 64; e += c.G * NTHREADS) { const int k = e & 63, n = e >> 6;
        WSP(bf16_t, WS_LW2T)[e] = f2bf(c.p->in[21][k * 1024 + n]); WSP(bf16_t, WS_LA2T)[e] = f2bf(c.p->in[23][k * 1024 + n]); }
#pragma unroll 1
    for (int e = c.bid * NTHREADS + c.tid; e < 1024 * 160; e += c.G * NTHREADS) { const int k = e % 160, n = e / 160;
        WSP(bf16_t, WS_LG2T)[e] = f2bf(c.p->in[24][k * 1024 + n]); }
}

struct ThinRow { float4 v[8]; float ss; };
__device__ __forceinline__ void thin_load(const Ctx& c, ThinRow& t, const float* O, int nsplit, int r) {
    t.ss = 0.f;
#pragma unroll
    for (int i = 0; i < 8; ++i) {
        if (r < NPR) { const uint2 w = *(const uint2*)((const bf16_t*)O + (size_t)r * DM + (i * 64 + c.lane) * 4);
            t.v[i] = make_float4(__uint_as_float(w.x << 16), __uint_as_float(w.x & 0xffff0000u), __uint_as_float(w.y << 16), __uint_as_float(w.y & 0xffff0000u)); }
        else { const float* os = WSP(const float, WS_OS) + (size_t)(r - NPR) * DM + (i * 64 + c.lane) * 4; float4 a = *(const float4*)os;
            for (int sp = 1; sp < nsplit; ++sp) { const float4 x = *(const float4*)(os + (size_t)sp * 256 * DM); a.x += x.x; a.y += x.y; a.z += x.z; a.w += x.w; }
            t.v[i] = a; }
        t.ss += dot4(t.v[i], t.v[i]); }
}
__device__ __forceinline__ void thin_finish(const Ctx& c, ThinRow& t, int r, int base_kind, const float* gpost, float scale, float* hout, const float* gpre, bf16_t* aout) {
    const float* bs = base_kind == 0 ? x_row(c, r) : (base_kind == 1 ? WSP(const float, WS_H1) : WSP(const float, WS_H2)) + (size_t)r * DM;
    float4 b[8];
#pragma unroll
    for (int i = 0; i < 8; ++i) b[i] = *(const float4*)(bs + (i * 64 + c.lane) * 4);
    const float ss = wave_sum(t.ss);
    const float s = rsqrtf(ss * (1.0f / DM) + RMS_EPS) * scale;
    float s2 = 0.f;
#pragma unroll
    for (int i = 0; i < 8; ++i) { const float4 gg = *(const float4*)(gpost + (i * 64 + c.lane) * 4);
        t.v[i].x = b[i].x + t.v[i].x * s * gg.x; t.v[i].y = b[i].y + t.v[i].y * s * gg.y; t.v[i].z = b[i].z + t.v[i].z * s * gg.z; t.v[i].w = b[i].w + t.v[i].w * s * gg.w;
        *(float4*)(hout + (size_t)r * DM + (i * 64 + c.lane) * 4) = t.v[i]; s2 += dot4(t.v[i], t.v[i]); }
    if (aout) {
        s2 = wave_sum(s2);
        const float q = rsqrtf(s2 * (1.0f / DM) + RMS_EPS);
#pragma unroll
        for (int i = 0; i < 8; ++i) { const float4 gg = *(const float4*)(gpre + (i * 64 + c.lane) * 4);
            *(uint2*)(aout + (size_t)r * DM + (i * 64 + c.lane) * 4) = make_uint2(pack2bf(t.v[i].x * q * gg.x, t.v[i].y * q * gg.y), pack2bf(t.v[i].z * q * gg.z, t.v[i].w * q * gg.w)); }
    }
}
__device__ __forceinline__ float block_sum(const Ctx& c, float v, float* red) {
    v = wave_sum(v);
    __syncthreads();
    if (c.lane == 0) red[c.wave] = v;
    __syncthreads();
    return ((red[0] + red[1]) + (red[2] + red[3])) + ((red[4] + red[5]) + (red[6] + red[7]));
}
__device__ __forceinline__ void thin_norm(const Ctx& c, const float* O, int nsplit  , int base_kind  , const float* gpost, float scale, float* hout, const float* gpre, bf16_t* aout) {
    const int stride = c.G * NWAVES;
#pragma unroll 1
    for (int r = c.bid * NWAVES + c.wave; r < NPR; r += 2 * stride) {
        const int r2 = r + stride; const bool two = r2 < NPR;
        ThinRow t0, t1;
        thin_load(c, t0, O, nsplit, r);
        if (two) thin_load(c, t1, O, nsplit, r2);
        thin_finish(c, t0, r, base_kind, gpost, scale, hout, gpre, aout);
        if (two) thin_finish(c, t1, r2, base_kind, gpost, scale, hout, gpre, aout);
    }
    if (c.bid < NSM) {
        const int r = NPR + c.bid, col = c.tid * 4;
        float* red = (float*)c.lds;
        const float* os = WSP(const float, WS_OS) + (size_t)c.bid * DM + col;
        float4 a = *(const float4*)os;
        for (int sp = 1; sp < nsplit; ++sp) { const float4 x = *(const float4*)(os + (size_t)sp * 256 * DM); a.x += x.x; a.y += x.y; a.z += x.z; a.w += x.w; }
        const float* bs = base_kind == 0 ? x_row(c, r) : (base_kind == 1 ? WSP(const float, WS_H1) : WSP(const float, WS_H2)) + (size_t)r * DM;
        const float4 b = *(const float4*)(bs + col), gg = *(const float4*)(gpost + col);
        const float ss = block_sum(c, dot4(a, a), red);
        const float sc = rsqrtf(ss * (1.0f / DM) + RMS_EPS) * scale;
        float4 h; h.x = b.x + a.x * sc * gg.x; h.y = b.y + a.y * sc * gg.y; h.z = b.z + a.z * sc * gg.z; h.w = b.w + a.w * sc * gg.w;
        *(float4*)(hout + (size_t)r * DM + col) = h;
        if (aout) {
            const float s2 = block_sum(c, dot4(h, h), red);
            const float q = rsqrtf(s2 * (1.0f / DM) + RMS_EPS);
            const float4 gp = *(const float4*)(gpre + col);
            *(uint2*)(aout + (size_t)r * DM + col) = make_uint2(pack2bf(h.x * q * gp.x, h.y * q * gp.y), pack2bf(h.z * q * gp.z, h.w * q * gp.w));
        }
    }
}

__device__ __forceinline__ int row_pos(int row) { return row < NPR ? (row & (SEQ - 1)) : PAST; }

__device__ __forceinline__ float rope_elem(const float* h16, const float* cs, int d) {
    return d < 8 ? h16[d] * cs[d] - h16[d + 8] * cs[8 + d] : h16[d] * cs[d - 8] + h16[d - 8] * cs[d];
}

constexpr float QSCALE = 0.18033688011112042f;
__device__ __forceinline__ float4 rope4(float4 x, int c16, float4 cs4, float4 sn4) {
    float4 p; p.x = dpp_mov<0x4E>(x.x); p.y = dpp_mov<0x4E>(x.y); p.z = dpp_mov<0x4E>(x.z); p.w = dpp_mov<0x4E>(x.w);
    const float sg = (c16 & 2) ? 1.0f : -1.0f; const bool rot = c16 < 4;
    float4 o;
    o.x = rot ? x.x * cs4.x + sg * p.x * sn4.x : x.x; o.y = rot ? x.y * cs4.y + sg * p.y * sn4.y : x.y;
    o.z = rot ? x.z * cs4.z + sg * p.z * sn4.z : x.z; o.w = rot ? x.w * cs4.w + sg * p.w * sn4.w : x.w;
    return o;
}
__device__ __forceinline__ uint2 bf4(float4 v, float sc) { return make_uint2(pg8::cvt_pk_bf16(v.x * sc, v.y * sc), pg8::cvt_pk_bf16(v.z * sc, v.w * sc)); }
__device__ __forceinline__ void p5a_nsa_prep(const Ctx& c, int grp) {
    const float* COLS = WSP(const float, WS_COLS);
    const float* ROPE = WSP(const float, WS_ROPE);
    const int lane = c.lane, c16 = lane & 15;
#pragma unroll 1
    for (int row = grp * 32 + c.wave * 4; row < grp * 32 + c.wave * 4 + 4; ++row) {
        const float* cr = COLS + (size_t)row * NINP;
        const int pos = row_pos(row);
        const float4 cs4 = *(const float4*)(ROPE + pos * 16 + 4 * (c16 & 1)), sn4 = *(const float4*)(ROPE + pos * 16 + 8 + 4 * (c16 & 1));
        float* kvo = c.out + O_KV + (size_t)row * 1024;
        const bool pr = row < NPR;
        const float4 q0 = *(const float4*)(cr + lane * 4), q1 = *(const float4*)(cr + (lane + 64) * 4), q2 = *(const float4*)(cr + (lane + 128) * 4), q3 = *(const float4*)(cr + (lane + 192) * 4);
        const float4 kc = *(const float4*)(cr + 1024 + lane * 4), vc = *(const float4*)(cr + 1280 + lane * 4), ksv = *(const float4*)(cr + 1536 + lane * 4),
                     vs = *(const float4*)(cr + 1792 + lane * 4), kwv = *(const float4*)(cr + 2048 + lane * 4), vw = *(const float4*)(cr + 2304 + lane * 4);
        const float4 r0 = rope4(q0, c16, cs4, sn4), r1 = rope4(q1, c16, cs4, sn4), r2 = rope4(q2, c16, cs4, sn4), r3 = rope4(q3, c16, cs4, sn4);
        const float4 ksr = rope4(ksv, c16, cs4, sn4), kwr = rope4(kwv, c16, cs4, sn4);
        *(float4*)(kvo + lane * 4) = kc; *(float4*)(kvo + 256 + lane * 4) = vc; *(float4*)(kvo + 512 + lane * 4) = ksr; *(float4*)(kvo + 768 + lane * 4) = vs;
        if (pr) {
            bf16_t* qrb = WSP(bf16_t, WS_QRB) + (size_t)row * 1024 + lane * 4; bf16_t* qsb = WSP(bf16_t, WS_QSB) + (size_t)row * 1024 + lane * 4;
            *(uint2*)(qrb) = bf4(q0, QSCALE); *(uint2*)(qrb + 256) = bf4(q1, QSCALE); *(uint2*)(qrb + 512) = bf4(q2, QSCALE); *(uint2*)(qrb + 768) = bf4(q3, QSCALE);
            *(uint2*)(qsb) = bf4(r0, QSCALE); *(uint2*)(qsb + 256) = bf4(r1, QSCALE); *(uint2*)(qsb + 512) = bf4(r2, QSCALE); *(uint2*)(qsb + 768) = bf4(r3, QSCALE);
            *(uint2*)(WSP(bf16_t, WS_KSB) + (size_t)row * 256 + lane * 4) = bf4(ksr, 1.0f); *(uint2*)(WSP(bf16_t, WS_VSB) + (size_t)row * 256 + lane * 4) = bf4(vs, 1.0f);
            *(uint2*)(WSP(bf16_t, WS_KWB) + (size_t)row * 256 + lane * 4) = bf4(kwr, 1.0f); *(uint2*)(WSP(bf16_t, WS_VWB) + (size_t)row * 256 + lane * 4) = bf4(vw, 1.0f);
            const int t = row & (SEQ - 1), b = row >> 12;
            if (t >= SEQ - 512) { float* wo = c.out + O_WINP + ((size_t)b * 512 + (t - (SEQ - 512))) * 512; *(float4*)(wo + lane * 4) = kwr; *(float4*)(wo + 256 + lane * 4) = vw; }
        } else {
            float* qra = WSP(float, WS_QRAW) + (size_t)row * 1024 + lane * 4; float* qro = WSP(float, WS_QROT) + (size_t)row * 1024 + lane * 4;
            *(float4*)(qra) = q0; *(float4*)(qra + 256) = q1; *(float4*)(qra + 512) = q2; *(float4*)(qra + 768) = q3;
            *(float4*)(qro) = r0; *(float4*)(qro + 256) = r1; *(float4*)(qro + 512) = r2; *(float4*)(qro + 768) = r3;
            float* kw = WSP(float, WS_KW) + (size_t)row * 512; *(float4*)(kw + lane * 4) = kwr; *(float4*)(kw + 256 + lane * 4) = vw;
            float* wo = c.out + O_WINS + ((size_t)(row - NPR) * 512 + 511) * 512; *(float4*)(wo + lane * 4) = kwr; *(float4*)(wo + 256 + lane * 4) = vw;
        }
        if (lane < 12) { const float4 gl = *(const float4*)(cr + 2560 + lane * 4);
            *(float4*)(WSP(float, WS_GATE) + (size_t)row * 48 + lane * 4) = make_float4(sigmoidf_(gl.x), sigmoidf_(gl.y), sigmoidf_(gl.z), sigmoidf_(gl.w)); }
        float* so = nullptr;
        if (!pr) so = c.out + O_SHS + (size_t)(row - NPR) * RWC; else if ((row & (SEQ - 1)) == SEQ - 1) so = c.out + O_SHP + (size_t)(row >> 12) * RWC;
        if (so) {
            const float* sp = cr + NSAC + lane * 4; float* dp = so + lane * 4;
            float4 t0, t1, t2, t3, t4, t5, t6, t7, t8, t9, t10, t11, t12, t13;
            t0 = *(const float4*)(sp); t1 = *(const float4*)(sp + 256); t2 = *(const float4*)(sp + 512); t3 = *(const float4*)(sp + 768); t4 = *(const float4*)(sp + 1024);
            t5 = *(const float4*)(sp + 1280); t6 = *(const float4*)(sp + 1536); t7 = *(const float4*)(sp + 1792); t8 = *(const float4*)(sp + 2048); t9 = *(const float4*)(sp + 2304);
            t10 = *(const float4*)(sp + 2560); t11 = *(const float4*)(sp + 2816); t12 = *(const float4*)(sp + 3072); t13 = *(const float4*)(sp + (lane < 8 ? 3328 : 3072));
            *(float4*)(dp) = t0; *(float4*)(dp + 256) = t1; *(float4*)(dp + 512) = t2; *(float4*)(dp + 768) = t3; *(float4*)(dp + 1024) = t4; *(float4*)(dp + 1280) = t5; *(float4*)(dp + 1536) = t6;
            *(float4*)(dp + 1792) = t7; *(float4*)(dp + 2048) = t8; *(float4*)(dp + 2304) = t9; *(float4*)(dp + 2560) = t10; *(float4*)(dp + 2816) = t11; *(float4*)(dp + 3072) = t12;
            if (lane < 8) *(float4*)(dp + 3328) = t13;
        }
    }
}

__device__ __forceinline__ void p5b_rwkv_prep(const Ctx& c) {
    const float* COLS = WSP(const float, WS_COLS);
    float* RW = WSP(float, WS_RW); float* V = WSP(float, WS_V); float* Gt = WSP(float, WS_G); float* BON = WSP(float, WS_BON);
    const float* mu = c.p->in[19]; const float* w0 = c.p->in[20]; const float* w2 = c.p->in[21]; const float* a0 = c.p->in[22]; const float* a2 = c.p->in[23];
    const float* g2 = c.p->in[24]; const float* kkw = c.p->in[25]; const float* kaw = c.p->in[26]; const float* rk = c.p->in[27];
    float* L = (float*)c.lds;
    constexpr int RG = 8;
#pragma unroll 1
    for (int it = c.bid; it < NR / RG; it += c.G) {
        const int row0 = it * RG;
        __syncthreads();
        for (int e = c.tid; e < RG * 288; e += NTHREADS) {
            const int r = e / 288, k = e % 288, row = row0 + r, col = 3072 + k;
            const float cur = COLS[(size_t)row * NINP + NSAC + col];
            float prev;
            if (row >= NPR) prev = c.p->in[6][(size_t)(row - NPR) * RWC + col];
            else prev = (row & (SEQ - 1)) == 0 ? 0.f : COLS[(size_t)(row - 1) * NINP + NSAC + col];
            const float xs = cur + (prev - cur) * mu[col];
            L[e] = k < 64 ? tanhf(xs) : (k < 128 ? xs : sigmoidf_(xs));
        }
        __syncthreads();
        float aw[RG][2], aa[RG][2], ag[RG][2];
#pragma unroll
        for (int r = 0; r < RG; ++r) { aw[r][0] = aw[r][1] = aa[r][0] = aa[r][1] = ag[r][0] = ag[r][1] = 0.f; }
        const int n0 = c.tid, n1 = c.tid + 512;
#pragma unroll 4
        for (int k = 0; k < 64; ++k) { const float x0 = w2[k * 1024 + n0], x1 = w2[k * 1024 + n1];
#pragma unroll
            for (int r = 0; r < RG; ++r) { const float l = L[r * 288 + k]; aw[r][0] += l * x0; aw[r][1] += l * x1; } }
#pragma unroll 4
        for (int k = 0; k < 64; ++k) { const float x0 = a2[k * 1024 + n0], x1 = a2[k * 1024 + n1];
#pragma unroll
            for (int r = 0; r < RG; ++r) { const float l = L[r * 288 + 64 + k]; aa[r][0] += l * x0; aa[r][1] += l * x1; } }
#pragma unroll 4
        for (int k = 0; k < 160; ++k) { const float x0 = g2[k * 1024 + n0], x1 = g2[k * 1024 + n1];
#pragma unroll
            for (int r = 0; r < RG; ++r) { const float l = L[r * 288 + 128 + k]; ag[r][0] += l * x0; ag[r][1] += l * x1; } }
#pragma unroll
        for (int r = 0; r < RG; ++r) {
            const int row = row0 + r;
            const float* cr = COLS + (size_t)row * NINP + NSAC;
            const bool first = row < NPR && (row & (SEQ - 1)) == 0;
            const float* pr = row >= NPR ? c.p->in[6] + (size_t)(row - NPR) * RWC : (cr - NINP);
#pragma unroll
            for (int j = 0; j < 2; ++j) {
                const int n = j == 0 ? n0 : n1;
                float xr, xk, xv;
                { const float cu = cr[n], p = first ? 0.f : pr[n]; xr = cu + (p - cu) * mu[n]; }
                { const float cu = cr[1024 + n], p = first ? 0.f : pr[1024 + n]; xk = cu + (p - cu) * mu[1024 + n]; }
                { const float cu = cr[2048 + n], p = first ? 0.f : pr[2048 + n]; xv = cu + (p - cu) * mu[2048 + n]; }
                const float wl = w0[n] + aw[r][j];
                const float nx = -wl; const float sp = fmaxf(nx, 0.f) + log1pf(__expf(-fabsf(nx)));
                const float wlog = -sp - 0.5f;
                const float decay = __expf(-__expf(wlog));
                const float a = sigmoidf_(a0[n] + aa[r][j]);
                const float g = ag[r][j];
                const float kkr = xk * kkw[n];
                const float ssq = wave_sum(kkr * kkr);
                const float kkn = kkr / fmaxf(sqrtf(ssq), 1e-12f);
                const float km = xk * (1.0f + (a - 1.0f) * kaw[n]);
                const float bs = wave_sum(xr * km * rk[n]);
                float* rw = RW + (size_t)row * 5 * 1024;
                rw[n] = xr; rw[1024 + n] = decay; rw[2048 + n] = km; rw[3072 + n] = kkn; rw[4096 + n] = kkn * a;
                V[(size_t)row * 1024 + n] = xv; Gt[(size_t)row * 1024 + n] = g;
                if (c.lane == 0) BON[(size_t)row * 16 + (n >> 6)] = bs;
            }
        }
    }
}

__device__ __forceinline__ void p5c_compress(const Ctx& c) {
    float* X = (float*)c.lds;
    float* HID = X + 80 * 256;
    const int tid = c.tid;
    const int n_items_p = 2 * 64, n_items_s = NSM * 32;
#pragma unroll 1
    for (int it = c.bid; it < n_items_p + n_items_s; it += c.G) {
        const bool smp = it >= n_items_p;
        const int b = smp ? (it - n_items_p) >> 5 : it >> 6;
        const int n0 = smp ? ((it - n_items_p) & 31) * 4 : (it & 63) * 4;
        const int nc = smp ? NCS : NCP;
        const int nb = (nc - n0) < 4 ? (nc - n0) : 4;
        const int nrows = 16 * (nb - 1) + 32;
#pragma unroll 1
        for (int kv = 0; kv < 2; ++kv) {
            const float* pe = c.p->in[kv == 0 ? 13 : 16]; const float* w1 = c.p->in[kv == 0 ? 14 : 17]; const float* w2 = c.p->in[kv == 0 ? 15 : 18];
            __syncthreads();
            for (int e = tid; e < nrows * 64; e += NTHREADS) {
                const int r = e >> 6, q4 = (e & 63) * 4; const int tok = 16 * n0 + r;
                const float* src;
                if (smp) { const int page = ((const int*)c.p->in[3])[b * NPAGES + (tok >> 7)]; src = c.p->in[2] + ((size_t)page * PAGE + (tok & 127)) * 1024 + kv * 256 + q4; }
                else src = WSP(const float, WS_COLS) + (size_t)(b * SEQ + tok) * NINP + 1024 + kv * 256 + q4;
                *(float4*)(X + r * 256 + q4) = *(const float4*)src;
            }
            __syncthreads();
            {
                const int kvh = tid >> 7, h = tid & 127;
                float acc[4] = {0.f, 0.f, 0.f, 0.f};
#pragma unroll 1
                for (int l = 0; l < 32; ++l) {
#pragma unroll 8
                    for (int d = 0; d < 64; ++d) {
                        const float w = w1[(l * 64 + d) * 128 + h], pv = pe[l * 64 + d];
#pragma unroll
                        for (int q = 0; q < 4; ++q) acc[q] += (X[(16 * q + l) * 256 + kvh * 64 + d] + pv) * w;
                    }
                }
#pragma unroll
                for (int q = 0; q < 4; ++q) HID[(q * 4 + kvh) * 128 + h] = siluf_(acc[q]);
            }
            __syncthreads();
            {
#pragma unroll
                for (int j = 0; j < 2; ++j) {
                    const int o = tid + j * 512; const int q = o >> 8, kvh = (o >> 6) & 3, dd = o & 63;
                    float s = 0.f;
#pragma unroll 8
                    for (int h = 0; h < 128; ++h) s += HID[(q * 4 + kvh) * 128 + h] * w2[h * 64 + dd];
                    if (q < nb) {
                        if (smp) WSP(float, kv == 0 ? WS_KCS : WS_VCS)[((size_t)b * 128 + n0 + q) * 256 + kvh * 64 + dd] = s;
                        else WSP(bf16_t, kv == 0 ? WS_KCB : WS_VCB)[((size_t)b * 256 + n0 + q) * 256 + kvh * 64 + dd] = f2bf(s);
                    } else if (!smp && n0 + q == 255) WSP(bf16_t, kv == 0 ? WS_KCB : WS_VCB)[((size_t)b * 256 + 255) * 256 + kvh * 64 + dd] = 0;
                }
            }
        }
    }
}

typedef short bf16x8_t __attribute__((ext_vector_type(8)));
typedef float f32x4_t __attribute__((ext_vector_type(4)));
#define MFMA16(a, b, c) __builtin_amdgcn_mfma_f32_16x16x32_bf16((a), (b), (c), 0, 0, 0)
constexpr int AT_LD = 72;
constexpr int AT_TILE = 64 * AT_LD;
constexpr int AT_OFF_K = 0, AT_OFF_V = 2 * AT_TILE * 2, AT_OFF_MSK = 4 * AT_TILE * 2, AT_OFF_SCO = AT_OFF_MSK + 512;

struct AtStage { uint4 k, v; };
__device__ __forceinline__ void at_load(AtStage& s, const bf16_t* kb, const bf16_t* vb, int row0, int tid) {
    const int key = tid >> 3, dc = tid & 7;
    s.k = *(const uint4*)(kb + (size_t)(row0 + key) * 256 + dc * 8);
    s.v = *(const uint4*)(vb + (size_t)(row0 + key) * 256 + dc * 8);
}
constexpr int AT_VDH = 4096 + 64;
typedef short at_v4i16 __attribute__((ext_vector_type(4)));
__device__ __forceinline__ at_v4i16 at_vtr(const unsigned char* p) { return __builtin_amdgcn_ds_read_tr16_b64_v4i16((__attribute__((address_space(3))) at_v4i16*)p); }
__device__ __forceinline__ void at_store(const AtStage& s, bf16_t* KT, bf16_t* VT, int tid) {
    const int key = tid >> 3, dc = tid & 7;
    *(uint4*)(KT + key * AT_LD + dc * 8) = s.k;
    *(uint4*)((unsigned char*)VT + (dc >> 2) * AT_VDH + key * 64 + (((dc & 3) * 16) ^ (((key >> 3) & 1) * 32))) = make_uint4(s.v.x, s.v.y, s.v.z, s.v.w);
}

__device__ __forceinline__ void at_scores(const bf16_t* KT, const bf16x8_t (&qf)[2], f32x4_t (&S)[2][2], const f32x4_t& nref4, int r, int q) {
    bf16x8_t a[2][2][2];
#pragma unroll
    for (int kg = 0; kg < 2; ++kg)
#pragma unroll
        for (int kt = 0; kt < 2; ++kt) {
            const int krow = 32 * kg + 8 * (r >> 2) + 4 * kt + (r & 3);
            a[kg][kt][0] = *(const bf16x8_t*)(KT + krow * AT_LD + q * 8); a[kg][kt][1] = *(const bf16x8_t*)(KT + krow * AT_LD + 32 + q * 8);
        }
    __builtin_amdgcn_sched_barrier(0);
#pragma unroll
    for (int kg = 0; kg < 2; ++kg)
#pragma unroll
        for (int kt = 0; kt < 2; ++kt) S[kg][kt] = MFMA16(a[kg][kt][1], qf[1], MFMA16(a[kg][kt][0], qf[0], nref4));
}
template <int MODE  >
__device__ __forceinline__ void at_update(const bf16_t* VT, f32x4_t (&S)[2][2], f32x4_t (&O)[4], f32x4_t& L, f32x4_t& nref4, bool& seen, int keybase, int lo, int hi, int r, int q) {
    const int vb0 = (8 * q + (r >> 2)) * 64 + ((8 * (r & 3)) ^ ((q & 1) * 32));
    const unsigned char* vp0 = (const unsigned char*)VT + vb0; const int vsw = (vb0 ^ 32) - vb0;
    bf16x8_t va[4][2];
#pragma unroll
    for (int dt = 0; dt < 4; ++dt)
#pragma unroll
        for (int kg = 0; kg < 2; ++kg) { const unsigned char* ap = vp0 + (dt >> 1) * AT_VDH + (dt & 1) * vsw + 32 * kg * 64;
            const at_v4i16 lo = at_vtr(ap), hi = at_vtr(ap + 4 * 64);
            va[dt][kg] = __builtin_shufflevector(lo, hi, 0, 1, 2, 3, 4, 5, 6, 7); }
    __builtin_amdgcn_sched_barrier(0);
    const int rhi = hi - keybase - 8 * q, rlo = lo - keybase - 8 * q;
    const bool on = hi >= 0;
    float mx = -3.0e38f;
#pragma unroll
    for (int kg = 0; kg < 2; ++kg)
#pragma unroll
        for (int kt = 0; kt < 2; ++kt)
#pragma unroll
            for (int i = 0; i < 4; ++i) {
                const int o = 32 * kg + 4 * kt + i;
                if (MODE == 1) S[kg][kt][i] = on ? S[kg][kt][i] : -3.0e38f;
                if (MODE == 2) S[kg][kt][i] = (o <= rhi) ? S[kg][kt][i] : -3.0e38f;
                if (MODE == 3) S[kg][kt][i] = (o <= rhi && o >= rlo) ? S[kg][kt][i] : -3.0e38f;
                mx = fmaxf(mx, S[kg][kt][i]); }
    mx = max_q(mx);
    const bool valid = mx > -1.0e30f;
    const bool need = valid && (!seen || mx > 24.0f);
    if (__any(need)) {
        const float d = need ? mx : 0.0f, sc = __builtin_amdgcn_exp2f(-d);
#pragma unroll
        for (int kg = 0; kg < 2; ++kg)
#pragma unroll
            for (int kt = 0; kt < 2; ++kt)
#pragma unroll
                for (int i = 0; i < 4; ++i) S[kg][kt][i] -= d;
#pragma unroll
        for (int dt = 0; dt < 4; ++dt) O[dt] *= sc;
        L *= sc;
        nref4 -= d;
    }
    seen = seen || valid;
    bf16x8_t pb[2];
#pragma unroll
    for (int kg = 0; kg < 2; ++kg) {
        float p[8];
#pragma unroll
        for (int kt = 0; kt < 2; ++kt)
#pragma unroll
            for (int i = 0; i < 4; ++i) p[kt * 4 + i] = __builtin_amdgcn_exp2f(S[kg][kt][i]);
        uint4 w; w.x = pg8::cvt_pk_bf16(p[0], p[1]); w.y = pg8::cvt_pk_bf16(p[2], p[3]); w.z = pg8::cvt_pk_bf16(p[4], p[5]); w.w = pg8::cvt_pk_bf16(p[6], p[7]);
        pb[kg] = __builtin_bit_cast(bf16x8_t, w);
    }
    const unsigned ow = (r == 0) ? 0x3F803F80u : 0u;
    const bf16x8_t ones = __builtin_bit_cast(bf16x8_t, make_uint4(ow, ow, ow, ow));
    L = MFMA16(ones, pb[1], MFMA16(ones, pb[0], L));
#pragma unroll
    for (int dt = 0; dt < 4; ++dt) {
        f32x4_t o = O[dt];
#pragma unroll
        for (int kg = 0; kg < 2; ++kg) o = MFMA16(va[dt][kg], pb[kg], o);
        O[dt] = o;
    }
}
__device__ __forceinline__ float at_rowsum(const f32x4_t& L, int q) { return sum_q(q == 0 ? L[0] : 0.0f); }
__device__ __forceinline__ void at_finish(f32x4_t (&OUT)[4], f32x4_t (&O)[4], f32x4_t& L, f32x4_t& nref4, bool& seen, float gate, int q) {
    const float l = at_rowsum(L, q);
    const float f = l > 0.f ? gate / l : 0.f;
#pragma unroll
    for (int dt = 0; dt < 4; ++dt) { OUT[dt] += O[dt] * f; O[dt] = (f32x4_t){0.f, 0.f, 0.f, 0.f}; }
    L = (f32x4_t){0.f, 0.f, 0.f, 0.f}; nref4 = (f32x4_t){0.f, 0.f, 0.f, 0.f}; seen = false;
}

#ifndef PROBE_T
#define PROBE_T -1
#endif
#define PSEC(k, x) do { if (PROBE_T == (k) && pacc) { x; } } while (0)
__device__ __forceinline__ void nsa_tile_mfma(const Ctx& c, int item, unsigned long long* pacc = nullptr) {
    const int tile = 127 - (item >> 3), bk = item & 7, b = bk >> 2, kvh = bk & 3;
    const int s0 = tile * 32;
    int tid = c.tid; asm volatile("" : "+v"(tid));
    const int lane = tid & 63, wave = c.wave, r = lane & 15, q = lane >> 4;
    bf16_t* KT = (bf16_t*)(c.lds + AT_OFF_K); bf16_t* VT = (bf16_t*)(c.lds + AT_OFF_V);
    unsigned long long* MSK = (unsigned long long*)(c.lds + AT_OFF_MSK);
    float* SCO = (float*)(c.lds + AT_OFF_SCO) + wave * 256;
    const int tokl = 4 * wave + (r >> 2), g = r & 3;
    const int t = s0 + tokl;
    const size_t trow = (size_t)b * SEQ + t;
    const size_t rb = (size_t)b * SEQ;
    bf16x8_t qr[2], qs[2];
#pragma unroll
    for (int ks = 0; ks < 2; ++ks) { qr[ks] = *(const bf16x8_t*)(WSP(const bf16_t, WS_QRB) + trow * 1024 + (kvh * 4 + g) * 64 + ks * 32 + q * 8);
                                     qs[ks] = *(const bf16x8_t*)(WSP(const bf16_t, WS_QSB) + trow * 1024 + (kvh * 4 + g) * 64 + ks * 32 + q * 8); }
    const float* gate = WSP(const float, WS_GATE) + trow * 48 + (kvh * 4 + g) * 3;
    const float g0 = gate[0], g1 = gate[1], g2 = gate[2];
    f32x4_t OUT[4], O[4];
#pragma unroll
    for (int dt = 0; dt < 4; ++dt) { OUT[dt] = (f32x4_t){0.f, 0.f, 0.f, 0.f}; O[dt] = (f32x4_t){0.f, 0.f, 0.f, 0.f}; }
    f32x4_t L = {0.f, 0.f, 0.f, 0.f}, nref4 = {0.f, 0.f, 0.f, 0.f}; bool seen = false;
    AtStage st;
    __syncthreads();
    unsigned long long pt_ = 0; PSEC(201, pt_ = wall_clock64());

    const int ntc = (s0 / 16 + 1 + 63) >> 6;
    const int ncr = t >= 31 ? (t - 31) / 16 + 1 : 0;
    f32x4_t SC[4][2][2];
#pragma unroll
    for (int ti = 0; ti < 4; ++ti)
#pragma unroll
        for (int kg = 0; kg < 2; ++kg)
#pragma unroll
            for (int kt = 0; kt < 2; ++kt) SC[ti][kg][kt] = (f32x4_t){0.f, 0.f, 0.f, 0.f};
    {
        const bf16_t* kb = WSP(const bf16_t, WS_KCB) + (size_t)b * 256 * 256 + kvh * 64; const bf16_t* vb = WSP(const bf16_t, WS_VCB) + (size_t)b * 256 * 256 + kvh * 64;
        AtStage c1, c2, c3;
        at_load(st, kb, vb, 0, tid);
        at_load(c1, kb, vb, (1 < ntc ? 1 : ntc - 1) * 64, tid); at_load(c2, kb, vb, (2 < ntc ? 2 : ntc - 1) * 64, tid); at_load(c3, kb, vb, (3 < ntc ? 3 : ntc - 1) * 64, tid);
        at_store(st, KT, VT, tid); __syncthreads();
#define AT_CMP_STEP(ti, nslot) \
            if ((ti) < ntc) { \
                f32x4_t S2[2][2]; \
                at_scores(KT + ((ti) & 1) * AT_TILE, qr, S2, nref4, r, q); \
                _Pragma("unroll") for (int kg = 0; kg < 2; ++kg) _Pragma("unroll") for (int kt = 0; kt < 2; ++kt) SC[ti][kg][kt] = S2[kg][kt] - nref4;          \
                at_update<2>(VT + ((ti) & 1) * AT_TILE, S2, O, L, nref4, seen, (ti) * 64, 0, ncr - 1, r, q); \
                if ((ti) + 1 < ntc) at_store(nslot, KT + (((ti) + 1) & 1) * AT_TILE, VT + (((ti) + 1) & 1) * AT_TILE, tid); \
                __syncthreads(); \
            }
        AT_CMP_STEP(0, c1) AT_CMP_STEP(1, c2) AT_CMP_STEP(2, c3) AT_CMP_STEP(3, c3)
#undef AT_CMP_STEP
    }
    {
        const float ltot = at_rowsum(L, q); const float m = -nref4[0];
        const float inv = ltot > 0.f ? 1.0f / ltot : 0.f;
        float A[8][2], Bv[8];
#pragma unroll
        for (int ti = 0; ti < 4; ++ti)
#pragma unroll
            for (int kg = 0; kg < 2; ++kg) {
                float pa[2][4];
#pragma unroll
                for (int kt = 0; kt < 2; ++kt)
#pragma unroll
                    for (int i = 0; i < 4; ++i) { const int n = ti * 64 + 32 * kg + 8 * q + 4 * kt + i; pa[kt][i] = (ti < ntc && n < ncr) ? __builtin_amdgcn_exp2f(SC[ti][kg][kt][i] - m) * inv : 0.f; }
                A[ti * 2 + kg][0] = 2.0f * (pa[0][0] + pa[0][1] + pa[0][2]) + pa[0][3];
                A[ti * 2 + kg][1] = 2.0f * (pa[1][0] + pa[1][1] + pa[1][2]) + pa[1][3] + pa[0][3];
                Bv[ti * 2 + kg] = pa[1][3];
            }
        float prevB[8];
#pragma unroll
        for (int kgg = 0; kgg < 8; ++kgg) prevB[kgg] = __shfl(Bv[kgg], (lane + 48) & 63);
#pragma unroll
        for (int kgg = 0; kgg < 8; ++kgg) { const float pb = q > 0 ? prevB[kgg] : (kgg > 0 ? prevB[kgg - 1] : 0.f); A[kgg][0] += pb; }
        const int cur = t >> 6;
#pragma unroll
        for (int kgg = 0; kgg < 8; ++kgg)
#pragma unroll
            for (int kt = 0; kt < 2; ++kt) { const float v = sum_quad(A[kgg][kt]);
                const int j = 8 * kgg + 2 * q + kt;
                const bool valid = j <= cur, forced = (j == 0) || (cur - j >= 0 && cur - j < 2);
                if (g == 0) SCO[(r >> 2) * 64 + j] = valid ? v + (forced ? 1.0e4f : 0.0f) : NEGV; }
    }
    at_finish(OUT, O, L, nref4, seen, g0, q);
    WAVE_SYNC();
    {
        const int tk = lane >> 4, jj = lane & 15;
        const float* sc = SCO + tk * 64;
        const float s0v = sc[jj], s1v = sc[jj + 16], s2v = sc[jj + 32], s3v = sc[jj + 48];
        int r0 = 0, r1 = 0, r2 = 0, r3 = 0;
#pragma unroll 8
        for (int jp = 0; jp < 64; ++jp) { const float o = sc[jp];
            r0 += (o > s0v || (o == s0v && jp < jj)) ? 1 : 0; r1 += (o > s1v || (o == s1v && jp < jj + 16)) ? 1 : 0;
            r2 += (o > s2v || (o == s2v && jp < jj + 32)) ? 1 : 0; r3 += (o > s3v || (o == s3v && jp < jj + 48)) ? 1 : 0; }
        const unsigned long long b0 = __ballot(r0 < 16 && s0v > -0.5e30f), b1 = __ballot(r1 < 16 && s1v > -0.5e30f), b2 = __ballot(r2 < 16 && s2v > -0.5e30f), b3 = __ballot(r3 < 16 && s3v > -0.5e30f);
        if (lane < 4) { const int sh = 16 * lane;
            MSK[wave * 4 + lane] = ((b0 >> sh) & 0xffffull) | (((b1 >> sh) & 0xffffull) << 16) | (((b2 >> sh) & 0xffffull) << 32) | (((b3 >> sh) & 0xffffull) << 48); }
    }
    __syncthreads();
    PSEC(201, *pacc += wall_clock64() - pt_); PSEC(202, pt_ = wall_clock64());
    {
        unsigned long long un = 0ull;
#pragma unroll 4
        for (int i = 0; i < 32; ++i) un |= MSK[i];
        const unsigned long long mine = MSK[tokl];
        unsigned long long wany, wall;
        { const unsigned long long m0 = MSK[4 * wave], m1 = MSK[4 * wave + 1], m2 = MSK[4 * wave + 2], m3 = MSK[4 * wave + 3]; const unsigned long long o_ = m0 | m1 | m2 | m3, a_ = m0 & m1 & m2 & m3;
          wany = ((unsigned long long)(unsigned)__builtin_amdgcn_readfirstlane((int)(o_ >> 32)) << 32) | (unsigned)__builtin_amdgcn_readfirstlane((int)o_);
          wall = ((unsigned long long)(unsigned)__builtin_amdgcn_readfirstlane((int)(a_ >> 32)) << 32) | (unsigned)__builtin_amdgcn_readfirstlane((int)a_); }
        const bf16_t* kb = WSP(const bf16_t, WS_KSB) + rb * 256 + kvh * 64; const bf16_t* vb = WSP(const bf16_t, WS_VSB) + rb * 256 + kvh * 64;
        int j = __ffsll((long long)un) - 1; un &= un - 1;
#define AT_NEXT(dst) do { dst = un ? (__ffsll((long long)un) - 1) : -1; un &= un - 1; } while (0)
#define AT_SEL_STEP(slot, jslot) { \
            if (j >= 0 && ((wany >> j) & 1ull)) { f32x4_t S[2][2]; const bool on_ = (mine >> j) & 1ull; \
                if (64 * j + 63 <= s0 + 4 * wave) {         \
                    f32x4_t cin_; cin_[0] = on_ ? nref4[0] : -3.0e38f; cin_[1] = on_ ? nref4[1] : -3.0e38f; cin_[2] = on_ ? nref4[2] : -3.0e38f; cin_[3] = on_ ? nref4[3] : -3.0e38f; \
                    at_scores(KT + buf * AT_TILE, qs, S, cin_, r, q); at_update<0>(VT + buf * AT_TILE, S, O, L, nref4, seen, j * 64, 0, 0, r, q); } \
                else { at_scores(KT + buf * AT_TILE, qs, S, nref4, r, q); at_update<2>(VT + buf * AT_TILE, S, O, L, nref4, seen, j * 64, 0, on_ ? t : -1, r, q); } } \
            at_store(slot, KT + (buf ^ 1) * AT_TILE, VT + (buf ^ 1) * AT_TILE, tid); __syncthreads(); \
            j = jslot; buf ^= 1; AT_NEXT(jslot); at_load(slot, kb, vb, (jslot >= 0 ? jslot : 0) * 64, tid); }
        at_load(st, kb, vb, j * 64, tid);
        int j0_, j1_, j2_, j3_; AT_NEXT(j0_); AT_NEXT(j1_); AT_NEXT(j2_); AT_NEXT(j3_);
        AtStage q0, q1, q2, q3;
        at_load(q0, kb, vb, (j0_ >= 0 ? j0_ : 0) * 64, tid);
        at_load(q1, kb, vb, (j1_ >= 0 ? j1_ : 0) * 64, tid);
        at_load(q2, kb, vb, (j2_ >= 0 ? j2_ : 0) * 64, tid);
        at_load(q3, kb, vb, (j3_ >= 0 ? j3_ : 0) * 64, tid);
        at_store(st, KT, VT, tid); __syncthreads();
        int buf = 0;
#pragma unroll 1
        do {
            AT_SEL_STEP(q0, j0_)
            AT_SEL_STEP(q1, j1_)
            AT_SEL_STEP(q2, j2_)
            AT_SEL_STEP(q3, j3_)
        } while (j >= 0);
#undef AT_SEL_STEP
#undef AT_NEXT
    }
    at_finish(OUT, O, L, nref4, seen, g1, q);
    PSEC(202, *pacc += wall_clock64() - pt_); PSEC(203, pt_ = wall_clock64());
    {
        const bf16_t* kb = WSP(const bf16_t, WS_KWB) + rb * 256 + kvh * 64; const bf16_t* vb = WSP(const bf16_t, WS_VWB) + rb * 256 + kvh * 64;
        const int j0 = (s0 > 512 ? s0 - 512 : 0) >> 6, j1 = (s0 + 31) >> 6;
        unsigned long long un = ((2ull << j1) - 1ull) & ~((1ull << j0) - 1ull);
        int j = j0; un &= un - 1;
#define AT_NEXT(dst) do { dst = un ? (__ffsll((long long)un) - 1) : -1; un &= un - 1; } while (0)
#define AT_WIN_STEP(slot, jslot) { \
            if (j >= 0) { f32x4_t S[2][2]; at_scores(KT + buf * AT_TILE, qs, S, nref4, r, q); \
                if (64 * j >= s0 + 4 * wave + 3 - 512 && 64 * j + 63 <= s0 + 4 * wave) at_update<0>(VT + buf * AT_TILE, S, O, L, nref4, seen, j * 64, 0, 0, r, q);     \
                else at_update<3>(VT + buf * AT_TILE, S, O, L, nref4, seen, j * 64, t - 512, t, r, q); } \
            at_store(slot, KT + (buf ^ 1) * AT_TILE, VT + (buf ^ 1) * AT_TILE, tid); __syncthreads(); \
            j = jslot; buf ^= 1; AT_NEXT(jslot); at_load(slot, kb, vb, (jslot >= 0 ? jslot : 0) * 64, tid); }
        at_load(st, kb, vb, j * 64, tid);
        int j0_, j1_, j2_, j3_; AT_NEXT(j0_); AT_NEXT(j1_); AT_NEXT(j2_); AT_NEXT(j3_);
        AtStage q0, q1, q2, q3;
        at_load(q0, kb, vb, (j0_ >= 0 ? j0_ : 0) * 64, tid);
        at_load(q1, kb, vb, (j1_ >= 0 ? j1_ : 0) * 64, tid);
        at_load(q2, kb, vb, (j2_ >= 0 ? j2_ : 0) * 64, tid);
        at_load(q3, kb, vb, (j3_ >= 0 ? j3_ : 0) * 64, tid);
        at_store(st, KT, VT, tid); __syncthreads();
        int buf = 0;
#pragma unroll 1
        do {
            AT_WIN_STEP(q0, j0_)
            AT_WIN_STEP(q1, j1_)
            AT_WIN_STEP(q2, j2_)
            AT_WIN_STEP(q3, j3_)
        } while (j >= 0);
#undef AT_WIN_STEP
#undef AT_NEXT
    }
    at_finish(OUT, O, L, nref4, seen, g2, q);
    PSEC(203, *pacc += wall_clock64() - pt_);
    {
        bf16_t* dst = WSP(bf16_t, WS_AMIX) + trow * DM + (kvh * 4 + g) * 64 + 4 * q;
#pragma unroll
        for (int dt = 0; dt < 4; ++dt) *(uint2*)(dst + 16 * dt) = make_uint2(pg8::cvt_pk_bf16(OUT[dt][0], OUT[dt][1]), pg8::cvt_pk_bf16(OUT[dt][2], OUT[dt][3]));
    }
}

constexpr int CP_LD = 72, CP_ABUF = 144 * CP_LD;
constexpr int CP_X1_OFF = 0, CP_HID_OFF = 73728, CP_HLD = 136;

__device__ __forceinline__ void cp_cvt_store(bf16_t* A, int u, const float4& x, const float4& y) {
    const int s = u >> 5, kvh = (u & 31) >> 3, d8 = (u & 7) * 8;
    *(uint4*)(A + (s * 4 + kvh) * CP_LD + d8) = make_uint4(pg8::cvt_pk_bf16(x.x, x.y), pg8::cvt_pk_bf16(x.z, x.w), pg8::cvt_pk_bf16(y.x, y.y), pg8::cvt_pk_bf16(y.z, y.w));
}

__device__ __forceinline__ void compress_mfma(const Ctx& c, int it) {
    const int tid = c.tid, lane = c.lane, wave = c.wave, r = lane & 15, q = lane >> 4;
    bf16_t* Abuf = (bf16_t*)c.lds;
    float* X1 = (float*)(c.lds + CP_X1_OFF);
    bf16_t* HID = (bf16_t*)(c.lds + CP_HID_OFF);
    const bf16_t* W1T = WSP(const bf16_t, WS_W1T); const bf16_t* W2T = WSP(const bf16_t, WS_W2T); const float* PET = WSP(const float, WS_PET);
    const int n_items_p = 2 * 8 * 2;
    {
        unsigned long long ps_ = 0; if (PROBE_T >= 331 && PROBE_T <= 333) ps_ = wall_clock64();
        const bool smp = it >= n_items_p;
        const int kv = it & 1;
        const int b = smp ? (it - n_items_p) >> 3 : it >> 4;
        const int g = smp ? ((it - n_items_p) >> 1) & 3 : (it >> 1) & 7;
        const int nseg = smp ? 128 : 256;
        const float* src[3]; const size_t tstride = smp ? 1024 : NINP;
#pragma unroll
        for (int k = 0; k < 3; ++k) {
            int u = k < 2 ? tid + k * 512 : (tid < 32 ? 1024 + tid : tid); if (k == 2) asm volatile("" : "+v"(u));
            int seg = 32 * g + (u >> 5); if (seg > nseg - 1) seg = nseg - 1;
            const int kvh = (u & 31) >> 3, d8 = (u & 7) * 8;
            if (smp) { const int page = ((const int*)c.p->in[3])[b * NPAGES + (seg >> 3)]; src[k] = c.p->in[2] + ((size_t)page * PAGE + ((16 * seg) & 127)) * 1024 + kv * 256 + kvh * 64 + d8; }
            else src[k] = WSP(const float, WS_COLS) + ((size_t)b * SEQ + 16 * seg) * NINP + 1024 + kv * 256 + kvh * 64 + d8;
        }
        const bool has3 = tid < 32;
        const bf16_t* wb = W1T + (size_t)kv * 16 * 256 * 64 + (size_t)(32 * wave + r) * 64 + q * 8;
        f32x4_t acc[9][2];
#pragma unroll
        for (int mt = 0; mt < 9; ++mt) { acc[mt][0] = (f32x4_t){0.f, 0.f, 0.f, 0.f}; acc[mt][1] = (f32x4_t){0.f, 0.f, 0.f, 0.f}; }
        float4 pf[2][3][2];
        bf16x8_t bc[2][2], bn[2][2];
        __syncthreads();
#define CP_LOADA(sl, L) do { _Pragma("unroll") for (int k = 0; k < 3; ++k) { pf[sl][k][0] = *(const float4*)(src[k] + (size_t)(L) * tstride); pf[sl][k][1] = *(const float4*)(src[k] + (size_t)(L) * tstride + 4); } } while (0)
#define CP_STOREA(sl, Ap) do { cp_cvt_store(Ap, tid, pf[sl][0][0], pf[sl][0][1]); cp_cvt_store(Ap, tid + 512, pf[sl][1][0], pf[sl][1][1]); cp_cvt_store(Ap, has3 ? 1024 + tid : 1056 + (tid & 31), pf[sl][2][0], pf[sl][2][1]); } while (0)
#define CP_LOADB(bb, L) do { _Pragma("unroll") for (int nt = 0; nt < 2; ++nt) _Pragma("unroll") for (int ks = 0; ks < 2; ++ks) bb[nt][ks] = *(const bf16x8_t*)(wb + (size_t)(L) * 256 * 64 + nt * 16 * 64 + ks * 32); } while (0)
#define CP_MMA(Ap, bb) do { _Pragma("unroll") for (int mg = 0; mg < 3; ++mg) { _Pragma("unroll") for (int ks = 0; ks < 2; ++ks) _Pragma("unroll") for (int mm = 0; mm < 3; ++mm) { const int mt = mg * 3 + mm; \
            const bf16x8_t a = *(const bf16x8_t*)((Ap) + (16 * mt + r) * CP_LD + ks * 32 + q * 8); acc[mt][0] = MFMA16(a, bb[0][ks], acc[mt][0]); acc[mt][1] = MFMA16(a, bb[1][ks], acc[mt][1]); } \
            } } while (0)
        CP_LOADA(0, 0); CP_LOADA(1, 1); CP_LOADB(bc, 0);
        CP_STOREA(0, Abuf); CP_STOREA(1, Abuf + CP_ABUF);
        __syncthreads();
        if (PROBE_T == 331) { if (c.tid == 0) atomicMax((unsigned*)(c.ws + WS_CTL) + 6000, (unsigned)(wall_clock64() - ps_)); }
        if (PROBE_T == 332) ps_ = wall_clock64();
#pragma unroll 1
        for (int lp = 0; lp < 7; ++lp) {
            const bf16_t* A0 = Abuf + ((lp & 1) * 2) * CP_ABUF;
            CP_LOADA(0, 2 * lp + 2); CP_LOADA(1, 2 * lp + 3);
            CP_LOADB(bn, 2 * lp + 1);
            __builtin_amdgcn_sched_barrier(0);
            CP_MMA(A0, bc);
            CP_LOADB(bc, 2 * lp + 2);
            __builtin_amdgcn_sched_barrier(0);
            CP_MMA(A0 + CP_ABUF, bn);
            { bf16_t* An = Abuf + (((lp + 1) & 1) * 2) * CP_ABUF; CP_STOREA(0, An); CP_STOREA(1, An + CP_ABUF); }
            __syncthreads();
        }
        { const bf16_t* A0 = Abuf + 2 * CP_ABUF;
            CP_LOADB(bn, 15);
            CP_MMA(A0, bc);
            CP_MMA(A0 + CP_ABUF, bn);
            __syncthreads(); }
#undef CP_LOADA
#undef CP_STOREA
#undef CP_LOADB
#undef CP_MMA
        if (PROBE_T == 332) { if (c.tid == 0) atomicMax((unsigned*)(c.ws + WS_CTL) + 6000, (unsigned)(wall_clock64() - ps_)); }
        if (PROBE_T == 333) ps_ = wall_clock64();
        if (wave >= 4) {
            int xw = 4 * q * 128 + 32 * (wave - 4) + r; asm volatile("" : "+v"(xw));
            float* xp = X1 + xw; float* xp8 = xp + 128 * 128;
#pragma unroll
            for (int mt = 0; mt < 9; ++mt)
#pragma unroll
                for (int nt = 0; nt < 2; ++nt)
#pragma unroll
                    for (int i = 0; i < 4; ++i) { if (mt < 8) xp[(16 * mt + i) * 128 + 16 * nt] = acc[mt][nt][i]; else xp8[i * 128 + 16 * nt] = acc[mt][nt][i]; }
        }
        __syncthreads();
        if (wave < 4) {
            int xr = (4 * q + 4) * 128 + 32 * wave + r, hw = 4 * q * CP_HLD + 32 * wave + r; asm volatile("" : "+v"(xr), "+v"(hw));
            const float* xp = X1 + xr; bf16_t* hp = HID + hw;
#pragma unroll
            for (int nt = 0; nt < 2; ++nt) {
                const float pt = PET[kv * 128 + 32 * wave + 16 * nt + r];
#pragma unroll
                for (int mt = 0; mt < 8; ++mt)
#pragma unroll
                    for (int i = 0; i < 4; ++i) { const float v = acc[mt][nt][i] + xp[(16 * mt + i) * 128 + 16 * nt] + pt;
                        hp[(16 * mt + i) * CP_HLD + 16 * nt] = f2bf(v * __builtin_amdgcn_rcpf(1.0f + __expf(-v))); }
            }
        }
        __syncthreads();
        {
            f32x4_t o2[4];
#pragma unroll
            for (int nt = 0; nt < 4; ++nt) o2[nt] = (f32x4_t){0.f, 0.f, 0.f, 0.f};
#pragma unroll
            for (int ks = 0; ks < 4; ++ks) { const bf16x8_t a = *(const bf16x8_t*)(HID + (16 * wave + r) * CP_HLD + ks * 32 + q * 8);
#pragma unroll
                for (int nt = 0; nt < 4; ++nt) { const bf16x8_t bb = *(const bf16x8_t*)(W2T + (size_t)kv * 64 * 128 + (16 * nt + r) * 128 + ks * 32 + q * 8); o2[nt] = MFMA16(a, bb, o2[nt]); } }
#pragma unroll
            for (int i = 0; i < 4; ++i) { const int row = 16 * wave + 4 * q + i, sl = row >> 2, kvh = row & 3, n = 32 * g + sl;
#pragma unroll
                for (int nt = 0; nt < 4; ++nt) { const int dd = 16 * nt + r;
                    if (smp) { if (n <= nseg - 2) WSP(float, kv == 0 ? WS_KCS : WS_VCS)[((size_t)b * 128 + n) * 256 + kvh * 64 + dd] = o2[nt][i]; }
                    else WSP(bf16_t, kv == 0 ? WS_KCB : WS_VCB)[((size_t)b * 256 + n) * 256 + kvh * 64 + dd] = n <= nseg - 2 ? f2bf(o2[nt][i]) : (bf16_t)0; } }
        }
        if (PROBE_T == 333) { __syncthreads(); if (c.tid == 0) atomicMax((unsigned*)(c.ws + WS_CTL) + 6000, (unsigned)(wall_clock64() - ps_)); }
    }
}

constexpr int LR_LD = 296;
__device__ __forceinline__ void p5_lora(const Ctx& c, int it) {
    const float* COLS = WSP(const float, WS_COLS);
    const float* mu = c.p->in[19]; const float* w0 = c.p->in[20]; const float* a0 = c.p->in[22];
    bf16_t* LA = (bf16_t*)c.lds;
    const int tid = c.tid, lane = c.lane, wave = c.wave, r = lane & 15, q = lane >> 4;
    {
        const int row0 = it * 32;
        __syncthreads();
        float4 cu_[5], pv_[5], m4_[5];
#pragma unroll
        for (int k = 0; k < 5; ++k) {
            int u = tid + k * NTHREADS; u = u < 32 * 72 ? u : 32 * 72 - 1;
            const int rr = u / 72, c4 = u - rr * 72, row = row0 + rr, col = 3072 + 4 * c4;
            cu_[k] = *(const float4*)(COLS + (size_t)row * NINP + NSAC + col);
            const float* pp = row >= NPR ? c.p->in[6] + (size_t)(row - NPR) * RWC + col : COLS + (size_t)((row & (SEQ - 1)) == 0 ? row : row - 1) * NINP + NSAC + col;
            pv_[k] = *(const float4*)pp;
            m4_[k] = *(const float4*)(mu + col);
        }
#pragma unroll
        for (int k = 0; k < 5; ++k) {
            const int u0 = tid + k * NTHREADS; const int u = u0 < 32 * 72 ? u0 : 32 * 72 - 1;
            const int rr = u / 72, c4 = u - rr * 72, row = row0 + rr;
            const float4 cu = cu_[k], m4 = m4_[k]; float4 pv = pv_[k];
            if (row < NPR && (row & (SEQ - 1)) == 0) pv = make_float4(0.f, 0.f, 0.f, 0.f);
            float x[4] = {cu.x + (pv.x - cu.x) * m4.x, cu.y + (pv.y - cu.y) * m4.y, cu.z + (pv.z - cu.z) * m4.z, cu.w + (pv.w - cu.w) * m4.w};
            if (c4 < 16) { for (int j = 0; j < 4; ++j) x[j] = tanhf(x[j]); }
            else if (c4 >= 32) { for (int j = 0; j < 4; ++j) x[j] = sigmoidf_(x[j]); }
            if (u0 < 32 * 72) *(uint2*)(LA + rr * LR_LD + 4 * c4) = make_uint2(pack2bf(x[0], x[1]), pack2bf(x[2], x[3]));
        }
        __syncthreads();
        int lao = r * LR_LD + 8 * q; asm volatile("" : "+v"(lao));
#pragma unroll
        for (int lo = 0; lo < 3; ++lo) {
            const int Kl = lo == 2 ? 160 : 64, koff = lo == 0 ? 0 : (lo == 1 ? 64 : 128);
            unsigned loff = (unsigned)((128 * wave + r) * Kl + 8 * q); asm volatile("" : "+v"(loff));
            const bf16_t* Wt = WSP(const bf16_t, lo == 0 ? WS_LW2T : (lo == 1 ? WS_LA2T : WS_LG2T)) + loff;
            f32x4_t acc[8][2];
#pragma unroll
            for (int nt = 0; nt < 8; ++nt) { acc[nt][0] = (f32x4_t){0.f, 0.f, 0.f, 0.f}; acc[nt][1] = (f32x4_t){0.f, 0.f, 0.f, 0.f}; }
#pragma unroll
            for (int ks = 0; ks < (lo == 2 ? 5 : 2); ++ks) {
                const bf16x8_t b0 = *(const bf16x8_t*)(LA + lao + koff + 32 * ks), b1 = *(const bf16x8_t*)(LA + lao + 16 * LR_LD + koff + 32 * ks);
#pragma unroll
                for (int nt = 0; nt < 8; ++nt) { const bf16x8_t a = *(const bf16x8_t*)(Wt + (size_t)(16 * nt) * Kl + 32 * ks);
                    acc[nt][0] = MFMA16(a, b0, acc[nt][0]); acc[nt][1] = MFMA16(a, b1, acc[nt][1]); }
            }
            float* dst = WSP(float, lo == 0 ? WS_DEC : (lo == 1 ? WS_AA : WS_G));
#pragma unroll
            for (int nt = 0; nt < 8; ++nt) {
                const int n4 = 128 * wave + 16 * nt + 4 * q;
                float4 bias = make_float4(0.f, 0.f, 0.f, 0.f);
                if (lo == 0) bias = *(const float4*)(w0 + n4); else if (lo == 1) bias = *(const float4*)(a0 + n4);
#pragma unroll
                for (int ct = 0; ct < 2; ++ct) {
                    float v[4] = {acc[nt][ct][0] + bias.x, acc[nt][ct][1] + bias.y, acc[nt][ct][2] + bias.z, acc[nt][ct][3] + bias.w};
                    if (lo == 0) {
#pragma unroll
                        for (int j = 0; j < 4; ++j) { const float nx = -v[j]; const float sp = fmaxf(nx, 0.f) + __logf(1.0f + __expf(-fabsf(nx))); v[j] = __expf(-__expf(-sp - 0.5f)); }
                    } else if (lo == 1) {
#pragma unroll
                        for (int j = 0; j < 4; ++j) v[j] = sigmoidf_(v[j]);
                    }
                    *(float4*)(dst + (size_t)(row0 + 16 * ct + r) * 1024 + n4) = make_float4(v[0], v[1], v[2], v[3]);
                }
            }
        }
    }
}

#define P5_QUEUE(word, n_items, BODY, PK) do { unsigned* q_ = (unsigned*)(c.ws + WS_CTL) + (word); unsigned nx_ = 0u; \
    int pull = (int)sh[1 + ((word) - CW_QMISC) / 64];        \
    _Pragma("unroll 1") while (pull < (n_items)) { if (c.tid == 0) nx_ = atomicAdd(q_, 1u); \
        unsigned long long ti_ = 0; if (PROBE_T == (PK)) ti_ = wall_clock64(); BODY; if (PROBE_T == (PK)) { __syncthreads(); if (c.tid == 0) atomicMax((unsigned*)(c.ws + WS_CTL) + 6000, (unsigned)(wall_clock64() - ti_)); } \
        __syncthreads(); if (c.tid == 0) sh[0] = nx_; __syncthreads(); pull = (int)sh[0]; } } while (0)
__device__ __forceinline__ void p5_queue(const Ctx& c, unsigned long long* pacc = nullptr) {
    volatile unsigned* sh = (volatile unsigned*)(c.lds + LDS_MISC + 64);
    unsigned long long t0_ = 0;
    __syncthreads();
    if (c.tid == 0) { unsigned* q0_ = (unsigned*)(c.ws + WS_CTL) + CW_QMISC; const unsigned f0 = atomicAdd(q0_, 1u), f1 = atomicAdd(q0_ + 64, 1u), f2 = atomicAdd(q0_ + 128, 1u); sh[1] = f0; sh[2] = f1; sh[3] = f2; }
    __syncthreads();
    if (PROBE_T == 301 && pacc) t0_ = wall_clock64();
    if (PROBE_T == 302 && pacc) t0_ = wall_clock64();
    P5_QUEUE(CW_QMISC + 64, NR / 32, p5_lora(c, pull), 322);
    if (PROBE_T == 302 && pacc) *pacc = wall_clock64() - t0_;
    if (PROBE_T == 312 && c.tid == 0) atomicMax((unsigned*)(c.ws + WS_CTL) + 6000, (unsigned)(wall_clock64() - *pacc));
    P5_QUEUE(CW_QMISC, 2 * 8 * 2 + NSM * 4 * 2, compress_mfma(c, pull), 323);
    if (PROBE_T == 301 && pacc) *pacc = wall_clock64() - t0_;
    if (PROBE_T == 311 && c.tid == 0) atomicMax((unsigned*)(c.ws + WS_CTL) + 6000, (unsigned)(wall_clock64() - *pacc));
    if (PROBE_T == 303 && pacc) t0_ = wall_clock64();
    P5_QUEUE(CW_QMISC + 128, NR / 32, p5a_nsa_prep(c, NR / 32 - 1 - pull), 321);
    if (PROBE_T == 303 && pacc) *pacc = wall_clock64() - t0_;
    if (PROBE_T == 313 && c.tid == 0) atomicMax((unsigned*)(c.ws + WS_CTL) + 6000, (unsigned)(wall_clock64() - *pacc));
}


struct RwConst { float mur, muk, muv, kkw, kaw, rkw; };
__device__ __forceinline__ RwConst rw_const(const Ctx& c, int h, int j) {
    const int n = h * 64 + j; RwConst k;
    k.mur = c.p->in[19][n]; k.muk = c.p->in[19][1024 + n]; k.muv = c.p->in[19][2048 + n]; k.kkw = c.p->in[25][n]; k.kaw = c.p->in[26][n]; k.rkw = c.p->in[27][n];
    return k;
}
struct RwStep { float r, d, km, kk, ka, v, bon; };
__device__ __forceinline__ RwStep rw_prep(const RwConst& k, float cr, float ck, float cv, float pr, float pk, float pv, float dec, float a) {
    RwStep o;
    o.r = cr + (pr - cr) * k.mur; const float xk = ck + (pk - ck) * k.muk; o.v = cv + (pv - cv) * k.muv;
    const float kkr = xk * k.kkw;
    const float ssq = wave_sum(kkr * kkr);
    o.kk = kkr * rsqrtf(fmaxf(ssq, 1e-24f));
    o.km = xk * (1.0f + (a - 1.0f) * k.kaw);
    o.ka = o.kk * a; o.d = dec;
    o.bon = wave_sum(o.r * o.km * k.rkw);
    return o;
}


constexpr int CKN = 32 * 256;
__device__ __forceinline__ void sm_mul(const float (&X)[4], const float (&Y)[4], float (&Z)[4], float* SA, float* SB, int q, int r) {
    WAVE_SYNC();
#pragma unroll
    for (int e = 0; e < 4; ++e) { SA[(4 * q + e) * 16 + r] = X[e]; SB[(4 * q + e) * 16 + r] = Y[e]; }
    WAVE_SYNC();
#pragma unroll
    for (int e = 0; e < 4; ++e) Z[e] = 0.f;
#pragma unroll
    for (int u4 = 0; u4 < 4; ++u4) {
        const float y0 = SB[(4 * u4) * 16 + r], y1 = SB[(4 * u4 + 1) * 16 + r], y2 = SB[(4 * u4 + 2) * 16 + r], y3 = SB[(4 * u4 + 3) * 16 + r];
#pragma unroll
        for (int e = 0; e < 4; ++e) { const float4 x = *(const float4*)(SA + (4 * q + e) * 16 + 4 * u4); Z[e] += x.x * y0 + x.y * y1 + x.z * y2 + x.w * y3; }
    }
}

__device__ __forceinline__ void rwc_prep_item(const Ctx& c, int item, float* wl) {
    const int chain = item >> 8, cc = item & 255, b = chain >> 4, h = chain & 15;
    const int lane = c.lane, q = lane >> 4, r = lane & 15;
    constexpr int XP = 68;
    float* XB = wl; float* XX = wl + 16 * XP; float* XA = wl + 32 * XP; float* XR = wl + 48 * XP;
    const float* COLS = WSP(const float, WS_COLS); const float* DEC = WSP(const float, WS_DEC); const float* AA = WSP(const float, WS_AA);
    const RwConst kc = rw_const(c, h, lane);
    const int hcol = h * 64 + lane;
    const size_t r0 = (size_t)b * SEQ + (size_t)cc * 16;
    float al[16], rh[16], vv[16];
    float gam = 1.0f, pr = 0.f, pk = 0.f, pv = 0.f;
    if (cc != 0) { const float* pp = COLS + (r0 - 1) * NINP + NSAC + hcol; pr = pp[0]; pk = pp[1024]; pv = pp[2048]; }
    WAVE_SYNC();
#pragma unroll
    for (int hf = 0; hf < 2; ++hf) {
        float cr[8], ck[8], cv[8], de[8], aa[8];
#pragma unroll
        for (int s_ = 0; s_ < 8; ++s_) { const size_t row = r0 + hf * 8 + s_; const float* cp = COLS + row * NINP + NSAC + hcol; cr[s_] = cp[0]; ck[s_] = cp[1024]; cv[s_] = cp[2048];
            de[s_] = DEC[row * 1024 + hcol]; aa[s_] = AA[row * 1024 + hcol]; }
#pragma unroll
        for (int s_ = 0; s_ < 8; ++s_) { const int t = hf * 8 + s_;
            const RwStep o = rw_prep(kc, cr[s_], ck[s_], cv[s_], pr, pk, pv, de[s_], aa[s_]); pr = cr[s_]; pk = ck[s_]; pv = cv[s_];
            if (lane == 0) WSP(float, WS_BON)[(r0 + t) * 16 + h] = o.bon;
            const float gp = gam; gam *= o.d; const float ig = __builtin_amdgcn_rcpf(gam);
            al[t] = gp * o.kk; rh[t] = gam * o.r; vv[t] = o.v;
            XB[t * XP + lane] = o.ka * ig; XX[t * XP + lane] = o.km * ig; XA[t * XP + lane] = al[t]; XR[t * XP + lane] = rh[t]; }
    }
    WAVE_SYNC();
    float mb[4], mx[4], nb[4], nx[4];
#pragma unroll
    for (int e = 0; e < 4; ++e) { mb[e] = 0.f; mx[e] = 0.f; nb[e] = 0.f; nx[e] = 0.f; }
#pragma unroll 4
    for (int j4 = 0; j4 < 16; ++j4) {
        const float4 a = *(const float4*)(XA + r * XP + 4 * j4), p = *(const float4*)(XR + r * XP + 4 * j4);
#pragma unroll
        for (int e = 0; e < 4; ++e) { const float4 be = *(const float4*)(XB + (4 * q + e) * XP + 4 * j4), xe = *(const float4*)(XX + (4 * q + e) * XP + 4 * j4);
            mb[e] += dot4(be, a); nb[e] += dot4(be, p); mx[e] += dot4(xe, a); nx[e] += dot4(xe, p); }
    }
#pragma unroll
    for (int e = 0; e < 4; ++e) { const int s = 4 * q + e; if (!(s < r)) { mb[e] = 0.f; mx[e] = 0.f; } if (!(s <= r)) { nb[e] = 0.f; nx[e] = 0.f; } }
    float* SA = XA; float* SB = XA + 256; float* TL = XA + 512; float* NL = XA + 768;
    float id[4], m2[4], m4[4], m8[4], t0[4], t1[4], f1[4], T[4], mh[4], nh[4], tmp[4];
#pragma unroll
    for (int e = 0; e < 4; ++e) id[e] = (4 * q + e == r) ? 1.0f : 0.0f;
    sm_mul(mb, mb, m2, SA, SB, q, r); sm_mul(m2, m2, m4, SA, SB, q, r); sm_mul(m4, m4, m8, SA, SB, q, r);
#pragma unroll
    for (int e = 0; e < 4; ++e) { t0[e] = id[e] - mb[e]; f1[e] = id[e] + m2[e]; }
    sm_mul(t0, f1, t1, SA, SB, q, r);
#pragma unroll
    for (int e = 0; e < 4; ++e) f1[e] = id[e] + m4[e];
    sm_mul(t1, f1, t0, SA, SB, q, r);
#pragma unroll
    for (int e = 0; e < 4; ++e) f1[e] = id[e] + m8[e];
    sm_mul(t0, f1, T, SA, SB, q, r);
    sm_mul(mx, T, mh, SA, SB, q, r);
    sm_mul(mh, nb, tmp, SA, SB, q, r);
#pragma unroll
    for (int e = 0; e < 4; ++e) nh[e] = nx[e] - tmp[e];
    WAVE_SYNC();
#pragma unroll
    for (int e = 0; e < 4; ++e) { TL[(4 * q + e) * 16 + r] = T[e]; NL[(4 * q + e) * 16 + r] = nb[e]; }
    WAVE_SYNC();
    float ah[16], ph[16];
#pragma unroll
    for (int t = 0; t < 16; ++t) { float a = 0.f;
#pragma unroll
        for (int s = 0; s <= t; ++s) a += al[s] * TL[s * 16 + t];
        ah[t] = a; }
#pragma unroll
    for (int t = 0; t < 16; ++t) { float p = rh[t];
#pragma unroll
        for (int s = 0; s <= t; ++s) p -= ah[s] * NL[s * 16 + t];
        ph[t] = p; }
    constexpr int AP = 72;
    bf16_t* ALa = (bf16_t*)XA; bf16_t* ALp = ALa + 16 * AP;
    WAVE_SYNC();
#pragma unroll
    for (int t = 0; t < 16; ++t) { ALa[t * AP + lane] = f2bf(ah[t]); ALp[t * AP + lane] = f2bf(ph[t]); }
    WAVE_SYNC();
    unsigned char* rec = c.ws + WS_CK + (size_t)item * CK_REC;
#pragma unroll
    for (int ks = 0; ks < 2; ++ks) {
        const uint2 alo = *(const uint2*)(ALa + r * AP + 32 * ks + 4 * q), ahi = *(const uint2*)(ALa + r * AP + 32 * ks + 16 + 4 * q);
        const uint2 plo = *(const uint2*)(ALp + r * AP + 32 * ks + 4 * q), phi = *(const uint2*)(ALp + r * AP + 32 * ks + 16 + 4 * q);
        ((uint4*)rec)[ks * 64 + lane] = make_uint4(alo.x, alo.y, ahi.x, ahi.y);
        ((uint4*)(rec + 2048))[ks * 64 + lane] = make_uint4(plo.x, plo.y, phi.x, phi.y);
    }
    ((uint2*)(rec + 4096))[lane] = make_uint2(pack2bf(mh[0], mh[1]), pack2bf(mh[2], mh[3]));
    ((uint2*)(rec + 4608))[lane] = make_uint2(pack2bf(nh[0], nh[1]), pack2bf(nh[2], nh[3]));
#pragma unroll
    for (int mt = 0; mt < 4; ++mt) { const float g16 = __shfl(gam, 16 * mt + r);
        const float b0 = XB[(4 * q) * XP + 16 * mt + r], b1 = XB[(4 * q + 1) * XP + 16 * mt + r], b2 = XB[(4 * q + 2) * XP + 16 * mt + r], b3 = XB[(4 * q + 3) * XP + 16 * mt + r];
        const float x0 = XX[(4 * q) * XP + 16 * mt + r], x1 = XX[(4 * q + 1) * XP + 16 * mt + r], x2 = XX[(4 * q + 2) * XP + 16 * mt + r], x3 = XX[(4 * q + 3) * XP + 16 * mt + r];
        ((uint2*)(rec + 5120))[mt * 64 + lane] = make_uint2(pack2bf(-b0 * g16, -b1 * g16), pack2bf(-b2 * g16, -b3 * g16));
        ((uint2*)(rec + 7168))[mt * 64 + lane] = make_uint2(pack2bf(x0 * g16, x1 * g16), pack2bf(x2 * g16, x3 * g16)); }
    ((float*)(rec + 9216))[lane] = gam;
    { uint4 v0, v1; v0.x = pack2bf(vv[0], vv[1]); v0.y = pack2bf(vv[2], vv[3]); v0.z = pack2bf(vv[4], vv[5]); v0.w = pack2bf(vv[6], vv[7]);
      v1.x = pack2bf(vv[8], vv[9]); v1.y = pack2bf(vv[10], vv[11]); v1.z = pack2bf(vv[12], vv[13]); v1.w = pack2bf(vv[14], vv[15]);
      uint4* vp = (uint4*)(rec + 9472) + lane * 2; vp[0] = v0; vp[1] = v1; }
    WAVE_SYNC();
}

__device__ __forceinline__ bf16x8_t half_frag(const uint2& v) { return __builtin_bit_cast(bf16x8_t, make_uint4(v.x, v.y, 0u, 0u)); }

__device__ __forceinline__ void rwc_fill(const unsigned char* src, unsigned char* dst, int lt) {
    constexpr int NU = 4 * (int)CK_REC / 16;
    const uint4* s4 = (const uint4*)src; uint4* d4 = (uint4*)dst;
    uint4 t0, t1, t2, t3, t4, t5, t6, t7, t8, t9, t10, t11;
    { const int u11 = lt + 2816 < NU ? lt + 2816 : NU - 1;
      t0 = s4[lt]; t1 = s4[lt + 256]; t2 = s4[lt + 512]; t3 = s4[lt + 768]; t4 = s4[lt + 1024]; t5 = s4[lt + 1280]; t6 = s4[lt + 1536]; t7 = s4[lt + 1792];
      t8 = s4[lt + 2048]; t9 = s4[lt + 2304]; t10 = s4[lt + 2560]; t11 = s4[u11]; }
    d4[lt] = t0; d4[lt + 256] = t1; d4[lt + 512] = t2; d4[lt + 768] = t3; d4[lt + 1024] = t4; d4[lt + 1280] = t5; d4[lt + 1536] = t6; d4[lt + 1792] = t7;
    d4[lt + 2048] = t8; d4[lt + 2304] = t9; d4[lt + 2560] = t10; if (lt + 2816 < NU) d4[lt + 2816] = t11;
}

__device__ __forceinline__ void rwc_wincopy(const Ctx& c, int slot, int lt) {
    const size_t per_b = (size_t)511 * 128, total = per_b * NSM; const float* sw = c.p->in[4]; float* wo = c.out + O_WINS;
#pragma unroll
    for (int hb = 0; hb < 2; ++hb) {
        float4 t0, t1, t2, t3, t4, t5, t6, t7;
        const size_t e0 = (size_t)slot * 4096 + lt + 2048 * hb;
#define WC_LD(tk, k) { const size_t e_ = e0 + 256 * (k); const size_t ec = e_ < total ? e_ : total - 1; tk = *(const float4*)(sw + (ec / per_b) * 512 * 512 + 512 + (ec % per_b) * 4); }
#define WC_ST(tk, k) { const size_t e_ = e0 + 256 * (k); if (e_ < total) *(float4*)(wo + (e_ / per_b) * 512 * 512 + (e_ % per_b) * 4) = tk; }
        WC_LD(t0, 0) WC_LD(t1, 1) WC_LD(t2, 2) WC_LD(t3, 3) WC_LD(t4, 4) WC_LD(t5, 5) WC_LD(t6, 6) WC_LD(t7, 7)
        WC_ST(t0, 0) WC_ST(t1, 1) WC_ST(t2, 2) WC_ST(t3, 3) WC_ST(t4, 4) WC_ST(t5, 5) WC_ST(t6, 6) WC_ST(t7, 7)
#undef WC_LD
#undef WC_ST
    }
}
__device__ __forceinline__ void rwc_gn(const Ctx& c, int chain, int g, const float* yb, int lw, int lane) {
    const int b = chain >> 4, h = chain & 15, hcol = h * 64 + lane;
    const float* COLS = WSP(const float, WS_COLS); const float* Gt = WSP(const float, WS_G); const float* BON = WSP(const float, WS_BON);
    const float gw = c.p->in[28][hcol], gb = c.p->in[29][hcol], muv = c.p->in[19][2048 + hcol];
    bf16_t* AM = WSP(bf16_t, WS_AMIX);
#pragma unroll
    for (int hb = 0; hb < 2; ++hb) {
        float cu[9], gg[8], bo[8];
        const size_t r0 = (size_t)b * SEQ + (size_t)g * 64 + lw * 16 + hb * 8;
        cu[0] = ((r0 & (SEQ - 1)) == 0) ? 0.f : COLS[(r0 - 1) * NINP + NSAC + 2048 + hcol];
#pragma unroll
        for (int k = 0; k < 8; ++k) { cu[k + 1] = COLS[(r0 + k) * NINP + NSAC + 2048 + hcol]; gg[k] = Gt[(r0 + k) * 1024 + hcol]; bo[k] = BON[(r0 + k) * 16 + h]; }
#pragma unroll
        for (int k = 0; k < 8; ++k) {
            const float y = yb[(lw * 16 + hb * 8 + k) * 64 + lane];
            const float mean = wave_sum(y) * (1.0f / 64.0f); const float d = y - mean; const float var = wave_sum(d * d) * (1.0f / 64.0f);
            const float yn = d * rsqrtf(var + GN_EPS) * gw + gb;
            const float xv = cu[k + 1] + (cu[k] - cu[k + 1]) * muv;
            AM[(r0 + k) * DM + 1024 + hcol] = f2bf((yn + bo[k] * xv) * gg[k]);
        }
    }
}

__device__ __forceinline__ void rwc_scan_wg(const Ctx& c, int chain) {
    constexpr int NB = 4, BUFB = NB * (int)CK_REC, NU = BUFB / 16;
    const int tid = c.tid, wave = c.wave, lane = c.lane, q = lane >> 4, r = lane & 15;
    unsigned char* buf0 = c.lds;
    const unsigned char* recs = c.ws + WS_CK + (size_t)chain * 256 * CK_REC;
    f32x4_t ST[4];
#pragma unroll
    for (int mt = 0; mt < 4; ++mt) ST[mt] = (f32x4_t){0.f, 0.f, 0.f, 0.f};
    float* YB = (float*)(c.lds + 2 * BUFB);
    const int lt = tid - 256;
    __syncthreads();
    if (wave >= 4) rwc_fill(recs, buf0, lt);
    __syncthreads();
#pragma unroll 1
    for (int g = 0; g < 256 / NB; ++g) {
        if (wave < 4) {
            const unsigned char* bb = buf0 + (g & 1) * BUFB;
            float* yb = YB + (g & 1) * 4096;
#pragma unroll
            for (int u4 = 0; u4 < NB; ++u4) {
                const int cc = g * NB + u4;
                const unsigned char* sl = bb + u4 * CK_REC;
                const uint4 at0 = ((const uint4*)sl)[lane], at1 = ((const uint4*)sl)[64 + lane], pt0 = ((const uint4*)(sl + 2048))[lane], pt1 = ((const uint4*)(sl + 2048))[64 + lane];
                const uint2 mhf = ((const uint2*)(sl + 4096))[lane], nhf = ((const uint2*)(sl + 4608))[lane];
                const uint2 vtf = *(const uint2*)(sl + 9472 + ((16 * wave + r) * 16 + 4 * q) * 2);
                bf16x8_t sb[2];
#pragma unroll
                for (int ks = 0; ks < 2; ++ks) { uint4 u; u.x = pg8::cvt_pk_bf16(ST[2 * ks][0], ST[2 * ks][1]); u.y = pg8::cvt_pk_bf16(ST[2 * ks][2], ST[2 * ks][3]);
                    u.z = pg8::cvt_pk_bf16(ST[2 * ks + 1][0], ST[2 * ks + 1][1]); u.w = pg8::cvt_pk_bf16(ST[2 * ks + 1][2], ST[2 * ks + 1][3]); sb[ks] = __builtin_bit_cast(bf16x8_t, u); }
                const bf16x8_t vb = half_frag(vtf);
                f32x4_t UT = {0.f, 0.f, 0.f, 0.f}, YT = {0.f, 0.f, 0.f, 0.f};
                UT = MFMA16(__builtin_bit_cast(bf16x8_t, at0), sb[0], UT); UT = MFMA16(__builtin_bit_cast(bf16x8_t, at1), sb[1], UT); UT = MFMA16(half_frag(mhf), vb, UT);
                YT = MFMA16(__builtin_bit_cast(bf16x8_t, pt0), sb[0], YT); YT = MFMA16(__builtin_bit_cast(bf16x8_t, pt1), sb[1], YT); YT = MFMA16(half_frag(nhf), vb, YT);
#pragma unroll
                for (int e = 0; e < 4; ++e) yb[(u4 * 16 + 4 * q + e) * 64 + 16 * wave + r] = YT[e];
                const bf16x8_t ub = __builtin_bit_cast(bf16x8_t, make_uint4(pg8::cvt_pk_bf16(UT[0], UT[1]), pg8::cvt_pk_bf16(UT[2], UT[3]), 0u, 0u));
#pragma unroll
                for (int mt = 0; mt < 4; ++mt) { const uint2 bgf = ((const uint2*)(sl + 5120))[mt * 64 + lane], xgf = ((const uint2*)(sl + 7168))[mt * 64 + lane];
                    const float4 gm = *(const float4*)(sl + 9216 + (16 * mt + 4 * q) * 4);
                    f32x4_t s = ST[mt]; s[0] *= gm.x; s[1] *= gm.y; s[2] *= gm.z; s[3] *= gm.w;
                    s = MFMA16(half_frag(bgf), ub, s); s = MFMA16(half_frag(xgf), vb, s); ST[mt] = s; }
            }
        } else {
            if (g + 1 < 256 / NB) rwc_fill(recs + (size_t)(g + 1) * BUFB, buf0 + ((g + 1) & 1) * BUFB, lt);
            if (g > 0) rwc_gn(c, chain, g - 1, YB + ((g - 1) & 1) * 4096, wave - 4, lane);
        }
        __syncthreads();
    }
    if (wave >= 4) rwc_gn(c, chain, 256 / NB - 1, YB + ((256 / NB - 1) & 1) * 4096, wave - 4, lane);
    if (wave < 4) {
        float* so = c.out + O_WKVP + ((size_t)chain * 64 + 16 * wave + r) * 64 + 4 * q;
#pragma unroll
        for (int mt = 0; mt < 4; ++mt) *(float4*)(so + 16 * mt) = make_float4(ST[mt][0], ST[mt][1], ST[mt][2], ST[mt][3]);
    }
}

__device__ __forceinline__ void scan_sample_item(const Ctx& c, int item, float* wl) {
    const int b = item >> 4, h = item & 15, lane = c.lane, lq = lane >> 4, c4 = lane & 15;
    const size_t row = (size_t)NPR + b; const int hcol = h * 64 + lane;
    float bon_s;
    {
        const RwConst kc = rw_const(c, h, lane);
        const float* cp = WSP(const float, WS_COLS) + row * NINP + NSAC + hcol; const float* pp = c.p->in[6] + (size_t)b * RWC + hcol;
        const RwStep o = rw_prep(kc, cp[0], cp[1024], cp[2048], pp[0], pp[1024], pp[2048], WSP(const float, WS_DEC)[row * 1024 + hcol], WSP(const float, WS_AA)[row * 1024 + hcol]);
        WAVE_SYNC();
        wl[lane] = o.r; wl[64 + lane] = o.d; wl[128 + lane] = o.km; wl[192 + lane] = o.kk; wl[256 + lane] = o.ka; wl[320 + lane] = o.v;
        bon_s = o.bon;
        WAVE_SYNC();
    }
    const float4 r4 = *(const float4*)(wl + c4 * 4), d4 = *(const float4*)(wl + 64 + c4 * 4), km4 = *(const float4*)(wl + 128 + c4 * 4), kk4 = *(const float4*)(wl + 192 + c4 * 4), ka4 = *(const float4*)(wl + 256 + c4 * 4);
    const float* S0 = c.p->in[5] + (size_t)item * 4096; float* S1 = c.out + O_WKVS + (size_t)item * 4096;
    float4 Sv[16];
#pragma unroll
    for (int itr = 0; itr < 16; ++itr) Sv[itr] = *(const float4*)(S0 + (itr * 4 + lq) * 64 + c4 * 4);
#pragma unroll
    for (int itr = 0; itr < 16; ++itr) {
        const int i = itr * 4 + lq;
        float4 S = Sv[itr];
        const float v = wl[320 + i];
        const float sa = -red16(dot4(S, kk4));
        S.x = S.x * d4.x + sa * ka4.x + v * km4.x; S.y = S.y * d4.y + sa * ka4.y + v * km4.y;
        S.z = S.z * d4.z + sa * ka4.z + v * km4.z; S.w = S.w * d4.w + sa * ka4.w + v * km4.w;
        *(float4*)(S1 + i * 64 + c4 * 4) = S;
        const float y = red16(dot4(S, r4));
        if (c4 == 0) wl[384 + i] = y;
    }
    WAVE_SYNC();
    {
        const float y = wl[384 + lane];
        const float mean = wave_sum(y) * (1.0f / 64.0f); const float d = y - mean; const float var = wave_sum(d * d) * (1.0f / 64.0f);
        const float yn = d * rsqrtf(var + GN_EPS) * c.p->in[28][hcol] + c.p->in[29][hcol];
        WSP(bf16_t, WS_AMIX)[row * DM + 1024 + hcol] = f2bf((yn + bon_s * wl[320 + lane]) * WSP(const float, WS_G)[row * 1024 + hcol]);
    }
    WAVE_SYNC();
}

__device__ __forceinline__ void seg_scores(const float4 (&q)[4], const float* kb, int stride, int count, float* sc, int off, int lane) {
    const int l15 = lane & 15, lq = lane >> 4;
#pragma unroll 1
    for (int k0 = 0; k0 < count; k0 += 4) {
        const int key = k0 + lq;
        float4 kv = make_float4(0.f, 0.f, 0.f, 0.f);
        if (key < count) kv = *(const float4*)(kb + (size_t)key * stride + 4 * l15);
        float s0 = red16(dot4(q[0], kv)), s1 = red16(dot4(q[1], kv)), s2 = red16(dot4(q[2], kv)), s3 = red16(dot4(q[3], kv));
        if (l15 == 0 && key < count) { sc[off + key] = s0 * 0.125f; sc[1024 + off + key] = s1 * 0.125f; sc[2048 + off + key] = s2 * 0.125f; sc[3072 + off + key] = s3 * 0.125f; }
    }
}
__device__ __forceinline__ void seg_pv(float4 (&acc)[4], const float* vb, int stride, int count, const float* sc, int off, int lane) {
    const int l15 = lane & 15, lq = lane >> 4;
#pragma unroll 1
    for (int k0 = 0; k0 < count; k0 += 4) {
        const int key = k0 + lq;
        if (key < count) {
            const float4 vv = *(const float4*)(vb + (size_t)key * stride + 4 * l15);
#pragma unroll
            for (int g = 0; g < 4; ++g) { const float pp = sc[g * 1024 + off + key]; acc[g].x += pp * vv.x; acc[g].y += pp * vv.y; acc[g].z += pp * vv.z; acc[g].w += pp * vv.w; }
        }
    }
}
__device__ __forceinline__ void softmax_rows(float* sc, int total, int lane) {
#pragma unroll 1
    for (int g = 0; g < 4; ++g) {
        float* r = sc + g * 1024;
        float m = -3.0e38f;
        for (int i = lane; i < total; i += 64) m = fmaxf(m, r[i]);
        m = wave_max(m);
        float s = 0.f;
        for (int i = lane; i < total; i += 64) { const float e = __expf(r[i] - m); r[i] = e; s += e; }
        s = wave_sum(s);
        const float inv = 1.0f / s;
        for (int i = lane; i < total; i += 64) r[i] *= inv;
    }
}
__device__ __forceinline__ void acc_finish(float4 (&o)[4], float4 (&acc)[4], const float* gate, int gi) {
#pragma unroll
    for (int g = 0; g < 4; ++g) {
        float4 a = acc[g];
        a.x = sum_q(a.x); a.y = sum_q(a.y); a.z = sum_q(a.z); a.w = sum_q(a.w);
        const float gt = gate[g * 3 + gi];
        o[g].x += gt * a.x; o[g].y += gt * a.y; o[g].z += gt * a.z; o[g].w += gt * a.w;
        acc[g] = make_float4(0.f, 0.f, 0.f, 0.f);
    }
}

__device__ __forceinline__ void nsa_item_naive(const Ctx& c, int row, int kvh, float* sc) {
    const int lane = c.lane, l15 = lane & 15;
    const bool smp = row >= NPR;
    const int b = smp ? row - NPR : row >> 12;
    const int t = smp ? PAST : (row & (SEQ - 1));
    const float* KVO = c.out + O_KV;
    const float* KWp = WSP(const float, WS_KW);
    float4 qr[4], qs[4];
#pragma unroll
    for (int g = 0; g < 4; ++g) { qr[g] = *(const float4*)(WSP(const float, WS_QRAW) + (size_t)row * 1024 + (kvh * 4 + g) * 64 + 4 * l15);
                                  qs[g] = *(const float4*)(WSP(const float, WS_QROT) + (size_t)row * 1024 + (kvh * 4 + g) * 64 + 4 * l15); }
    const float* gate = WSP(const float, WS_GATE) + (size_t)row * 48 + kvh * 12;
    float4 o[4], acc[4];
#pragma unroll
    for (int g = 0; g < 4; ++g) { o[g] = make_float4(0.f, 0.f, 0.f, 0.f); acc[g] = make_float4(0.f, 0.f, 0.f, 0.f); }
    WAVE_SYNC();
    int ncmp = smp ? NCS : (t >= 31 ? (t - 31) / 16 + 1 : 0); if (ncmp > NCP) ncmp = NCP;
    const float* kc = (smp ? WSP(const float, WS_KCS) + (size_t)b * 128 * 256 : WSP(const float, WS_KCP) + (size_t)b * 256 * 256) + kvh * 64;
    const float* vc = (smp ? WSP(const float, WS_VCS) + (size_t)b * 128 * 256 : WSP(const float, WS_VCP) + (size_t)b * 256 * 256) + kvh * 64;
    if (ncmp > 0) {
        seg_scores(qr, kc, 256, ncmp, sc, 0, lane); WAVE_SYNC();
        softmax_rows(sc, ncmp, lane); WAVE_SYNC();
        seg_pv(acc, vc, 256, ncmp, sc, 0, lane);
        acc_finish(o, acc, gate, 0);
    }
    unsigned long long mask;
    {
        const int j = lane;
        float imp = 0.f;
#pragma unroll
        for (int r = -1; r <= 3; ++r) { const int n = 4 * j + r; if (n >= 0 && n < ncmp) { const float P = sc[n] + sc[1024 + n] + sc[2048 + n] + sc[3072 + n]; imp += (r == -1 || r == 3) ? P : 2.0f * P; } }
        const int cur = t >> 6;
        const bool valid = j <= cur;
        const bool forced = (j == 0) || (cur - j >= 0 && cur - j < 2);
        const float score = valid ? imp + (forced ? 1.0e4f : 0.0f) : NEGV;
        int rank = 0;
#pragma unroll 1
        for (int jp = 0; jp < 64; ++jp) { const float o2 = __shfl(score, jp); rank += (o2 > score || (o2 == score && jp < j)) ? 1 : 0; }
        mask = __ballot(valid && rank < 16);
    }
    WAVE_SYNC();
    {
        int off = 0;
        unsigned long long m = mask;
#pragma unroll 1
        while (m) { const int j = __ffsll((long long)m) - 1; m &= m - 1;
            const float* kp; int cnt;
            if (!smp) { kp = KVO + ((size_t)(b * SEQ + 64 * j)) * 1024 + 512 + kvh * 64; cnt = t - 64 * j + 1; cnt = cnt > 64 ? 64 : cnt; }
            else if (j < 32) { const int page = ((const int*)c.p->in[3])[b * NPAGES + (j >> 1)]; kp = c.p->in[2] + ((size_t)page * PAGE + (j & 1) * 64) * 1024 + 512 + kvh * 64; cnt = 64; }
            else { kp = KVO + (size_t)row * 1024 + 512 + kvh * 64; cnt = 1; }
            seg_scores(qs, kp, 1024, cnt, sc, off, lane); off += cnt; }
        WAVE_SYNC();
        softmax_rows(sc, off, lane); WAVE_SYNC();
        off = 0; m = mask;
#pragma unroll 1
        while (m) { const int j = __ffsll((long long)m) - 1; m &= m - 1;
            const float* kp; int cnt;
            if (!smp) { kp = KVO + ((size_t)(b * SEQ + 64 * j)) * 1024 + 512 + kvh * 64; cnt = t - 64 * j + 1; cnt = cnt > 64 ? 64 : cnt; }
            else if (j < 32) { const int page = ((const int*)c.p->in[3])[b * NPAGES + (j >> 1)]; kp = c.p->in[2] + ((size_t)page * PAGE + (j & 1) * 64) * 1024 + 512 + kvh * 64; cnt = 64; }
            else { kp = KVO + (size_t)row * 1024 + 512 + kvh * 64; cnt = 1; }
            seg_pv(acc, kp + 256, 1024, cnt, sc, off, lane); off += cnt; }
        acc_finish(o, acc, gate, 1);
    }
    WAVE_SYNC();
    {
        int total;
        if (!smp) { const int start = t > 512 ? t - 512 : 0; const float* kp = KWp + ((size_t)(b * SEQ + start)) * 512 + kvh * 64; total = t - start + 1;
            seg_scores(qs, kp, 512, total, sc, 0, lane); WAVE_SYNC(); softmax_rows(sc, total, lane); WAVE_SYNC(); seg_pv(acc, kp + 256, 512, total, sc, 0, lane); }
        else { const float* k1 = c.p->in[4] + (size_t)b * 512 * 512 + kvh * 64; const float* k2 = KWp + (size_t)row * 512 + kvh * 64; total = 513;
            seg_scores(qs, k1, 512, 512, sc, 0, lane); seg_scores(qs, k2, 512, 1, sc, 512, lane); WAVE_SYNC(); softmax_rows(sc, total, lane); WAVE_SYNC();
            seg_pv(acc, k1 + 256, 512, 512, sc, 0, lane); seg_pv(acc, k2 + 256, 512, 1, sc, 512, lane); }
        acc_finish(o, acc, gate, 2);
    }
    WAVE_SYNC();
    if (lane < 16) {
        bf16_t* dst = WSP(bf16_t, WS_AMIX) + (size_t)row * DM + kvh * 256 + 4 * l15;
#pragma unroll
        for (int g = 0; g < 4; ++g) *(uint2*)(dst + g * 64) = make_uint2(pack2bf(o[g].x, o[g].y), pack2bf(o[g].z, o[g].w));
    }
}

#define SW_LOAD(dst, base, kb_) _Pragma("unroll") for (int u = 0; u < 8; ++u) { int key = (kb_) + 4 * u + lq; key = key < k1 ? key : k1 - 1; dst[u] = *(const float4*)((base) + (size_t)key * stride + 4 * l15); }
__device__ __forceinline__ void sw_scores(const float4 (&q)[4], const float* kb, int stride, int k0, int k1, float* sc, int ld, int off, int lane) {
    const int l15 = lane & 15, lq = lane >> 4;
#define SW_SCORE(kv, kb_) _Pragma("unroll") for (int u = 0; u < 8; ++u) { const int key = (kb_) + 4 * u + lq; \
            const float s0 = red16(dot4(q[0], kv[u])), s1 = red16(dot4(q[1], kv[u])), s2 = red16(dot4(q[2], kv[u])), s3 = red16(dot4(q[3], kv[u])); \
            if (l15 == 0 && key < k1) { sc[off + key] = s0 * 0.125f; sc[ld + off + key] = s1 * 0.125f; sc[2 * ld + off + key] = s2 * 0.125f; sc[3 * ld + off + key] = s3 * 0.125f; } }
    float4 ka[8], kc_[8];
    SW_LOAD(ka, kb, k0)
#pragma unroll 1
    for (int kb0 = k0; kb0 < k1; kb0 += 64) {
        SW_LOAD(kc_, kb, kb0 + 32)
        SW_SCORE(ka, kb0)
        SW_LOAD(ka, kb, kb0 + 64)
        if (kb0 + 32 < k1) { SW_SCORE(kc_, kb0 + 32) }
    }
#undef SW_SCORE
}
__device__ __forceinline__ void sw_pv(float4 (&acc)[4], const float* vb, int stride, int k0, int k1, const float* sc, int ld, int off, int lane) {
    const int l15 = lane & 15, lq = lane >> 4;
#define SW_PV(vv, kb_) _Pragma("unroll") for (int u = 0; u < 8; ++u) { const int key = (kb_) + 4 * u + lq; \
            if (key < k1) { \
                _Pragma("unroll") for (int g = 0; g < 4; ++g) { const float pp = sc[g * ld + off + key]; acc[g].x += pp * vv[u].x; acc[g].y += pp * vv[u].y; acc[g].z += pp * vv[u].z; acc[g].w += pp * vv[u].w; } } }
    float4 va[8], vc_[8];
    SW_LOAD(va, vb, k0)
#pragma unroll 1
    for (int kb0 = k0; kb0 < k1; kb0 += 64) {
        SW_LOAD(vc_, vb, kb0 + 32)
        SW_PV(va, kb0)
        SW_LOAD(va, vb, kb0 + 64)
        if (kb0 + 32 < k1) { SW_PV(vc_, kb0 + 32) }
    }
#undef SW_PV
}
#undef SW_LOAD
__device__ __forceinline__ void sw_softmax_row(float* r, int total, int lane) {
    float m = -3.0e38f;
    for (int i = lane; i < total; i += 64) m = fmaxf(m, r[i]);
    m = wave_max(m);
    float s = 0.f;
    for (int i = lane; i < total; i += 64) { const float e = __expf(r[i] - m); r[i] = e; s += e; }
    s = wave_sum(s);
    const float inv = 1.0f / s;
    for (int i = lane; i < total; i += 64) r[i] *= inv;
}
__device__ __forceinline__ void sw_gate_add(float4 (&tot)[4], float4 (&acc)[4], const float* gate, int gi) {
#pragma unroll
    for (int g = 0; g < 4; ++g) { const float gt = gate[g * 3 + gi]; tot[g].x += gt * acc[g].x; tot[g].y += gt * acc[g].y; tot[g].z += gt * acc[g].z; tot[g].w += gt * acc[g].w; acc[g] = make_float4(0.f, 0.f, 0.f, 0.f); }
}

__device__ __forceinline__ void nsa_sample_wg(const Ctx& c, int item) {
    const int b = item >> 2, kvh = item & 3, row = NPR + b;
    int tid = c.tid; asm volatile("" : "+v"(tid));
    const int lane = tid & 63, wave = c.wave, l15 = lane & 15;
    float* L = (float*)c.lds;
    float* SCC = L;
    float* SCS = L + 512;
    float* SCW = L + 512 + 4096;
    float* SCO = SCW + 4 * 576;
    float* PART = SCO + 64;
    unsigned long long* MSKp = (unsigned long long*)(PART + 8 * 256);
    const float* KVO = c.out + O_KV;
    const float* gate = WSP(const float, WS_GATE) + (size_t)row * 48 + kvh * 12;
    float4 qr[4], qs[4];
#pragma unroll
    for (int g = 0; g < 4; ++g) { qr[g] = *(const float4*)(WSP(const float, WS_QRAW) + (size_t)row * 1024 + (kvh * 4 + g) * 64 + 4 * l15);
                                  qs[g] = *(const float4*)(WSP(const float, WS_QROT) + (size_t)row * 1024 + (kvh * 4 + g) * 64 + 4 * l15); }
    float4 tot[4], acc[4];
#pragma unroll
    for (int g = 0; g < 4; ++g) { tot[g] = make_float4(0.f, 0.f, 0.f, 0.f); acc[g] = make_float4(0.f, 0.f, 0.f, 0.f); }
    const float* kc = WSP(const float, WS_KCS) + (size_t)b * 128 * 256 + kvh * 64;
    const float* vc = WSP(const float, WS_VCS) + (size_t)b * 128 * 256 + kvh * 64;
    const float* kw1 = c.p->in[4] + (size_t)b * 512 * 512 + kvh * 64;
    const float* kw2 = WSP(const float, WS_KW) + (size_t)row * 512 + kvh * 64;
    __syncthreads();
    { const int k0 = 16 * wave, k1 = (16 * wave + 16) < NCS ? 16 * wave + 16 : NCS; if (k0 < k1) sw_scores(qr, kc, 256, k0, k1, SCC, 128, 0, lane); }
    sw_scores(qs, kw1, 512, 64 * wave, 64 * wave + 64, SCW, 576, 0, lane);
    if (wave == 7) sw_scores(qs, kw2, 512, 0, 1, SCW, 576, 512, lane);
    __syncthreads();
    if (wave < 4) sw_softmax_row(SCC + wave * 128, NCS, lane); else sw_softmax_row(SCW + (wave - 4) * 576, 513, lane);
    __syncthreads();
    if (wave == 0) {
        const int j = lane;
        float imp = 0.f;
#pragma unroll
        for (int r = -1; r <= 3; ++r) { const int n = 4 * j + r; if (n >= 0 && n < NCS) { const float P = SCC[n] + SCC[128 + n] + SCC[256 + n] + SCC[384 + n]; imp += (r == -1 || r == 3) ? P : 2.0f * P; } }
        const bool valid = j <= 32, forced = (j == 0) || (j == 31) || (j == 32);
        const float score = valid ? imp + (forced ? 1.0e4f : 0.0f) : NEGV;
        SCO[j] = score;
        WAVE_SYNC();
        int rank = 0;
#pragma unroll 8
        for (int jp = 0; jp < 64; ++jp) { const float o2 = SCO[jp]; rank += (o2 > score || (o2 == score && jp < j)) ? 1 : 0; }
        const unsigned long long mk = __ballot(valid && rank < 16);
        if (lane == 0) MSKp[0] = mk;
    }
    { const int k0 = 16 * wave, k1 = (16 * wave + 16) < NCS ? 16 * wave + 16 : NCS; if (k0 < k1) sw_pv(acc, vc, 256, k0, k1, SCC, 128, 0, lane); }
    sw_gate_add(tot, acc, gate, 0);
    sw_pv(acc, kw1 + 256, 512, 64 * wave, 64 * wave + 64, SCW, 576, 0, lane);
    if (wave == 7) sw_pv(acc, kw2 + 256, 512, 0, 1, SCW, 576, 512, lane);
    sw_gate_add(tot, acc, gate, 2);
    __syncthreads();
    const unsigned long long mask = MSKp[0];
    const float* kp[2]; int cnt[2];
    {
        unsigned long long m = mask; int sidx = 0;
        kp[0] = KVO; kp[1] = KVO; cnt[0] = 0; cnt[1] = 0;
#pragma unroll 1
        while (m) { const int j = __ffsll((long long)m) - 1; m &= m - 1;
            if ((sidx >> 1) == wave) {
                const float* p; int n;
                if (j < 32) { const int page = ((const int*)c.p->in[3])[b * NPAGES + (j >> 1)]; p = c.p->in[2] + ((size_t)page * PAGE + (j & 1) * 64) * 1024 + 512 + kvh * 64; n = 64; }
                else { p = KVO + (size_t)row * 1024 + 512 + kvh * 64; n = 1; }
                if (sidx & 1) { kp[1] = p; cnt[1] = n; } else { kp[0] = p; cnt[0] = n; }
            }
            ++sidx; }
    }
    int total_sel; { const int nsel = __popcll(mask); total_sel = (mask >> 32) & 1ull ? 64 * (nsel - 1) + 1 : 64 * nsel; }
    if (cnt[0] > 0) sw_scores(qs, kp[0], 1024, 0, cnt[0], SCS, 1024, 128 * wave, lane);
    if (cnt[1] > 0) sw_scores(qs, kp[1], 1024, 0, cnt[1], SCS, 1024, 128 * wave + 64, lane);
    __syncthreads();
    if (wave < 4) sw_softmax_row(SCS + wave * 1024, total_sel, lane);
    __syncthreads();
    if (cnt[0] > 0) sw_pv(acc, kp[0] + 256, 1024, 0, cnt[0], SCS, 1024, 128 * wave, lane);
    if (cnt[1] > 0) sw_pv(acc, kp[1] + 256, 1024, 0, cnt[1], SCS, 1024, 128 * wave + 64, lane);
    sw_gate_add(tot, acc, gate, 1);
#pragma unroll
    for (int g = 0; g < 4; ++g) { tot[g].x = sum_q(tot[g].x); tot[g].y = sum_q(tot[g].y); tot[g].z = sum_q(tot[g].z); tot[g].w = sum_q(tot[g].w);
        if (lane < 16) *(float4*)(PART + (wave * 4 + g) * 64 + 4 * l15) = tot[g]; }
    __syncthreads();
    if (tid < 256) { float s = 0.f;
#pragma unroll
        for (int w = 0; w < 8; ++w) s += PART[w * 256 + tid];
        WSP(bf16_t, WS_AMIX)[(size_t)row * DM + kvh * 256 + tid] = f2bf(s); }
}

__device__ __forceinline__ void p6_prep(const Ctx& c) {
    float* wl = (float*)c.lds + c.wave * 4352;
    __syncthreads();
    unsigned long long tp_ = 0; if (PROBE_T >= 341 && PROBE_T <= 343) tp_ = wall_clock64();
#pragma unroll 1
    for (int it = c.bid * NWAVES + c.wave; it < CKN; it += c.G * NWAVES) rwc_prep_item(c, it, wl);
    if (PROBE_T == 341) { __syncthreads(); if (c.tid == 0) atomicMax((unsigned*)(c.ws + WS_CTL) + 6000, (unsigned)(wall_clock64() - tp_)); }
#pragma unroll 1
    for (int it = c.bid * NWAVES + c.wave; it < NSM * 16; it += c.G * NWAVES) scan_sample_item(c, it, wl);
    if (PROBE_T == 342) { __syncthreads(); if (c.tid == 0) atomicMax((unsigned*)(c.ws + WS_CTL) + 6000, (unsigned)(wall_clock64() - tp_)); }
    {
        const size_t per_b = (size_t)511 * 128, total = per_b * NSM, nthr = (size_t)c.G * NTHREADS; const float* sw = c.p->in[4]; float* wo = c.out + O_WINS;
#pragma unroll 1
        for (size_t e0 = (size_t)c.bid * NTHREADS + c.tid; e0 < total; e0 += 8 * nthr) {
            float4 t0, t1, t2, t3, t4, t5, t6, t7;
#define WC_LD(tk, k) { const size_t e_ = e0 + (k) * nthr; const size_t ec = e_ < total ? e_ : total - 1; tk = *(const float4*)(sw + (ec / per_b) * 512 * 512 + 512 + (ec % per_b) * 4); }
#define WC_ST(tk, k) { const size_t e_ = e0 + (k) * nthr; if (e_ < total) *(float4*)(wo + (e_ / per_b) * 512 * 512 + (e_ % per_b) * 4) = tk; }
            WC_LD(t0, 0) WC_LD(t1, 1) WC_LD(t2, 2) WC_LD(t3, 3) WC_LD(t4, 4) WC_LD(t5, 5) WC_LD(t6, 6) WC_LD(t7, 7)
            WC_ST(t0, 0) WC_ST(t1, 1) WC_ST(t2, 2) WC_ST(t3, 3) WC_ST(t4, 4) WC_ST(t5, 5) WC_ST(t6, 6) WC_ST(t7, 7)
#undef WC_LD
#undef WC_ST
        }
    }
}

__device__ __forceinline__ void p6_mixers(const Ctx& c, int qi = 0, unsigned long long* probe_scan_end = nullptr, unsigned long long* probe_acc = nullptr) {
    if (c.bid < 32) { rwc_scan_wg(c, c.bid); if (probe_scan_end && c.bid == 0) *probe_scan_end = wall_clock64(); }
    __syncthreads();
    unsigned* q = (unsigned*)(c.ws + WS_CTL) + CW_QATT + 64 * qi;
    volatile unsigned* sh = (volatile unsigned*)(c.lds + LDS_MISC + 64);
    const int n_mfma = 1024, n_pulls = n_mfma + NSM * 4;
    unsigned nx_ = 0u;
    __syncthreads();
    if (c.tid == 0) sh[0] = atomicAdd(q, 1u);
    __syncthreads();
    unsigned pull = sh[0];
#pragma unroll 1
    while (pull < (unsigned)n_pulls) {
        if (c.tid == 0) nx_ = atomicAdd(q, 1u);
        if (pull < (unsigned)n_mfma) nsa_tile_mfma(c, (int)pull, probe_acc);
        else { unsigned long long ps_ = 0; if (PROBE_T == 204 && probe_acc) ps_ = wall_clock64(); nsa_sample_wg(c, (int)pull - n_mfma); if (PROBE_T == 204 && probe_acc) *probe_acc += wall_clock64() - ps_; }
        __syncthreads();
        if (c.tid == 0) sh[0] = nx_;
        __syncthreads();
        pull = sh[0];
    }
}


constexpr int N_PHASES = 14;

template <class Epi>
__device__ __forceinline__ void run_gemm(const Ctx& c, const bf16_t* A, const bf16_t* Bt, int M, int N, int K, const Epi& E) {
    pg8::Gemm g{A, Bt, M, N, K, K};
    pg8::StaticOrder S; S.init(M, N, c.G, c.bid);
    pg8::gemm_phase<Epi, pg8::StaticOrder, false>((PG8_LAS unsigned char*)c.lds, g, S, E, nullptr);
}
__device__ __forceinline__ void run_gemm_split(const Ctx& c, const bf16_t* A, const bf16_t* Bt, int N, int K, int nsplit) {
    pg8::Gemm g{A + (size_t)NPR * K, Bt, 256, N, K / nsplit, K};
    pg8::SplitOrder S{N / 256, nsplit, K / nsplit, c.G, c.bid};
    pg8::EpiF32 E{WSP(float, WS_OS), N, nullptr, (size_t)256 * N};
    pg8::gemm_phase<pg8::EpiF32, pg8::SplitOrder, false>((PG8_LAS unsigned char*)c.lds, g, S, E, nullptr);
}
__device__ __forceinline__ void reduce_cols_sample(const Ctx& c) {
    const float* os = WSP(const float, WS_OS); float* cols = WSP(float, WS_COLS) + (size_t)NPR * NINP;
    const int n4 = NSM * NINP / 4;
#pragma unroll 1
    for (int e = c.bid * NTHREADS + c.tid; e < n4; e += c.G * NTHREADS) {
        float4 a = *(const float4*)(os + (size_t)e * 4);
#pragma unroll
        for (int sp = 1; sp < 8; ++sp) { const float4 t = *(const float4*)(os + (size_t)sp * 256 * NINP + (size_t)e * 4); a.x += t.x; a.y += t.y; a.z += t.z; a.w += t.w; }
        *(float4*)(cols + (size_t)e * 4) = a;
    }
}

__device__ __forceinline__ bool phase_refresh(Ctx& c) { int t_ = threadIdx.x; asm volatile("" : "+v"(t_)); c.tid = t_; c.lane = t_ & 63; return true; }

__global__ void __launch_bounds__(NTHREADS, 2) hybrid_fwd(Params prm) {
    extern __shared__ __attribute__((aligned(16))) unsigned char shm[];
    Ctx c; c.p = &prm; c.ws = prm.ws; c.out = prm.out; c.lds = shm;
    c.tid = threadIdx.x; c.lane = c.tid & 63; c.wave = __builtin_amdgcn_readfirstlane(c.tid >> 6); c.bid = blockIdx.x; c.G = gridDim.x;
    const int lo = prm.ph_lo, hi = prm.ph_hi;
    if (c.tid < 4) ((volatile unsigned*)(shm + LDS_MISC))[c.tid] = 0u;
    __syncthreads();
    XcdBarrier bar; bar.bar = (unsigned*)(c.ws + WS_CTL) + CW_BAR; bar.x = 0; bar.st = nullptr;
    const bool multi = (hi - lo) > 1;
    if (multi) bar = xcd_barrier_post((unsigned*)(c.ws + WS_CTL) + CW_BAR, (volatile LAS unsigned*)(shm + LDS_MISC));
#ifndef PROBE_PH
#define PROBE_PH -1
#endif
#ifndef PROBE_T
#define PROBE_T -1
#endif
    unsigned long long probe_dt = 0, probe_t0 = 0;
#define PT0(k) do { if (PROBE_T == (k) && c.bid == 0) probe_t0 = wall_clock64(); } while (0)
#define PT1(k) do { if (PROBE_T == (k) && c.bid == 0) probe_dt = wall_clock64() - probe_t0; } while (0)
#define IN(k) (lo <= (k) && (k) < hi && phase_refresh(c))
#define SEAM(k) do { if (lo <= (k) && (k) + 1 < hi) xcd_barrier(bar); } while (0)

    PT0(0);
    if (IN(0)) { p0_prologue(c); } SEAM(0);
    PT1(0);
    PT0(1);
    if (IN(1)) { pg8::EpiSwiGLU E{WSP(bf16_t, WS_ACT), DFF}; run_gemm(c, WSP(const bf16_t, WS_A1), WSP(const bf16_t, WS_WGU1), MP, NGU, DM, E); } SEAM(1);
    PT1(1);
    PT0(2);
    if (IN(2)) { pg8::EpiB16 E{WSP(bf16_t, WS_O), DM}; run_gemm(c, WSP(const bf16_t, WS_ACT), WSP(const bf16_t, WS_WDN1), NPR, DM, DFF, E);
                 run_gemm_split(c, WSP(const bf16_t, WS_ACT), WSP(const bf16_t, WS_WDN1), DM, DFF, 11); } SEAM(2);
    PT1(2);
    PT0(3);
    if (IN(3)) { thin_norm(c, WSP(const float, WS_O), 11, 0, prm.in[8], 0.5f, WSP(float, WS_H1), prm.in[11], WSP(bf16_t, WS_A2)); } SEAM(3);
    PT1(3);
    PT0(4);
    if (IN(4)) { pg8::EpiF32 E{WSP(float, WS_COLS), NINP, nullptr, 0}; run_gemm(c, WSP(const bf16_t, WS_A2), WSP(const bf16_t, WS_WIN), NPR, NINP, DM, E);
                 run_gemm_split(c, WSP(const bf16_t, WS_A2), WSP(const bf16_t, WS_WIN), NINP, DM, 8); } SEAM(4);
    PT1(4);
    PT0(5);
    if (IN(5)) { reduce_cols_sample(c); } SEAM(5);
    PT1(5);
    PT0(6);
    if (IN(6)) {
#if PROBE_T >= 301 && PROBE_T <= 303
        unsigned long long pa_ = 0; p5_queue(c, &pa_); if (c.bid == 255) probe_dt = pa_;
#elif PROBE_T >= 311 && PROBE_T <= 333
        unsigned long long pa_ = wall_clock64(); p5_queue(c, &pa_);
#else
        p5_queue(c);
#endif
    } SEAM(6);
    PT1(6);
#if PROBE_T >= 311 && PROBE_T <= 333
    if (c.bid == 255) probe_dt = (unsigned long long)__hip_atomic_load((unsigned*)(c.ws + WS_CTL) + 6000, __ATOMIC_RELAXED, __HIP_MEMORY_SCOPE_AGENT);
#endif
    PT0(7);
    if (IN(7)) { p6_prep(c); } SEAM(7);
    PT1(7);
#if PROBE_T >= 341 && PROBE_T <= 343
    if (c.bid == 255) probe_dt = (unsigned long long)__hip_atomic_load((unsigned*)(c.ws + WS_CTL) + 6000, __ATOMIC_RELAXED, __HIP_MEMORY_SCOPE_AGENT);
#endif
    PT0(8);
    if (IN(8)) {
#if PROBE_T == 100
        unsigned long long ts0 = wall_clock64(), ts1 = ts0; p6_mixers(c, 0, &ts1); if (c.bid == 0) probe_dt = ts1 - ts0;
#elif PROBE_T >= 201 && PROBE_T <= 212
        unsigned long long pa_ = 0; p6_mixers(c, 0, nullptr, &pa_); if (c.bid == 255) probe_dt = pa_;
#else
        p6_mixers(c, 0);
#endif
    } SEAM(8);
    PT1(8);
    PT0(9);
    if (IN(9)) { pg8::EpiB16 E{WSP(bf16_t, WS_O), DM}; run_gemm(c, WSP(const bf16_t, WS_AMIX), WSP(const bf16_t, WS_WOUT), NPR, DM, DM, E);
                  run_gemm_split(c, WSP(const bf16_t, WS_AMIX), WSP(const bf16_t, WS_WOUT), DM, DM, 8); } SEAM(9);
    PT1(9);
    PT0(10);
    if (IN(10)) { thin_norm(c, WSP(const float, WS_O), 8, 1, prm.in[31], 1.0f, WSP(float, WS_H2), prm.in[32], WSP(bf16_t, WS_A3)); } SEAM(10);
    PT1(10);
    PT0(11);
    if (IN(11)) { pg8::EpiSwiGLU E{WSP(bf16_t, WS_ACT), DFF}; run_gemm(c, WSP(const bf16_t, WS_A3), WSP(const bf16_t, WS_WGU2), MP, NGU, DM, E); } SEAM(11);
    PT1(11);
    PT0(12);
    if (IN(12)) { pg8::EpiB16 E{WSP(bf16_t, WS_O), DM}; run_gemm(c, WSP(const bf16_t, WS_ACT), WSP(const bf16_t, WS_WDN2), NPR, DM, DFF, E);
                  run_gemm_split(c, WSP(const bf16_t, WS_ACT), WSP(const bf16_t, WS_WDN2), DM, DFF, 11); } SEAM(12);
    PT1(12);
    PT0(13);
    if (IN(13)) { thin_norm(c, WSP(const float, WS_O), 11, 2, prm.in[35], 0.5f, c.out + O_Y, nullptr, nullptr); }
    if (PROBE_T >= 0 && c.bid == (PROBE_T >= 201 ? 255 : 0) && c.tid == 0) { const unsigned long long te = wall_clock64(); while (wall_clock64() - te < probe_dt) __builtin_amdgcn_s_sleep(8); }
#undef IN
#undef SEAM
}

extern "C" void kernel_launch(void* const* d_in, const int* in_sizes, int n_in, void* d_out, int out_size, void* d_ws, size_t ws_size, hipStream_t stream) {
    static int grid = 0;
    if (grid == 0) {
        if (n_in != 36 || (size_t)out_size != O_END || ws_size < WS_END) { fprintf(stderr, "kernel_launch: unexpected problem shape (n_in %d, out %d, ws %zu; need 36, %zu, >= %zu)\n", n_in, out_size, ws_size, (size_t)O_END, (size_t)WS_END); grid = -1; return; }
        int dev = 0, cus = 0, per_cu = 0;
        if (hipGetDevice(&dev) != hipSuccess || hipDeviceGetAttribute(&cus, hipDeviceAttributeMultiprocessorCount, dev) != hipSuccess) { grid = -1; return; }
        if (hipFuncSetAttribute((const void*)hybrid_fwd, hipFuncAttributeMaxDynamicSharedMemorySize, LDS_BYTES) != hipSuccess) { fprintf(stderr, "kernel_launch: hipFuncSetAttribute failed\n"); grid = -1; return; }
        if (hipOccupancyMaxActiveBlocksPerMultiprocessor(&per_cu, (const void*)hybrid_fwd, NTHREADS, LDS_BYTES) != hipSuccess || per_cu < 1) { fprintf(stderr, "kernel_launch: occupancy query says %d\n", per_cu); }
        (void)hipGetLastError();
        grid = cus;
        if (grid != 256) fprintf(stderr, "kernel_launch: %d CUs (expected 256)\n", grid);
    }
    if (grid < 0) return;
    if (hipMemsetAsync((char*)d_ws + WS_CTL, 0, CTL_BYTES, stream) != hipSuccess) return;
    Params p{};
    for (int i = 0; i < 36; ++i) p.in[i] = (const float*)d_in[i];
    p.out = (float*)d_out; p.ws = (unsigned char*)d_ws; p.pad0 = 0; p.pad1 = 0;
#if MK_N_LAUNCHES == 1
    p.ph_lo = 0; p.ph_hi = N_PHASES;
    hipLaunchKernelGGL(hybrid_fwd, dim3(grid), dim3(NTHREADS), LDS_BYTES, stream, p);
#else
    for (int ph = 0; ph < N_PHASES; ++ph) { p.ph_lo = ph; p.ph_hi = ph + 1; hipLaunchKernelGGL(hybrid_fwd, dim3(grid), dim3(NTHREADS), LDS_BYTES, stream, p); }
#endif
}
```
